# Optimizing an MI355X kernel written in HIP

```python
import jax, jax.numpy as jnp
from jax import lax
import numpy as np

D_MODEL = 1024
BATCH = 8
SEQ = 4096
DEPTH = 4

CHUNK = 64
Q_BLOCK = 128

D_MIX = D_MODEL
FOX_HEADS = 8
FOX_HEAD_DIM = 64
FOX_W = FOX_HEADS * FOX_HEAD_DIM
MLA_HEADS = 8
MLA_NOPE = 64
MLA_ROPE = 32
MLA_V = 64
MLA_W = MLA_HEADS * MLA_V
Q_LORA = 256
KV_LORA = 128
ROPE_THETA = 10000.0
EPS = 1e-6

IN_SIZES = (FOX_W, FOX_W, FOX_W, FOX_HEADS, FOX_W,
            Q_LORA, KV_LORA, MLA_ROPE, MLA_W)
N_IN = FOX_W * 4 + FOX_HEADS + Q_LORA + KV_LORA + MLA_ROPE + MLA_W

kernel_name = "hybrid_fox_mla_adaln_trunk"


def rms_norm(x, g):
    xf = x.astype(jnp.float32)
    y = xf * lax.rsqrt(jnp.mean(xf * xf, axis=-1, keepdims=True) + EPS) * g.astype(jnp.float32)
    return y.astype(x.dtype)


def to_blocks(a):
    b, s = a.shape[0], a.shape[1]
    return a.reshape((b, s // Q_BLOCK, Q_BLOCK) + a.shape[2:]).swapaxes(0, 1)


def from_blocks(a):
    nb, b, qb = a.shape[0], a.shape[1], a.shape[2]
    return a.swapaxes(0, 1).reshape((b, nb * qb) + a.shape[3:])


def apply_rope(t, cos, sin):
    tf = t.astype(jnp.float32)
    t1, t2 = jnp.split(tf, 2, axis=-1)
    out = jnp.concatenate([t1 * cos - t2 * sin, t2 * cos + t1 * sin], axis=-1)
    return out.astype(t.dtype)


def fox_attention(q, k, v, log_f):
    s_len = q.shape[1]
    cum = jnp.cumsum(log_f, axis=1)
    cum_k = cum.transpose(0, 2, 1)
    key_idx = jnp.arange(s_len)
    scale = FOX_HEAD_DIM ** -0.5

    def block(args):
        qb, cum_qb, start = args
        s = jnp.einsum('bqhd,bkhd->bhqk', qb, k, preferred_element_type=jnp.float32) * scale
        s = s + cum_qb.transpose(0, 2, 1)[..., None] - cum_k[:, :, None, :]
        q_idx = start + jnp.arange(Q_BLOCK)
        mask = key_idx[None, :] <= q_idx[:, None]
        p = jax.nn.softmax(jnp.where(mask, s, -jnp.inf), axis=-1)
        return jnp.einsum('bhqk,bkhd->bqhd', p.astype(v.dtype), v)

    starts = jnp.arange(s_len // Q_BLOCK, dtype=jnp.int32) * Q_BLOCK
    out = lax.map(block, (to_blocks(q), to_blocks(cum), starts))
    return from_blocks(out)


def mla_attention(q_nope, q_rope, k_nope, k_rope, v):
    s_len = q_nope.shape[1]
    key_chunk = jnp.arange(s_len) // CHUNK
    scale = (MLA_NOPE + MLA_ROPE) ** -0.5

    def block(args):
        qn, qr, start = args
        s = jnp.einsum('bqhd,bkhd->bhqk', qn, k_nope, preferred_element_type=jnp.float32)
        s = s + jnp.einsum('bqhr,bkr->bhqk', qr, k_rope, preferred_element_type=jnp.float32)
        q_chunk = (start + jnp.arange(Q_BLOCK)) // CHUNK
        mask = key_chunk[None, :] <= q_chunk[:, None]
        p = jax.nn.softmax(jnp.where(mask, s * scale, -jnp.inf), axis=-1)
        return jnp.einsum('bhqk,bkhd->bqhd', p.astype(v.dtype), v)

    starts = jnp.arange(s_len // Q_BLOCK, dtype=jnp.int32) * Q_BLOCK
    out = lax.map(block, (to_blocks(q_nope), to_blocks(q_rope), starts))
    return from_blocks(out)


def setup_inputs(seed: int = 0) -> dict:
    key = jax.random.key(seed)
    ks = jax.random.split(key, 16)
    f32 = jnp.float32
    x = jax.random.normal(ks[0], (BATCH, SEQ, D_MODEL), f32)
    c = jax.random.normal(ks[1], (BATCH, D_MODEL), f32)
    offset = jax.random.randint(ks[2], (BATCH,), 0, 16, dtype=jnp.int32) * CHUNK
    positions = (offset[:, None] + jnp.arange(SEQ, dtype=jnp.int32)[None, :]).astype(jnp.int32)
    norm_g = 1.0 + 0.02 * jax.random.normal(ks[3], (DEPTH, D_MODEL), f32)
    w_ada = 0.5 * jax.random.normal(ks[4], (DEPTH, D_MODEL, 3 * D_MODEL), f32) * D_MODEL ** -0.5
    b_ada = 0.02 * jax.random.normal(ks[5], (DEPTH, 3 * D_MODEL), f32)
    w_in = jax.random.normal(ks[6], (DEPTH, D_MODEL, N_IN), f32) * D_MODEL ** -0.5
    b_f = jax.random.uniform(ks[7], (DEPTH, FOX_HEADS), f32, 1.0, 4.0)
    q_norm_g = 1.0 + 0.02 * jax.random.normal(ks[8], (DEPTH, Q_LORA), f32)
    w_uq = jax.random.normal(ks[9], (DEPTH, Q_LORA, MLA_HEADS * (MLA_NOPE + MLA_ROPE)), f32) * Q_LORA ** -0.5
    kv_norm_g = 1.0 + 0.02 * jax.random.normal(ks[10], (DEPTH, KV_LORA), f32)
    w_ukv = jax.random.normal(ks[11], (DEPTH, KV_LORA, MLA_HEADS * (MLA_NOPE + MLA_V)), f32) * KV_LORA ** -0.5
    w_out = jax.random.normal(ks[12], (DEPTH, D_MIX, D_MODEL), f32) * D_MIX ** -0.5
    final_g = 1.0 + 0.02 * jax.random.normal(ks[13], (D_MODEL,), f32)
    return {"x": x, "c": c, "positions": positions, "norm_g": norm_g, "w_ada": w_ada,
            "b_ada": b_ada, "w_in": w_in, "b_f": b_f, "q_norm_g": q_norm_g, "w_uq": w_uq,
            "kv_norm_g": kv_norm_g, "w_ukv": w_ukv, "w_out": w_out, "final_g": final_g}


def reference(x, c, positions, norm_g, w_ada, b_ada, w_in, b_f, q_norm_g, w_uq,
              kv_norm_g, w_ukv, w_out, final_g):
    b, s_len, _ = x.shape
    splits = [int(i) for i in np.cumsum(IN_SIZES)[:-1]]

    inv_freq = 1.0 / (ROPE_THETA ** (jnp.arange(0, MLA_ROPE, 2, dtype=jnp.float32) / MLA_ROPE))
    ang = positions.astype(jnp.float32)[..., None] * inv_freq
    cos, sin = jnp.cos(ang), jnp.sin(ang)

    c_act = jax.nn.silu(c)
    for l in range(DEPTH):
        mod = c_act @ w_ada[l] + b_ada[l]
        shift, scale, gate = jnp.split(mod, 3, axis=-1)
        h = rms_norm(x, norm_g[l]) * (1.0 + scale[:, None, :]) + shift[:, None, :]

        z = h @ w_in[l]
        fq, fk, fv, ff, fg, q_lat, kv_lat, k_r, mg = jnp.split(z, splits, axis=-1)

        log_f = jax.nn.log_sigmoid(ff.astype(jnp.float32) + b_f[l].astype(jnp.float32))
        y_fox = fox_attention(fq.reshape(b, s_len, FOX_HEADS, FOX_HEAD_DIM),
                              fk.reshape(b, s_len, FOX_HEADS, FOX_HEAD_DIM),
                              fv.reshape(b, s_len, FOX_HEADS, FOX_HEAD_DIM), log_f)
        y_fox = y_fox.reshape(b, s_len, FOX_W) * jax.nn.silu(fg)

        q = (rms_norm(q_lat, q_norm_g[l]) @ w_uq[l]).reshape(b, s_len, MLA_HEADS, MLA_NOPE + MLA_ROPE)
        q_nope, q_rope = q[..., :MLA_NOPE], q[..., MLA_NOPE:]
        q_rope = apply_rope(q_rope, cos[:, :, None, :], sin[:, :, None, :])
        kv = (rms_norm(kv_lat, kv_norm_g[l]) @ w_ukv[l]).reshape(b, s_len, MLA_HEADS, MLA_NOPE + MLA_V)
        k_nope, v = kv[..., :MLA_NOPE], kv[..., MLA_NOPE:]
        k_rope = apply_rope(k_r, cos, sin)
        y_mla = mla_attention(q_nope, q_rope, k_nope, k_rope, v)
        y_mla = y_mla.reshape(b, s_len, MLA_W) * jax.nn.silu(mg)

        y = jnp.concatenate([y_fox, y_mla], axis=-1) @ w_out[l]
        x = x + gate[:, None, :] * y

    return rms_norm(x, final_g)
```

```cpp
#include <hip/hip_runtime.h>
#include <hip/hip_cooperative_groups.h>
#include <cstdio>
#include <cstdint>
#include <cmath>
namespace cg = cooperative_groups;
__device__ __forceinline__ int otid(int wave_s) { int l; asm volatile("v_mbcnt_lo_u32_b32 %0, -1, 0\n\tv_mbcnt_hi_u32_b32 %0, -1, %0" : "=v"(l)); int w = wave_s; asm volatile("" : "+s"(w)); return (w << 6) | l; }
namespace pg8 {
#define PG8_LAS __attribute__((address_space(3)))
typedef unsigned short bf16_t;
typedef short bf16x8 __attribute__((ext_vector_type(8)));
typedef float f32x4 __attribute__((ext_vector_type(4)));
typedef unsigned u32x4 __attribute__((ext_vector_type(4)));
constexpr int BM = 256, BK = 64, HALF = 128, HTB = HALF * BK * 2  , STAGE_BYTES = 8 * HTB, NXCD = 8, WGM = 8;

__host__ __device__ __forceinline__ int lds_byte(int r, int c) { const int st = (r >> 4) * 2 + (c >> 5), rr = r & 15, cc = c & 31, ob = rr * 64 + cc * 2; return st * 1024 + (ob ^ (((ob >> 9) & 1) << 5)); }
__host__ __device__ __forceinline__ void stage_rc(int b, int& R, int& C) { const int st = b / 1024, sb = b % 1024, swz = sb ^ (((sb >> 9) & 1) << 5); R = (st >> 1) * 16 + swz / 64; C = (st & 1) * 32 + (swz % 64) / 2; }
__host__ __device__ __forceinline__ int perm32(int rho) { const int n = rho >> 4, i = rho & 15; return 8 * (i >> 2) + 4 * n + (i & 3); }

struct Unit { int pm, pn; };
struct Gemm { const bf16_t* A; const bf16_t* Bt; int M, N, K; };

struct StaticOrder {
    int nM, nN, nwg, G, c;
    __host__ __device__ void init(int M, int N, int G_, int c_) { nM = M / BM; nN = N / BM; nwg = nM * nN; G = G_; c = c_; }
    __host__ __device__ bool next(int i, Unit& u) const {
        const long L = (long)i * G + c; if (L >= nwg) return false;
        int wgid = (int)L; { const int q = nwg / NXCD, r = nwg % NXCD, xcd = wgid % NXCD, off = wgid / NXCD; wgid = (xcd < r ? xcd * (q + 1) : r * (q + 1) + (xcd - r) * q) + off; }
        const int nig = WGM * nN, gid = wgid / nig, fm = gid * WGM, gsz = (nM - fm) < WGM ? (nM - fm) : WGM;
        u.pm = fm + ((wgid % nig) % gsz); u.pn = (wgid % nig) / gsz; return true;
    }
    __device__ __forceinline__ void a_ready(const Unit&) const {}
    __device__ __forceinline__ void done(const Unit&) const {}
};

__device__ __forceinline__ unsigned cvt_pk_bf16(float lo, float hi) { unsigned r; asm volatile("v_cvt_pk_bf16_f32 %0, %1, %2" : "=v"(r) : "v"(lo), "v"(hi)); return r; }
template <class Epi, class Sched, bool ALIGN_EPI = false, bool SP2 = false>
__device__ __forceinline__ void gemm_phase(PG8_LAS unsigned char* lds, const Gemm g, const Sched& S, const Epi& E, int wave_s) {
    const int tid = otid(wave_s), wid = __builtin_amdgcn_readfirstlane(tid >> 6), lane = tid & 63, wr = wid >> 2, wc = wid & 3, fr = lane & 15, fq = lane >> 4;
    const int K = g.K, nt = K / BK;
    unsigned voffA[2], voffB[2];
#pragma unroll
    for (int i = 0; i < 2; ++i) { int R, C; stage_rc(tid * 16 + i * 8192, R, C); const int Rb = Epi::PERM ? ((R & ~31) + perm32(R & 31)) : R;
        voffA[i] = (unsigned)(R * K + C) * 2u; voffB[i] = (unsigned)(Rb * K + C) * 2u; }
    const size_t kstep = (size_t)(BK * 2);
    const size_t hstep = (size_t)HALF * K * 2;
    const size_t tstep = 2 * hstep;
    const unsigned ldsw = (unsigned)wid * 1024u;
    const int aoff = lds_byte(wr * 64 + fr, fq * 8), boff = lds_byte(wc * 32 + fr, fq * 8);
#define PG8_SA(b, h) (((b) * 2 + (h)) * HTB)
#define PG8_SB(b, h) ((4 + (b) * 2 + (h)) * HTB)
#define PG8_STAGE(bufoff, gbase, voff) do { _Pragma("unroll") for (int _i = 0; _i < 2; ++_i) \
        __builtin_amdgcn_global_load_lds((const unsigned*)((const char*)(gbase) + (voff)[_i]), (PG8_LAS unsigned*)(lds + (bufoff) + ldsw + _i * 8192), 16, 0, 0); } while (0)
#define PG8_LDA(dst, b, h) do { _Pragma("unroll") for (int m = 0; m < 4; ++m) _Pragma("unroll") for (int k = 0; k < 2; ++k) dst[m][k] = *(const PG8_LAS bf16x8*)(lds + PG8_SA(b, h) + aoff + m * 2048 + k * 1024); } while (0)
#define PG8_LDB(dst, b, h) do { _Pragma("unroll") for (int n = 0; n < 2; ++n) _Pragma("unroll") for (int k = 0; k < 2; ++k) dst[n][k] = *(const PG8_LAS bf16x8*)(lds + PG8_SB(b, h) + boff + n * 2048 + k * 1024); } while (0)
#define PG8_MMA(ai, bj, At, Bt) do { __builtin_amdgcn_s_setprio(1); _Pragma("unroll") for (int m = 0; m < 4; ++m) _Pragma("unroll") for (int n = 0; n < 2; ++n) _Pragma("unroll") for (int k = 0; k < 2; ++k) \
        acc[ai][bj][m][n] = __builtin_amdgcn_mfma_f32_16x16x32_bf16(Bt[n][k], At[m][k], acc[ai][bj][m][n], 0, 0, 0); __builtin_amdgcn_s_setprio(0); } while (0)
#define PG8_WAIT_V(n) asm volatile("s_waitcnt vmcnt(" #n ")" ::: "memory")
#define PG8_WAIT_L(n) asm volatile("s_waitcnt lgkmcnt(" #n ")" ::: "memory")
#define PG8_BAR __builtin_amdgcn_s_barrier()
#define PG8_SCHED __builtin_amdgcn_sched_barrier(0)
    Unit cur, nxt; int ui = 0;
    if (!S.next(0, cur)) return;
    f32x4 acc[2][2][4][2];
#pragma unroll
    for (int a = 0; a < 2; ++a)
#pragma unroll
        for (int b = 0; b < 2; ++b)
#pragma unroll
            for (int m = 0; m < 4; ++m)
#pragma unroll
                for (int n = 0; n < 2; ++n) acc[a][b][m][n] = (f32x4){0.f, 0.f, 0.f, 0.f};
    bf16x8 At[4][2], B0[2][2], B1[2][2];
    const char* cA = (const char*)g.A + (size_t)cur.pm * tstep; const char* cB = (const char*)g.Bt + (size_t)cur.pn * tstep;
    S.a_ready(cur);
    if constexpr (SP2) {
        PG8_STAGE(PG8_SB(0, 0), cB, voffB); PG8_STAGE(PG8_SB(0, 1), cB + hstep, voffB); PG8_STAGE(PG8_SA(0, 0), cA, voffA); PG8_STAGE(PG8_SA(0, 1), cA + hstep, voffA);
        if (wr == 1) PG8_BAR;
        PG8_WAIT_V(2); PG8_BAR;
        PG8_STAGE(PG8_SB(1, 0), cB + kstep, voffB); PG8_STAGE(PG8_SA(1, 0), cA + kstep, voffA); PG8_STAGE(PG8_SB(1, 1), cB + hstep + kstep, voffB);
        PG8_WAIT_V(6); PG8_BAR;
    } else {
        PG8_STAGE(PG8_SB(0, 0), cB, voffB); PG8_STAGE(PG8_SA(0, 0), cA, voffA); PG8_STAGE(PG8_SB(0, 1), cB + hstep, voffB); PG8_STAGE(PG8_SA(0, 1), cA + hstep, voffA);
        if (wr == 1) PG8_BAR;
        PG8_WAIT_V(4); PG8_BAR;
        PG8_STAGE(PG8_SB(1, 0), cB + kstep, voffB); PG8_STAGE(PG8_SA(1, 0), cA + kstep, voffA); PG8_STAGE(PG8_SB(1, 1), cB + hstep + kstep, voffB);
        PG8_WAIT_V(6); PG8_BAR;
    }
    for (;;) {
        const bool has_next = S.next(ui + 1, nxt);
        const char* nA = has_next ? (const char*)g.A + (size_t)nxt.pm * tstep : cA; const char* nB = has_next ? (const char*)g.Bt + (size_t)nxt.pn * tstep : cB;
        for (int t = 0; t < nt; t += 2) {
            const bool last = (t == nt - 2);
            const char* a1 = cA + (size_t)(t + 1) * kstep;
            const char* a2 = last ? nA : cA + (size_t)(t + 2) * kstep; const char* b2 = last ? nB : cB + (size_t)(t + 2) * kstep;
            const char* a3 = a2 + kstep; const char* b3 = b2 + kstep;
            if (last && has_next) S.a_ready(nxt);
            if constexpr (SP2) {
            PG8_LDB(B0, 0, 0); PG8_LDB(B1, 0, 1); PG8_SCHED; PG8_LDA(At, 0, 0); PG8_STAGE(PG8_SA(1, 1), a1 + hstep, voffA);
            PG8_WAIT_V(8); PG8_WAIT_L(0); PG8_BAR; PG8_MMA(0, 0, At, B0); PG8_MMA(0, 1, At, B1); PG8_BAR; PG8_SCHED;
            PG8_LDA(At, 0, 1); PG8_STAGE(PG8_SB(0, 0), b2, voffB); PG8_STAGE(PG8_SB(0, 1), b2 + hstep, voffB); PG8_STAGE(PG8_SA(0, 0), a2, voffA);
            PG8_WAIT_V(8); PG8_WAIT_L(0); PG8_BAR; PG8_MMA(1, 0, At, B0); PG8_MMA(1, 1, At, B1); PG8_BAR; PG8_SCHED;
            PG8_LDB(B0, 1, 0); PG8_LDB(B1, 1, 1); PG8_SCHED; PG8_LDA(At, 1, 0); PG8_STAGE(PG8_SA(0, 1), a2 + hstep, voffA);
            PG8_WAIT_V(8); PG8_WAIT_L(0); PG8_BAR; PG8_MMA(0, 0, At, B0); PG8_MMA(0, 1, At, B1); PG8_BAR; PG8_SCHED;
            PG8_LDA(At, 1, 1); PG8_STAGE(PG8_SB(1, 0), b3, voffB); PG8_STAGE(PG8_SB(1, 1), b3 + hstep, voffB); PG8_STAGE(PG8_SA(1, 0), a3, voffA);
            PG8_WAIT_V(8); PG8_WAIT_L(0); PG8_BAR; PG8_MMA(1, 0, At, B0); PG8_MMA(1, 1, At, B1); PG8_BAR; PG8_SCHED;
            } else {
            PG8_LDB(B0, 0, 0); PG8_SCHED; PG8_LDA(At, 0, 0); PG8_STAGE(PG8_SA(1, 1), a1 + hstep, voffA);
            PG8_WAIT_L(8); PG8_BAR; PG8_WAIT_L(0); PG8_MMA(0, 0, At, B0); PG8_BAR; PG8_SCHED;
            PG8_LDB(B1, 0, 1); PG8_STAGE(PG8_SB(0, 0), b2, voffB);
            PG8_BAR; PG8_WAIT_L(0); PG8_MMA(0, 1, At, B1); PG8_BAR;
            PG8_LDA(At, 0, 1); PG8_STAGE(PG8_SA(0, 0), a2, voffA);
            PG8_BAR; PG8_WAIT_L(0); PG8_MMA(1, 0, At, B0); PG8_BAR; PG8_SCHED;
            PG8_STAGE(PG8_SB(0, 1), b2 + hstep, voffB);
            PG8_WAIT_V(6); PG8_BAR; PG8_MMA(1, 1, At, B1); PG8_BAR;
            PG8_LDB(B0, 1, 0); PG8_SCHED; PG8_LDA(At, 1, 0); PG8_STAGE(PG8_SA(0, 1), a2 + hstep, voffA);
            PG8_WAIT_L(8); PG8_BAR; PG8_WAIT_L(0); PG8_MMA(0, 0, At, B0); PG8_BAR; PG8_SCHED;
            PG8_LDB(B1, 1, 1); PG8_STAGE(PG8_SB(1, 0), b3, voffB);
            PG8_BAR; PG8_WAIT_L(0); PG8_MMA(0, 1, At, B1); PG8_BAR;
            PG8_LDA(At, 1, 1); PG8_STAGE(PG8_SA(1, 0), a3, voffA);
            PG8_BAR; PG8_WAIT_L(0); PG8_MMA(1, 0, At, B0); PG8_BAR; PG8_SCHED;
            PG8_STAGE(PG8_SB(1, 1), b3 + hstep, voffB);
            PG8_WAIT_V(6); PG8_BAR; PG8_MMA(1, 1, At, B1); PG8_BAR;
            }
        }
        if constexpr (ALIGN_EPI) { if (wr == 0) PG8_BAR; }
        if constexpr (!Epi::AFTER_DRAIN) { int fr2 = fr, fq2 = fq; asm volatile("" : "+v"(fr2), "+v"(fq2)); E(acc, cur, wr, wc, fr2, fq2); S.done(cur); }
        if (!has_next) break;
#pragma unroll
        for (int a = 0; a < 2; ++a)
#pragma unroll
            for (int b = 0; b < 2; ++b)
#pragma unroll
                for (int m = 0; m < 4; ++m)
#pragma unroll
                    for (int n = 0; n < 2; ++n) acc[a][b][m][n] = (f32x4){0.f, 0.f, 0.f, 0.f};
        cur = nxt; cA = nA; cB = nB; ++ui;
        if constexpr (ALIGN_EPI) { if (wr == 1) PG8_BAR; }
    }
    PG8_WAIT_V(0);
    if constexpr (!ALIGN_EPI) { if (wr == 0) PG8_BAR; }
    PG8_BAR;
    if constexpr (Epi::AFTER_DRAIN) { E.fused(acc, cur, wr, wc, fr, fq, lds, wid, lane); S.done(cur); }
#undef PG8_SA
#undef PG8_SB
#undef PG8_STAGE
#undef PG8_LDA
#undef PG8_LDB
#undef PG8_MMA
#undef PG8_WAIT_V
#undef PG8_WAIT_L
#undef PG8_BAR
#undef PG8_SCHED
}
}

#define LAS __attribute__((address_space(3)))
typedef unsigned short bf16_t;
typedef short bf16x8 __attribute__((ext_vector_type(8)));
typedef float f32x4 __attribute__((ext_vector_type(4)));
typedef float f32x16 __attribute__((ext_vector_type(16)));
typedef unsigned u32x4 __attribute__((ext_vector_type(4)));
typedef unsigned u32x2 __attribute__((ext_vector_type(2)));
typedef short v4i16_t __attribute__((ext_vector_type(4)));

constexpr int NB = 8, SEQ = 4096, DM = 1024, DEPTH = 4, MTOK = NB * SEQ, NIN = 2984, NINP = 3072;
constexpr float EPS_ = 1e-6f, LOG2E = 1.4426950408889634f;
constexpr float C2F = 0.125f * LOG2E;
constexpr float C2M = 0.10206207261596575f * LOG2E;
constexpr int LDS_BYTES = 132096;

constexpr size_t MiB = 1u << 20;
constexpr size_t WS_WIN = 2 * MiB, WS_WOUT = 26 * MiB, WS_WUQ = 34 * MiB, WS_WUKV = 36 * MiB, WS_MOD = 37 * MiB, WS_COS = 38 * MiB, WS_SIN = 40 * MiB,
                 WS_LOGF = 42 * MiB, WS_CUM = 43 * MiB, WS_SSQQ = 44 * MiB, WS_SSQK = 45 * MiB, WS_H = 48 * MiB, WS_QF = 112 * MiB, WS_KF = 144 * MiB,
                 WS_VF = 176 * MiB, WS_GATE = 208 * MiB, WS_QLAT = 272 * MiB, WS_KVLAT = 288 * MiB, WS_KR = 296 * MiB, WS_QM = 298 * MiB, WS_KM = 346 * MiB,
                 WS_VM = 378 * MiB, WS_END = 410 * MiB;

__device__ __forceinline__ unsigned f2bf(float f) { unsigned u = __builtin_bit_cast(unsigned, f); return (u + 0x7fffu + ((u >> 16) & 1u)) >> 16; }
__device__ __forceinline__ unsigned pk2(float lo, float hi) { return f2bf(lo) | (f2bf(hi) << 16); }
__device__ __forceinline__ float bf2f(bf16_t v) { return __builtin_bit_cast(float, (unsigned)v << 16); }
__device__ __forceinline__ u32x2 pk4(f32x4 v) { u32x2 w; w.x = pk2(v[0], v[1]); w.y = pk2(v[2], v[3]); return w; }
__device__ __forceinline__ float silu_f(float v) { return v / (1.f + __expf(-v)); }
__device__ __forceinline__ f32x4 silu4(f32x4 v) { return (f32x4){silu_f(v[0]), silu_f(v[1]), silu_f(v[2]), silu_f(v[3])}; }
__device__ __forceinline__ float logsig_f(float x) { return fminf(x, 0.f) - log1pf(expf(-fabsf(x))); }
__device__ __forceinline__ float shx(float v, int mask, int lane) { return __builtin_bit_cast(float, __builtin_amdgcn_ds_bpermute((lane ^ mask) << 2, __builtin_bit_cast(int, v))); }
__device__ __forceinline__ float shup(float v, int off, int lane) { return __builtin_bit_cast(float, __builtin_amdgcn_ds_bpermute(((lane - off) & 63) << 2, __builtin_bit_cast(int, v))); }
__device__ __forceinline__ float wave_sum(float v, int lane) {
#pragma unroll
    for (int o = 1; o < 64; o <<= 1) v += shx(v, o, lane);
    return v;
}
#define LDS_WAIT() asm volatile("s_waitcnt lgkmcnt(0)" ::: "memory")

using pg8::Unit;
struct EpiIn {
    static constexpr bool PERM = false, AFTER_DRAIN = false;
    unsigned char* ws; const float* BF;
    __device__ __forceinline__ void operator()(const f32x4 (&acc)[2][2][4][2], const Unit& u, int wr, int wc, int fr, int fq) const {
        const int row0 = u.pm * 256 + wr * 64 + fr;
        bf16_t* QF = (bf16_t*)(ws + WS_QF); bf16_t* GATE = (bf16_t*)(ws + WS_GATE); bf16_t* QLAT = (bf16_t*)(ws + WS_QLAT); bf16_t* KVLAT = (bf16_t*)(ws + WS_KVLAT); bf16_t* KR = (bf16_t*)(ws + WS_KR);
        float* LOGF = (float*)(ws + WS_LOGF); float* SSQQ = (float*)(ws + WS_SSQQ); float* SSQK = (float*)(ws + WS_SSQK); const float* COS = (const float*)(ws + WS_COS); const float* SIN = (const float*)(ws + WS_SIN);
        if (u.pn == 8) {
#pragma unroll
            for (int ai = 0; ai < 2; ++ai)
#pragma unroll
                for (int m = 0; m < 4; ++m) {
                    float s = 0.f;
#pragma unroll
                    for (int bj = 0; bj < 2; ++bj)
#pragma unroll
                        for (int n = 0; n < 2; ++n) { const f32x4 x = acc[ai][bj][m][n]; s += (x[0] * x[0] + x[1] * x[1]) + (x[2] * x[2] + x[3] * x[3]); }
                    s += shx(s, 16, fq * 16 + fr); s += shx(s, 32, fq * 16 + fr);
                    if (fq == 0) SSQQ[(size_t)(row0 + ai * 128 + m * 16) * 4 + wc] = s;
                }
        } else if (u.pn == 9) {
#pragma unroll
            for (int ai = 0; ai < 2; ++ai)
#pragma unroll
                for (int m = 0; m < 4; ++m) {
                    float s = 0.f;
#pragma unroll
                    for (int n = 0; n < 2; ++n) { const f32x4 x = acc[ai][0][m][n]; s += (x[0] * x[0] + x[1] * x[1]) + (x[2] * x[2] + x[3] * x[3]); }
                    s += shx(s, 16, fq * 16 + fr); s += shx(s, 32, fq * 16 + fr);
                    if (fq == 0) SSQK[(size_t)(row0 + ai * 128 + m * 16) * 4 + wc] = s;
                }
        }
#pragma unroll
        for (int bj = 0; bj < 2; ++bj) {
            const int gcol = u.pn * 256 + bj * 128 + wc * 32;
            if (gcol < 1536) {
                const int seg = gcol >> 9; bf16_t* base = QF + (size_t)seg * ((WS_KF - WS_QF) / 2); const float sc = seg == 0 ? C2F : 1.f; const int c0 = (gcol & 511) + 4 * fq;
#pragma unroll
                for (int ai = 0; ai < 2; ++ai)
#pragma unroll
                    for (int m = 0; m < 4; ++m) { bf16_t* rp = base + (size_t)(row0 + ai * 128 + m * 16) * 512 + c0;
#pragma unroll
                        for (int n = 0; n < 2; ++n) *(u32x2*)(rp + 16 * n) = pk4(acc[ai][bj][m][n] * sc); }
            } else if (gcol < 2048 || (gcol >= 2464 && gcol < 2976)) {
                const int c0 = (gcol < 2048 ? gcol - 1536 : gcol - 2464 + 512) + 4 * fq;
#pragma unroll
                for (int ai = 0; ai < 2; ++ai)
#pragma unroll
                    for (int m = 0; m < 4; ++m) { bf16_t* rp = GATE + (size_t)(row0 + ai * 128 + m * 16) * 1024 + c0;
#pragma unroll
                        for (int n = 0; n < 2; ++n) *(u32x2*)(rp + 16 * n) = pk4(silu4(acc[ai][bj][m][n])); }
            } else if (gcol < 2304) {
                const int c0 = gcol - 2048 + 4 * fq;
#pragma unroll
                for (int ai = 0; ai < 2; ++ai)
#pragma unroll
                    for (int m = 0; m < 4; ++m) { bf16_t* rp = QLAT + (size_t)(row0 + ai * 128 + m * 16) * 256 + c0;
#pragma unroll
                        for (int n = 0; n < 2; ++n) *(u32x2*)(rp + 16 * n) = pk4(acc[ai][bj][m][n]); }
            } else if (gcol < 2432) {
                const int c0 = gcol - 2304 + 4 * fq;
#pragma unroll
                for (int ai = 0; ai < 2; ++ai)
#pragma unroll
                    for (int m = 0; m < 4; ++m) { bf16_t* rp = KVLAT + (size_t)(row0 + ai * 128 + m * 16) * 128 + c0;
#pragma unroll
                        for (int n = 0; n < 2; ++n) *(u32x2*)(rp + 16 * n) = pk4(acc[ai][bj][m][n]); }
            } else if (gcol < 2464) {
#pragma unroll
                for (int ai = 0; ai < 2; ++ai)
#pragma unroll
                    for (int m = 0; m < 4; ++m) { const size_t row = (size_t)(row0 + ai * 128 + m * 16);
                        const f32x4 cs = *(const f32x4*)(COS + row * 16 + 4 * fq), sn = *(const f32x4*)(SIN + row * 16 + 4 * fq);
                        const f32x4 t1 = acc[ai][bj][m][0], t2 = acc[ai][bj][m][1];
                        const f32x4 o1 = t1 * cs - t2 * sn, o2 = t2 * cs + t1 * sn;
                        bf16_t* rp = KR + row * 32 + 4 * fq; *(u32x2*)(rp) = pk4(o1); *(u32x2*)(rp + 16) = pk4(o2); if (m & 1) asm volatile("" ::: "memory"); }
            } else if (gcol == 2976) {
                if (fq < 2) {
                    const f32x4 bfv = *(const f32x4*)(BF + 4 * fq);
#pragma unroll
                    for (int ai = 0; ai < 2; ++ai)
#pragma unroll
                        for (int m = 0; m < 4; ++m) { const size_t row = (size_t)(row0 + ai * 128 + m * 16); const f32x4 v = acc[ai][bj][m][0] + bfv;
                            *(f32x4*)(LOGF + row * 8 + 4 * fq) = (f32x4){logsig_f(v[0]), logsig_f(v[1]), logsig_f(v[2]), logsig_f(v[3])}; }
                }
            }
        }
    }
};
struct EpiQ {
    static constexpr bool PERM = false, AFTER_DRAIN = false;
    unsigned char* ws;
    __device__ __forceinline__ void operator()(const f32x4 (&acc)[2][2][4][2], const Unit& u, int wr, int wc, int fr, int fq) const {
        const int row0 = u.pm * 256 + wr * 64 + fr;
        const float* SSQ = (const float*)(ws + WS_SSQQ); const float* COS = (const float*)(ws + WS_COS); const float* SIN = (const float*)(ws + WS_SIN); bf16_t* QM = (bf16_t*)(ws + WS_QM);
        float rs[2][4];
#pragma unroll
        for (int ai = 0; ai < 2; ++ai)
#pragma unroll
            for (int m = 0; m < 4; ++m) { const f32x4 s = *(const f32x4*)(SSQ + (size_t)(row0 + ai * 128 + m * 16) * 4); rs[ai][m] = rsqrtf(((s[0] + s[1]) + (s[2] + s[3])) * (1.f / 256.f) + EPS_) * C2M; }
#pragma unroll
        for (int bj = 0; bj < 2; ++bj) {
            const int gcol = u.pn * 256 + bj * 128 + wc * 32; const bool rope = ((gcol >> 5) % 3) == 2;
#pragma unroll
            for (int ai = 0; ai < 2; ++ai)
#pragma unroll
                for (int m = 0; m < 4; ++m) { const size_t row = (size_t)(row0 + ai * 128 + m * 16);
                    f32x4 v0 = acc[ai][bj][m][0] * rs[ai][m], v1 = acc[ai][bj][m][1] * rs[ai][m];
                    if (rope) { const f32x4 cs = *(const f32x4*)(COS + row * 16 + 4 * fq), sn = *(const f32x4*)(SIN + row * 16 + 4 * fq);
                        const f32x4 o1 = v0 * cs - v1 * sn, o2 = v1 * cs + v0 * sn; v0 = o1; v1 = o2; }
                    bf16_t* rp = QM + row * 768 + gcol + 4 * fq; *(u32x2*)(rp) = pk4(v0); *(u32x2*)(rp + 16) = pk4(v1); if (m & 1) asm volatile("" ::: "memory"); }
        }
    }
};
struct EpiKV {
    static constexpr bool PERM = false, AFTER_DRAIN = false;
    unsigned char* ws;
    __device__ __forceinline__ void operator()(const f32x4 (&acc)[2][2][4][2], const Unit& u, int wr, int wc, int fr, int fq) const {
        const int row0 = u.pm * 256 + wr * 64 + fr;
        const float* SSQ = (const float*)(ws + WS_SSQK); bf16_t* KM = (bf16_t*)(ws + WS_KM);
        float rs[2][4];
#pragma unroll
        for (int ai = 0; ai < 2; ++ai)
#pragma unroll
            for (int m = 0; m < 4; ++m) { const f32x4 s = *(const f32x4*)(SSQ + (size_t)(row0 + ai * 128 + m * 16) * 4); rs[ai][m] = rsqrtf(((s[0] + s[1]) + (s[2] + s[3])) * (1.f / 128.f) + EPS_); }
#pragma unroll
        for (int bj = 0; bj < 2; ++bj) {
            const int gcol = u.pn * 256 + bj * 128 + wc * 32; const int head = gcol >> 7, within = gcol & 127;
            bf16_t* base = KM + (within < 64 ? (size_t)0 : (size_t)((WS_VM - WS_KM) / 2)); const int c0 = head * 64 + (within & 63) + 4 * fq;
#pragma unroll
            for (int ai = 0; ai < 2; ++ai)
#pragma unroll
                for (int m = 0; m < 4; ++m) { bf16_t* rp = base + (size_t)(row0 + ai * 128 + m * 16) * 512 + c0;
#pragma unroll
                    for (int n = 0; n < 2; ++n) *(u32x2*)(rp + 16 * n) = pk4(acc[ai][bj][m][n] * rs[ai][m]); }
        }
    }
};
struct EpiOut {
    static constexpr bool PERM = false, AFTER_DRAIN = false;
    const float* XIN; float* XOUT; const float* MODG;
    __device__ __forceinline__ void operator()(const f32x4 (&acc)[2][2][4][2], const Unit& u, int wr, int wc, int fr, int fq) const {
        const int row0 = u.pm * 256 + wr * 64 + fr; const int b = (u.pm * 256) >> 12;
#pragma unroll
        for (int bj = 0; bj < 2; ++bj)
#pragma unroll
            for (int n = 0; n < 2; ++n) { const int col = u.pn * 256 + bj * 128 + wc * 32 + 16 * n + 4 * fq; const f32x4 g4 = *(const f32x4*)(MODG + (size_t)b * 3072 + col);
#pragma unroll
                for (int ai = 0; ai < 2; ++ai)
#pragma unroll
                    for (int m = 0; m < 4; ++m) { const size_t off = (size_t)(row0 + ai * 128 + m * 16) * 1024 + col; const f32x4 xi = *(const f32x4*)(XIN + off); *(f32x4*)(XOUT + off) = xi + g4 * acc[ai][bj][m][n]; } asm volatile("" ::: "memory"); }
    }
};

__device__ __forceinline__ int crow(int r, int hi) { return (r & 3) + 8 * (r >> 2) + 4 * hi; }
__device__ __forceinline__ bf16x8 vtr2(const LAS unsigned char* p) {
    const v4i16_t lo = __builtin_amdgcn_ds_read_tr16_b64_v4i16((LAS v4i16_t*)p), hi = __builtin_amdgcn_ds_read_tr16_b64_v4i16((LAS v4i16_t*)(p + 512));
    return (bf16x8){lo[0], lo[1], lo[2], lo[3], hi[0], hi[1], hi[2], hi[3]};
}
typedef float f32x2_t __attribute__((ext_vector_type(2))); typedef __bf16 bf16x2_t __attribute__((ext_vector_type(2)));
__device__ __forceinline__ unsigned cvtpk_s(float lo, float hi) { f32x2_t v = {lo, hi}; bf16x2_t b = __builtin_convertvector(v, bf16x2_t); return __builtin_bit_cast(unsigned, b); }
constexpr int AT_KBUF = 13312, AT_OFF_V = 2 * AT_KBUF, AT_OFF_CK = AT_OFF_V + 2 * 8192, AT_OFF_WS = AT_OFF_CK + 512;

template <bool MLA>
__device__ __forceinline__ void attn_unit(LAS unsigned char* lds, int b, int h, int qb, unsigned char* ws, int wave_s) {
    constexpr int DQK = MLA ? 96 : 64, NDS = DQK / 16, KROW = MLA ? 208 : 144, QP = MLA ? 768 : 512;
    const bf16_t* Q = (const bf16_t*)(ws + (MLA ? WS_QM : WS_QF)); const bf16_t* K = (const bf16_t*)(ws + (MLA ? WS_KM : WS_KF)); const bf16_t* V = (const bf16_t*)(ws + (MLA ? WS_VM : WS_VF));
    const bf16_t* KRp = (const bf16_t*)(ws + WS_KR); const float* CUM = (const float*)(ws + WS_CUM); const bf16_t* GATE = (const bf16_t*)(ws + WS_GATE); bf16_t* Y = (bf16_t*)(ws + WS_H);
    const int tid = otid(wave_s), lane = tid & 63, r32 = lane & 31, hi = lane >> 5; const int wid = __builtin_amdgcn_readfirstlane(tid >> 6);
    const int q0 = qb * 256, qw0 = q0 + wid * 32; const size_t rowbase = (size_t)b * SEQ;
    const int NT = q0 / 64 + 4;
    bf16x8 qr[NDS];
    { const bf16_t* qp = Q + (rowbase + qw0 + r32) * QP + h * DQK + hi * 8;
#pragma unroll
      for (int ds = 0; ds < NDS; ++ds) qr[ds] = *(const bf16x8*)(qp + ds * 16); }
    float cq = 0.f; if (!MLA) cq = CUM[(size_t)(b * 8 + h) * SEQ + qw0 + r32];
    const int krow = tid >> 3, kch = tid & 7;
    const bf16_t* kg = K + (rowbase + krow) * 512 + h * 64 + kch * 8; const int kdst = krow * KROW + kch * 16;
    const bf16_t* krg = KRp + (rowbase + (tid >> 2)) * 32 + (tid & 3) * 8; const int krdst = (tid >> 2) * KROW + 128 + (tid & 3) * 16;
    const int vdh = tid >> 8, vrow = (tid >> 2) & 63, vc4 = tid & 3;
    const bf16_t* vg = V + (rowbase + vrow) * 512 + h * 64 + vdh * 32 + vc4 * 8; const int vdst = AT_OFF_V + vdh * 4096 + vrow * 64 + vc4 * 16;
    const float* ckg = CUM + (size_t)(b * 8 + h) * SEQ + (tid & 63);
    u32x4 kreg, krreg = (u32x4){0u, 0u, 0u, 0u}, vreg; float ckreg = 0.f;
#define AT_LOAD(t) do { kreg = *(const u32x4*)(kg + (size_t)(t) * 64 * 512); vreg = *(const u32x4*)(vg + (size_t)(t) * 64 * 512); \
        if (MLA) { if (tid < 256) krreg = *(const u32x4*)(krg + (size_t)(t) * 64 * 32); } else { if (tid < 64) ckreg = ckg[(t) * 64]; } } while (0)
#define AT_STORE(bf) do { *(LAS u32x4*)(lds + (bf) * AT_KBUF + kdst) = kreg; *(LAS u32x4*)(lds + (bf) * 8192 + vdst) = vreg; \
        if (MLA) { if (tid < 256) *(LAS u32x4*)(lds + (bf) * AT_KBUF + krdst) = krreg; } else { if (tid < 64) *(LAS float*)(lds + AT_OFF_CK + (bf) * 256 + tid * 4) = ckreg; } } while (0)
    __syncthreads();
    AT_LOAD(0); AT_STORE(0);
    __syncthreads();
    float mhat = -1e30f, lsum = 0.f; f32x16 o0 = {}, o1 = {};
    LAS float* wsf = (LAS float*)(lds + AT_OFF_WS) + wid * 64;
    const int vb = AT_OFF_V + ((lane >> 4) & 1) * 32 + (lane & 3) * 8 + (4 * hi + ((lane & 15) >> 2)) * 64;
    for (int t = 0; t < NT; ++t) {
        const int buf = t & 1;
        if (t + 1 < NT) AT_LOAD(t + 1);
        const int ks = t * 64;
        if (ks <= qw0) {
            f32x16 p0, p1;
            if (!MLA) {
#pragma unroll
                for (int g = 0; g < 4; ++g) { const f32x4 c0 = *(const LAS f32x4*)(lds + AT_OFF_CK + buf * 256 + (8 * g + 4 * hi) * 4), c1 = *(const LAS f32x4*)(lds + AT_OFF_CK + buf * 256 + (32 + 8 * g + 4 * hi) * 4);
#pragma unroll
                    for (int e = 0; e < 4; ++e) { p0[4 * g + e] = cq - c0[e]; p1[4 * g + e] = cq - c1[e]; } }
            } else { p0 = (f32x16){}; p1 = (f32x16){}; }
            const LAS unsigned char* kb = lds + buf * AT_KBUF + r32 * KROW + hi * 16;
#pragma unroll
            for (int ds = 0; ds < NDS; ++ds) {
                const bf16x8 kf0 = *(const LAS bf16x8*)(kb + ds * 32), kf1 = *(const LAS bf16x8*)(kb + 32 * KROW + ds * 32);
                p0 = __builtin_amdgcn_mfma_f32_32x32x16_bf16(kf0, qr[ds], p0, 0, 0, 0);
                p1 = __builtin_amdgcn_mfma_f32_32x32x16_bf16(kf1, qr[ds], p1, 0, 0, 0);
            }
            if (!MLA && ks + 63 > qw0) {
                const int q = qw0 + r32;
#pragma unroll
                for (int r = 0; r < 16; ++r) { const int kv = ks + crow(r, hi); if (kv > q) p0[r] = -INFINITY; if (kv + 32 > q) p1[r] = -INFINITY; }
            }
            float rm = fmaxf(p0[0], p1[0]);
#pragma unroll
            for (int r = 1; r < 16; ++r) rm = fmaxf(rm, fmaxf(p0[r], p1[r]));
            rm = fmaxf(rm, shx(rm, 32, lane));
            if (__any(rm > mhat + 8.f)) {
                const float mnew = fmaxf(mhat, rm), alpha = __builtin_amdgcn_exp2f(mhat - mnew);
                lsum *= alpha; mhat = mnew;
                if (hi == 0) wsf[r32] = alpha;
                LDS_WAIT();
#pragma unroll
                for (int g = 0; g < 4; ++g) { const f32x4 a = *(const LAS f32x4*)(wsf + 8 * g + 4 * hi);
#pragma unroll
                    for (int e = 0; e < 4; ++e) { o0[4 * g + e] *= a[e]; o1[4 * g + e] *= a[e]; } }
                LDS_WAIT();
            }
            float sacc = 0.f;
#pragma unroll
            for (int r = 0; r < 16; ++r) { p0[r] = __builtin_amdgcn_exp2f(p0[r] - mhat); p1[r] = __builtin_amdgcn_exp2f(p1[r] - mhat); sacc += p0[r] + p1[r]; }
            lsum += sacc;
            u32x4 pw[4];
#pragma unroll
            for (int s = 0; s < 2; ++s) {
                pw[s]     = (u32x4){cvtpk_s(p0[8 * s], p0[8 * s + 1]), cvtpk_s(p0[8 * s + 2], p0[8 * s + 3]), cvtpk_s(p0[8 * s + 4], p0[8 * s + 5]), cvtpk_s(p0[8 * s + 6], p0[8 * s + 7])};
                pw[2 + s] = (u32x4){cvtpk_s(p1[8 * s], p1[8 * s + 1]), cvtpk_s(p1[8 * s + 2], p1[8 * s + 3]), cvtpk_s(p1[8 * s + 4], p1[8 * s + 5]), cvtpk_s(p1[8 * s + 6], p1[8 * s + 7])};
            }
            const LAS unsigned char* vp = lds + vb + buf * 8192;
#pragma unroll
            for (int s = 0; s < 4; ++s) {
                const bf16x8 pa = __builtin_bit_cast(bf16x8, pw[s]);
                const bf16x8 v0 = vtr2(vp + s * 1024), v1 = vtr2(vp + 4096 + s * 1024);
                o0 = __builtin_amdgcn_mfma_f32_32x32x16_bf16(pa, v0, o0, 0, 0, 0);
                o1 = __builtin_amdgcn_mfma_f32_32x32x16_bf16(pa, v1, o1, 0, 0, 0);
            }
        }
        if (t + 1 < NT) AT_STORE(buf ^ 1);
        __syncthreads();
    }
#undef AT_LOAD
#undef AT_STORE
    const float lt = lsum + shx(lsum, 32, lane);
    if (hi == 0) wsf[r32] = 1.f / lt;
    LDS_WAIT();
    float rli[16];
#pragma unroll
    for (int g = 0; g < 4; ++g) { const f32x4 a = *(const LAS f32x4*)(wsf + 8 * g + 4 * hi);
#pragma unroll
        for (int e = 0; e < 4; ++e) rli[4 * g + e] = a[e]; }
    LDS_WAIT();
    const int cb = (MLA ? 512 : 0) + h * 64 + r32;
#pragma unroll
    for (int r = 0; r < 16; ++r) { const size_t off = (rowbase + qw0 + crow(r, hi)) * 1024 + cb;
        const float g0 = bf2f(GATE[off]), g1 = bf2f(GATE[off + 32]);
        Y[off] = (bf16_t)f2bf(o0[r] * rli[r] * g0); Y[off + 32] = (bf16_t)f2bf(o1[r] * rli[r] * g1); }
}

template <int MODE>
__device__ __forceinline__ void transpose_item(const float* __restrict__ W, int K, int Nsrc, int Ndst, bf16_t* __restrict__ WT, const float* __restrict__ kscale, LAS float* scr, int item, int lane) {
    const int nblk = Ndst / 32, kb = item / nblk, nb = item % nblk, k0 = 64 * kb, n0 = 32 * nb;
    const int nd = n0 + (lane & 31); int ns = nd; bool valid = true;
    if (MODE == 1) { if (nd < 1536) ns = nd; else if (nd < 2976) ns = nd + 8; else if (nd < 2984) ns = nd - 1440; else { ns = 0; valid = false; } }
#pragma unroll 8
    for (int i = 0; i < 32; ++i) { const int kk = 2 * i + (lane >> 5); float v = valid ? W[(size_t)(k0 + kk) * Nsrc + ns] : 0.f; if (kscale) v *= kscale[k0 + kk]; scr[kk * 33 + (lane & 31)] = v; }
    LDS_WAIT();
    const int c = lane & 7;
#pragma unroll
    for (int j = 0; j < 4; ++j) { const int n = (lane >> 3) + 8 * j; const LAS float* s = scr + (8 * c) * 33 + n;
        u32x4 o; o.x = pk2(s[0 * 33], s[1 * 33]); o.y = pk2(s[2 * 33], s[3 * 33]); o.z = pk2(s[4 * 33], s[5 * 33]); o.w = pk2(s[6 * 33], s[7 * 33]);
        *(u32x4*)(WT + (size_t)(n0 + n) * K + k0 + 8 * c) = o; }
    LDS_WAIT();
}

struct Args { const void* in[14]; float* out; unsigned char* ws; };

__global__ void __launch_bounds__(512) mk_fwd(Args args) {
    extern __shared__ __attribute__((aligned(16))) unsigned char smem[];
    LAS unsigned char* lds = (LAS unsigned char*)smem;
    cg::grid_group grid = cg::this_grid();
    const int wave_s = __builtin_amdgcn_readfirstlane((int)threadIdx.x >> 6);
    const int G = gridDim.x, bx = blockIdx.x, NGW = G * 8;
    unsigned char* ws = args.ws; float* X = args.out;
    float* MOD = (float*)(ws + WS_MOD);

    {
        const int tid = otid(wave_s), lane = tid & 63; const int wave = __builtin_amdgcn_readfirstlane(tid >> 6); const int gw = bx * 8 + wave;
        const float* c_in = (const float*)args.in[1]; const int* pos_in = (const int*)args.in[2];
        const float* w_ada = (const float*)args.in[4]; const float* b_ada = (const float*)args.in[5];
        const float* w_in = (const float*)args.in[6]; const float* q_norm_g = (const float*)args.in[8];
        const float* w_uq = (const float*)args.in[9]; const float* kv_norm_g = (const float*)args.in[10]; const float* w_ukv = (const float*)args.in[11];
        const float* w_out = (const float*)args.in[12];
        bf16_t* WIN = (bf16_t*)(ws + WS_WIN); bf16_t* WOUT = (bf16_t*)(ws + WS_WOUT); bf16_t* WUQ = (bf16_t*)(ws + WS_WUQ); bf16_t* WUKV = (bf16_t*)(ws + WS_WUKV);
        float* COS = (float*)(ws + WS_COS); float* SIN = (float*)(ws + WS_SIN);
        for (int unit = bx; unit < DEPTH * 48; unit += G) {
            LAS float* cact = (LAS float*)lds; LAS float* red = (LAS float*)(lds + 32768);
            const int l = unit / 48, n = (unit % 48) * 64 + lane;
            for (int i = tid; i < NB * DM; i += 512) cact[i] = silu_f(c_in[i]);
            __syncthreads();
            float a[8];
#pragma unroll
            for (int b = 0; b < 8; ++b) a[b] = 0.f;
            const float* wp = w_ada + ((size_t)l * DM + 128 * wave) * 3072 + n;
#pragma unroll 4
            for (int kk = 0; kk < 128; ++kk) { const float wv = wp[(size_t)kk * 3072];
#pragma unroll
                for (int b = 0; b < 8; ++b) a[b] += cact[b * DM + 128 * wave + kk] * wv; }
#pragma unroll
            for (int b = 0; b < 8; ++b) red[(wave * 8 + b) * 64 + lane] = a[b];
            __syncthreads();
            { float s = b_ada[l * 3072 + n];
#pragma unroll
              for (int w2 = 0; w2 < 8; ++w2) s += red[(w2 * 8 + wave) * 64 + lane];
              MOD[(size_t)(l * 8 + wave) * 3072 + n] = s; }
            __syncthreads();
        }
        { LAS float* scr = (LAS float*)(lds + 49152) + wave * (64 * 33);
          constexpr int I_IN = 16 * 96, I_OUT = 16 * 32, I_UQ = 4 * 24, I_UKV = 2 * 32, I_L = I_IN + I_OUT + I_UQ + I_UKV;
          for (int it = gw; it < DEPTH * I_L; it += NGW) {
              const int l = it / I_L; int r = it % I_L;
              if (r < I_IN) { transpose_item<1>(w_in + (size_t)l * DM * NIN, DM, NIN, NINP, WIN + (size_t)l * NINP * DM, nullptr, scr, r, lane); continue; } r -= I_IN;
              if (r < I_OUT) { transpose_item<0>(w_out + (size_t)l * DM * DM, DM, DM, DM, WOUT + (size_t)l * DM * DM, nullptr, scr, r, lane); continue; } r -= I_OUT;
              if (r < I_UQ) { transpose_item<0>(w_uq + (size_t)l * 256 * 768, 256, 768, 768, WUQ + (size_t)l * 768 * 256, q_norm_g + l * 256, scr, r, lane); continue; } r -= I_UQ;
              transpose_item<0>(w_ukv + (size_t)l * 128 * 1024, 128, 1024, 1024, WUKV + (size_t)l * 1024 * 128, kv_norm_g + l * 128, scr, r, lane);
          } }
        for (int idx = bx * 512 + tid; idx < MTOK * 16; idx += G * 512) {
            const int tok = idx >> 4, i = idx & 15;
            const float inv = 1.0f / powf(10000.0f, (float)(2 * i) * (1.0f / 32.0f));
            const float ang = (float)pos_in[tok] * inv; float sn, cs; sincosf(ang, &sn, &cs);
            COS[idx] = cs; SIN[idx] = sn;
        }
    }

    for (int l = 0; l <= DEPTH; ++l) {
        grid.sync();
        {
            const int tid = otid(wave_s), lane = tid & 63; const int wave = __builtin_amdgcn_readfirstlane(tid >> 6); const int gw = bx * 8 + wave;
            const bool fin = (l == DEPTH);
            const float* xs = (l == 0) ? (const float*)args.in[0] : X; const float* gsrc = fin ? (const float*)args.in[13] : (const float*)args.in[3] + l * DM;
            bf16_t* H = (bf16_t*)(ws + WS_H);
            for (int r0 = gw * 16; r0 < MTOK; r0 += NGW * 16) {
                const int b = r0 >> 12;
                f32x4 gs[4], sh[4];
#pragma unroll
                for (int j = 0; j < 4; ++j) { const int col = 4 * lane + 256 * j; const f32x4 g = *(const f32x4*)(gsrc + col);
                    if (fin) { gs[j] = g; sh[j] = (f32x4){0.f, 0.f, 0.f, 0.f}; }
                    else { const f32x4 sc = *(const f32x4*)(MOD + (size_t)(l * 8 + b) * 3072 + 1024 + col); gs[j] = g * (sc + 1.0f); sh[j] = *(const f32x4*)(MOD + (size_t)(l * 8 + b) * 3072 + col); } }
                for (int rr = 0; rr < 16; ++rr) {
                    const size_t row = (size_t)(r0 + rr);
                    f32x4 v[4]; float ss = 0.f;
#pragma unroll
                    for (int j = 0; j < 4; ++j) { v[j] = *(const f32x4*)(xs + row * DM + 4 * lane + 256 * j); ss += (v[j][0] * v[j][0] + v[j][1] * v[j][1]) + (v[j][2] * v[j][2] + v[j][3] * v[j][3]); }
                    const float rstd = rsqrtf(wave_sum(ss, lane) * (1.f / DM) + EPS_);
                    if (fin) {
#pragma unroll
                        for (int j = 0; j < 4; ++j) *(f32x4*)(X + row * DM + 4 * lane + 256 * j) = v[j] * rstd * gs[j];
                    } else {
#pragma unroll
                        for (int j = 0; j < 4; ++j) *(u32x2*)(H + row * DM + 4 * lane + 256 * j) = pk4(v[j] * rstd * gs[j] + sh[j]);
                    }
                }
            }
        }
        if (l == DEPTH) break;
        grid.sync();
        {
            pg8::Gemm g{(const bf16_t*)(ws + WS_H), (const bf16_t*)(ws + WS_WIN) + (size_t)l * NINP * DM, MTOK, NINP, DM}; pg8::StaticOrder S; S.init(MTOK, NINP, G, bx);
            EpiIn E{ws, (const float*)args.in[7] + l * 8};
            pg8::gemm_phase<EpiIn, pg8::StaticOrder, true, true>(lds, g, S, E, wave_s);
        }
        grid.sync();
        {
            const int tid = otid(wave_s), lane = tid & 63; const int wave = __builtin_amdgcn_readfirstlane(tid >> 6);
            const float* LOGF = (const float*)(ws + WS_LOGF); float* CUM = (float*)(ws + WS_CUM);
            for (int u = bx; u < 64; u += G) {
                LAS float* wsum = (LAS float*)lds;
                const float* lf = LOGF + (size_t)(u >> 3) * SEQ * 8 + (u & 7);
                float v[8]; float s = 0.f;
#pragma unroll
                for (int i = 0; i < 8; ++i) { s += lf[(size_t)(8 * tid + i) * 8]; v[i] = s; }
                float incl = s;
#pragma unroll
                for (int off = 1; off < 64; off <<= 1) { const float t = shup(incl, off, lane); if (lane >= off) incl += t; }
                if (lane == 63) wsum[wave] = incl;
                __syncthreads();
                float base = 0.f;
                for (int w2 = 0; w2 < wave; ++w2) base += wsum[w2];
                const float excl = base + incl - s;
#pragma unroll
                for (int i = 0; i < 8; ++i) CUM[(size_t)u * SEQ + 8 * tid + i] = (excl + v[i]) * LOG2E;
                __syncthreads();
            }
        }
        { pg8::Gemm g{(const bf16_t*)(ws + WS_QLAT), (const bf16_t*)(ws + WS_WUQ) + (size_t)l * 768 * 256, MTOK, 768, 256}; pg8::StaticOrder S; S.init(MTOK, 768, G, bx);
          EpiQ E{ws};
          pg8::gemm_phase<EpiQ, pg8::StaticOrder, true, true>(lds, g, S, E, wave_s); }
        __syncthreads();
        { pg8::Gemm g{(const bf16_t*)(ws + WS_KVLAT), (const bf16_t*)(ws + WS_WUKV) + (size_t)l * 1024 * 128, MTOK, 1024, 128}; pg8::StaticOrder S; S.init(MTOK, 1024, G, bx);
          EpiKV E{ws};
          pg8::gemm_phase<EpiKV, pg8::StaticOrder, true, true>(lds, g, S, E, wave_s); }
        grid.sync();
        {
            const int vcu = (G % 8 == 0) ? (bx % 8) * (G / 8) + bx / 8 : bx;
            for (int u = vcu; u < 2048; u += G) {
                const int i = u & 255, j = u >> 8; const int bh = i >> 2, s = i & 3, jj = j & 3;
                const int qb = (jj == 0) ? 15 - s : (jj == 1) ? 8 + s : (jj == 2) ? 7 - s : s;
                if (j < 4) attn_unit<true>(lds, bh >> 3, bh & 7, qb, ws, wave_s);
                else attn_unit<false>(lds, bh >> 3, bh & 7, qb, ws, wave_s);
            }
        }
        grid.sync();
        {
            pg8::Gemm g{(const bf16_t*)(ws + WS_H), (const bf16_t*)(ws + WS_WOUT) + (size_t)l * DM * DM, MTOK, DM, DM}; pg8::StaticOrder S; S.init(MTOK, DM, G, bx);
            EpiOut E{l == 0 ? (const float*)args.in[0] : X, X, MOD + (size_t)l * 8 * 3072 + 2048};
            pg8::gemm_phase<EpiOut, pg8::StaticOrder, true, true>(lds, g, S, E, wave_s);
        }
    }
}

extern "C" void kernel_launch(void* const* d_in, const int* in_sizes, int n_in, void* d_out, int out_size, void* d_ws, size_t ws_size, hipStream_t stream) {
    static int grid = 0;
    if (grid == 0) {
        if (n_in != 14 || out_size != MTOK * DM || ws_size < WS_END) { fprintf(stderr, "kernel_launch: unexpected shapes (n_in %d, out %d, ws %zu)\n", n_in, out_size, ws_size); grid = -1; return; }
        int dev = 0, cus = 0, per_cu = 0;
        (void)hipGetDevice(&dev); (void)hipDeviceGetAttribute(&cus, hipDeviceAttributeMultiprocessorCount, dev);
        (void)hipFuncSetAttribute((const void*)mk_fwd, hipFuncAttributeMaxDynamicSharedMemorySize, LDS_BYTES);
        if (hipOccupancyMaxActiveBlocksPerMultiprocessor(&per_cu, (const void*)mk_fwd, 512, LDS_BYTES) != hipSuccess || per_cu < 1) per_cu = 1;
        (void)hipGetLastError();
        grid = cus * per_cu;
    }
    if (grid < 0) return;
    Args a{};
    for (int i = 0; i < 14; ++i) a.in[i] = d_in[i];
    a.out = (float*)d_out; a.ws = (unsigned char*)d_ws;
    void* kargs[] = {&a};
    hipError_t e = hipLaunchCooperativeKernel((const void*)mk_fwd, dim3(grid), dim3(512), kargs, LDS_BYTES, stream);
    if (e != hipSuccess) fprintf(stderr, "cooperative launch failed: %s (grid %d)\n", hipGetErrorString(e), grid);
}
```

```cpp
#include <hip/hip_runtime.h>
#include <hip/hip_cooperative_groups.h>
#include <cstdio>
#include <cstdint>
#include <cmath>
namespace cg = cooperative_groups;
__device__ __forceinline__ int otid(int wave_s) { int l; asm volatile("v_mbcnt_lo_u32_b32 %0, -1, 0\n\tv_mbcnt_hi_u32_b32 %0, -1, %0" : "=v"(l)); int w = wave_s; asm volatile("" : "+s"(w)); return (w << 6) | l; }
namespace pg8 {
#define PG8_LAS __attribute__((address_space(3)))
typedef unsigned short bf16_t;
typedef short bf16x8 __attribute__((ext_vector_type(8)));
typedef float f32x4 __attribute__((ext_vector_type(4)));
typedef unsigned u32x4 __attribute__((ext_vector_type(4)));
constexpr int BM = 256, BK = 64, HALF = 128, HTB = HALF * BK * 2  , STAGE_BYTES = 8 * HTB, NXCD = 8, WGM = 8;

__host__ __device__ __forceinline__ int lds_byte(int r, int c) { const int st = (r >> 4) * 2 + (c >> 5), rr = r & 15, cc = c & 31, ob = rr * 64 + cc * 2; return st * 1024 + (ob ^ (((ob >> 9) & 1) << 5)); }
__host__ __device__ __forceinline__ void stage_rc(int b, int& R, int& C) { const int st = b / 1024, sb = b % 1024, swz = sb ^ (((sb >> 9) & 1) << 5); R = (st >> 1) * 16 + swz / 64; C = (st & 1) * 32 + (swz % 64) / 2; }
__host__ __device__ __forceinline__ int perm32(int rho) { const int n = rho >> 4, i = rho & 15; return 8 * (i >> 2) + 4 * n + (i & 3); }

struct Unit { int pm, pn; };
struct Gemm { const bf16_t* A; const bf16_t* Bt; int M, N, K; };

struct StaticOrder {
    int nM, nN, nwg, G, c;
    __host__ __device__ void init(int M, int N, int G_, int c_) { nM = M / BM; nN = N / BM; nwg = nM * nN; G = G_; c = c_; }
    __host__ __device__ bool next(int i, Unit& u) const {
        const long L = (long)i * G + c; if (L >= nwg) return false;
        int wgid = (int)L; { const int q = nwg / NXCD, r = nwg % NXCD, xcd = wgid % NXCD, off = wgid / NXCD; wgid = (xcd < r ? xcd * (q + 1) : r * (q + 1) + (xcd - r) * q) + off; }
        const int nig = WGM * nN, gid = wgid / nig, fm = gid * WGM, gsz = (nM - fm) < WGM ? (nM - fm) : WGM;
        u.pm = fm + ((wgid % nig) % gsz); u.pn = (wgid % nig) / gsz; return true;
    }
    __device__ __forceinline__ void a_ready(const Unit&) const {}
    __device__ __forceinline__ void done(const Unit&) const {}
};

__device__ __forceinline__ unsigned cvt_pk_bf16(float lo, float hi) { unsigned r; asm volatile("v_cvt_pk_bf16_f32 %0, %1, %2" : "=v"(r) : "v"(lo), "v"(hi)); return r; }
template <class Epi, class Sched, bool ALIGN_EPI = false, bool SP2 = false>
__device__ __forceinline__ void gemm_phase(PG8_LAS unsigned char* lds, const Gemm g, const Sched& S, const Epi& E, int wave_s) {
    const int tid = otid(wave_s), wid = __builtin_amdgcn_readfirstlane(tid >> 6), lane = tid & 63, wr = wid >> 2, wc = wid & 3, fr = lane & 15, fq = lane >> 4;
    const int K = g.K, nt = K / BK;
    unsigned voffA[2], voffB[2];
#pragma unroll
    for (int i = 0; i < 2; ++i) { int R, C; stage_rc(tid * 16 + i * 8192, R, C); const int Rb = Epi::PERM ? ((R & ~31) + perm32(R & 31)) : R;
        voffA[i] = (unsigned)(R * K + C) * 2u; voffB[i] = (unsigned)(Rb * K + C) * 2u; }
    const size_t kstep = (size_t)(BK * 2);
    const size_t hstep = (size_t)HALF * K * 2;
    const size_t tstep = 2 * hstep;
    const unsigned ldsw = (unsigned)wid * 1024u;
    const int aoff = lds_byte(wr * 64 + fr, fq * 8), boff = lds_byte(wc * 32 + fr, fq * 8);
#define PG8_SA(b, h) (((b) * 2 + (h)) * HTB)
#define PG8_SB(b, h) ((4 + (b) * 2 + (h)) * HTB)
#define PG8_STAGE(bufoff, gbase, voff) do { _Pragma("unroll") for (int _i = 0; _i < 2; ++_i) \
        __builtin_amdgcn_global_load_lds((const unsigned*)((const char*)(gbase) + (voff)[_i]), (PG8_LAS unsigned*)(lds + (bufoff) + ldsw + _i * 8192), 16, 0, 0); } while (0)
#define PG8_LDA(dst, b, h) do { _Pragma("unroll") for (int m = 0; m < 4; ++m) _Pragma("unroll") for (int k = 0; k < 2; ++k) dst[m][k] = *(const PG8_LAS bf16x8*)(lds + PG8_SA(b, h) + aoff + m * 2048 + k * 1024); } while (0)
#define PG8_LDB(dst, b, h) do { _Pragma("unroll") for (int n = 0; n < 2; ++n) _Pragma("unroll") for (int k = 0; k < 2; ++k) dst[n][k] = *(const PG8_LAS bf16x8*)(lds + PG8_SB(b, h) + boff + n * 2048 + k * 1024); } while (0)
#define PG8_MMA(ai, bj, At, Bt) do { __builtin_amdgcn_s_setprio(1); _Pragma("unroll") for (int m = 0; m < 4; ++m) _Pragma("unroll") for (int n = 0; n < 2; ++n) _Pragma("unroll") for (int k = 0; k < 2; ++k) \
        acc[ai][bj][m][n] = __builtin_amdgcn_mfma_f32_16x16x32_bf16(Bt[n][k], At[m][k], acc[ai][bj][m][n], 0, 0, 0); __builtin_amdgcn_s_setprio(0); } while (0)
#define PG8_WAIT_V(n) asm volatile("s_waitcnt vmcnt(" #n ")" ::: "memory")
#define PG8_WAIT_L(n) asm volatile("s_waitcnt lgkmcnt(" #n ")" ::: "memory")
#define PG8_BAR __builtin_amdgcn_s_barrier()
#define PG8_SCHED __builtin_amdgcn_sched_barrier(0)
    Unit cur, nxt; int ui = 0;
    if (!S.next(0, cur)) return;
    f32x4 acc[2][2][4][2];
#pragma unroll
    for (int a = 0; a < 2; ++a)
#pragma unroll
        for (int b = 0; b < 2; ++b)
#pragma unroll
            for (int m = 0; m < 4; ++m)
#pragma unroll
                for (int n = 0; n < 2; ++n) acc[a][b][m][n] = (f32x4){0.f, 0.f, 0.f, 0.f};
    bf16x8 At[4][2], B0[2][2], B1[2][2];
    const char* cA = (const char*)g.A + (size_t)cur.pm * tstep; const char* cB = (const char*)g.Bt + (size_t)cur.pn * tstep;
    S.a_ready(cur);
    if constexpr (SP2) {
        PG8_STAGE(PG8_SB(0, 0), cB, voffB); PG8_STAGE(PG8_SB(0, 1), cB + hstep, voffB); PG8_STAGE(PG8_SA(0, 0), cA, voffA); PG8_STAGE(PG8_SA(0, 1), cA + hstep, voffA);
        if (wr == 1) PG8_BAR;
        PG8_WAIT_V(2); PG8_BAR;
        PG8_STAGE(PG8_SB(1, 0), cB + kstep, voffB); PG8_STAGE(PG8_SA(1, 0), cA + kstep, voffA); PG8_STAGE(PG8_SB(1, 1), cB + hstep + kstep, voffB);
        PG8_WAIT_V(6); PG8_BAR;
    } else {
        PG8_STAGE(PG8_SB(0, 0), cB, voffB); PG8_STAGE(PG8_SA(0, 0), cA, voffA); PG8_STAGE(PG8_SB(0, 1), cB + hstep, voffB); PG8_STAGE(PG8_SA(0, 1), cA + hstep, voffA);
        if (wr == 1) PG8_BAR;
        PG8_WAIT_V(4); PG8_BAR;
        PG8_STAGE(PG8_SB(1, 0), cB + kstep, voffB); PG8_STAGE(PG8_SA(1, 0), cA + kstep, voffA); PG8_STAGE(PG8_SB(1, 1), cB + hstep + kstep, voffB);
        PG8_WAIT_V(6); PG8_BAR;
    }
    for (;;) {
        const bool has_next = S.next(ui + 1, nxt);
        const char* nA = has_next ? (const char*)g.A + (size_t)nxt.pm * tstep : cA; const char* nB = has_next ? (const char*)g.Bt + (size_t)nxt.pn * tstep : cB;
        for (int t = 0; t < nt; t += 2) {
            const bool last = (t == nt - 2);
            const char* a1 = cA + (size_t)(t + 1) * kstep;
            const char* a2 = last ? nA : cA + (size_t)(t + 2) * kstep; const char* b2 = last ? nB : cB + (size_t)(t + 2) * kstep;
            const char* a3 = a2 + kstep; const char* b3 = b2 + kstep;
            if (last && has_next) S.a_ready(nxt);
            if constexpr (SP2) {
            PG8_LDB(B0, 0, 0); PG8_LDB(B1, 0, 1); PG8_SCHED; PG8_LDA(At, 0, 0); PG8_STAGE(PG8_SA(1, 1), a1 + hstep, voffA);
            PG8_WAIT_V(8); PG8_WAIT_L(0); PG8_BAR; PG8_MMA(0, 0, At, B0); PG8_MMA(0, 1, At, B1); PG8_BAR; PG8_SCHED;
            PG8_LDA(At, 0, 1); PG8_STAGE(PG8_SB(0, 0), b2, voffB); PG8_STAGE(PG8_SB(0, 1), b2 + hstep, voffB); PG8_STAGE(PG8_SA(0, 0), a2, voffA);
            PG8_WAIT_V(8); PG8_WAIT_L(0); PG8_BAR; PG8_MMA(1, 0, At, B0); PG8_MMA(1, 1, At, B1); PG8_BAR; PG8_SCHED;
            PG8_LDB(B0, 1, 0); PG8_LDB(B1, 1, 1); PG8_SCHED; PG8_LDA(At, 1, 0); PG8_STAGE(PG8_SA(0, 1), a2 + hstep, voffA);
            PG8_WAIT_V(8); PG8_WAIT_L(0); PG8_BAR; PG8_MMA(0, 0, At, B0); PG8_MMA(0, 1, At, B1); PG8_BAR; PG8_SCHED;
            PG8_LDA(At, 1, 1); PG8_STAGE(PG8_SB(1, 0), b3, voffB); PG8_STAGE(PG8_SB(1, 1), b3 + hstep, voffB); PG8_STAGE(PG8_SA(1, 0), a3, voffA);
            PG8_WAIT_V(8); PG8_WAIT_L(0); PG8_BAR; PG8_MMA(1, 0, At, B0); PG8_MMA(1, 1, At, B1); PG8_BAR; PG8_SCHED;
            } else {
            PG8_LDB(B0, 0, 0); PG8_SCHED; PG8_LDA(At, 0, 0); PG8_STAGE(PG8_SA(1, 1), a1 + hstep, voffA);
            PG8_WAIT_L(8); PG8_BAR; PG8_WAIT_L(0); PG8_MMA(0, 0, At, B0); PG8_BAR; PG8_SCHED;
            PG8_LDB(B1, 0, 1); PG8_STAGE(PG8_SB(0, 0), b2, voffB);
            PG8_BAR; PG8_WAIT_L(0); PG8_MMA(0, 1, At, B1); PG8_BAR;
            PG8_LDA(At, 0, 1); PG8_STAGE(PG8_SA(0, 0), a2, voffA);
            PG8_BAR; PG8_WAIT_L(0); PG8_MMA(1, 0, At, B0); PG8_BAR; PG8_SCHED;
            PG8_STAGE(PG8_SB(0, 1), b2 + hstep, voffB);
            PG8_WAIT_V(6); PG8_BAR; PG8_MMA(1, 1, At, B1); PG8_BAR;
            PG8_LDB(B0, 1, 0); PG8_SCHED; PG8_LDA(At, 1, 0); PG8_STAGE(PG8_SA(0, 1), a2 + hstep, voffA);
            PG8_WAIT_L(8); PG8_BAR; PG8_WAIT_L(0); PG8_MMA(0, 0, At, B0); PG8_BAR; PG8_SCHED;
            PG8_LDB(B1, 1, 1); PG8_STAGE(PG8_SB(1, 0), b3, voffB);
            PG8_BAR; PG8_WAIT_L(0); PG8_MMA(0, 1, At, B1); PG8_BAR;
            PG8_LDA(At, 1, 1); PG8_STAGE(PG8_SA(1, 0), a3, voffA);
            PG8_BAR; PG8_WAIT_L(0); PG8_MMA(1, 0, At, B0); PG8_BAR; PG8_SCHED;
            PG8_STAGE(PG8_SB(1, 1), b3 + hstep, voffB);
            PG8_WAIT_V(6); PG8_BAR; PG8_MMA(1, 1, At, B1); PG8_BAR;
            }
        }
        if constexpr (ALIGN_EPI) { if (wr == 0) PG8_BAR; }
        if constexpr (!Epi::AFTER_DRAIN) { int fr2 = fr, fq2 = fq; asm volatile("" : "+v"(fr2), "+v"(fq2)); E(acc, cur, wr, wc, fr2, fq2); S.done(cur); }
        if (!has_next) break;
#pragma unroll
        for (int a = 0; a < 2; ++a)
#pragma unroll
            for (int b = 0; b < 2; ++b)
#pragma unroll
                for (int m = 0; m < 4; ++m)
#pragma unroll
                    for (int n = 0; n < 2; ++n) acc[a][b][m][n] = (f32x4){0.f, 0.f, 0.f, 0.f};
        cur = nxt; cA = nA; cB = nB; ++ui;
        if constexpr (ALIGN_EPI) { if (wr == 1) PG8_BAR; }
    }
    PG8_WAIT_V(0);
    if constexpr (!ALIGN_EPI) { if (wr == 0) PG8_BAR; }
    PG8_BAR;
    if constexpr (Epi::AFTER_DRAIN) { E.fused(acc, cur, wr, wc, fr, fq, lds, wid, lane); S.done(cur); }
#undef PG8_SA
#undef PG8_SB
#undef PG8_STAGE
#undef PG8_LDA
#undef PG8_LDB
#undef PG8_MMA
#undef PG8_WAIT_V
#undef PG8_WAIT_L
#undef PG8_BAR
#undef PG8_SCHED
}
}

#define LAS __attribute__((address_space(3)))
typedef unsigned short bf16_t;
typedef short bf16x8 __attribute__((ext_vector_type(8)));
typedef float f32x4 __attribute__((ext_vector_type(4)));
typedef float f32x16 __attribute__((ext_vector_type(16)));
typedef unsigned u32x4 __attribute__((ext_vector_type(4)));
typedef unsigned u32x2 __attribute__((ext_vector_type(2)));
typedef short v4i16_t __attribute__((ext_vector_type(4)));

constexpr int NB = 8, SEQ = 4096, DM = 1024, DEPTH = 4, MTOK = NB * SEQ, NIN = 2984, NINP = 3072;
constexpr float EPS_ = 1e-6f, LOG2E = 1.4426950408889634f;
constexpr float C2F = 0.125f * LOG2E;
constexpr float C2M = 0.10206207261596575f * LOG2E;
constexpr int LDS_BYTES = 132096;

constexpr size_t MiB = 1u << 20;
constexpr size_t WS_WIN = 2 * MiB, WS_WOUT = 26 * MiB, WS_WUQ = 34 * MiB, WS_WUKV = 36 * MiB, WS_MOD = 37 * MiB, WS_COS = 38 * MiB, WS_SIN = 40 * MiB,
                 WS_LOGF = 42 * MiB, WS_CUM = 43 * MiB, WS_SSQQ = 44 * MiB, WS_SSQK = 45 * MiB, WS_H = 48 * MiB, WS_QF = 112 * MiB, WS_KF = 144 * MiB,
                 WS_VF = 176 * MiB, WS_GATE = 208 * MiB, WS_QLAT = 272 * MiB, WS_KVLAT = 288 * MiB, WS_KR = 296 * MiB, WS_QM = 298 * MiB, WS_KM = 346 * MiB,
                 WS_VM = 378 * MiB, WS_END = 410 * MiB;

__device__ __forceinline__ unsigned f2bf(float f) { unsigned u = __builtin_bit_cast(unsigned, f); return (u + 0x7fffu + ((u >> 16) & 1u)) >> 16; }
__device__ __forceinline__ unsigned pk2(float lo, float hi) { return f2bf(lo) | (f2bf(hi) << 16); }
__device__ __forceinline__ float bf2f(bf16_t v) { return __builtin_bit_cast(float, (unsigned)v << 16); }
__device__ __forceinline__ u32x2 pk4(f32x4 v) { u32x2 w; w.x = pk2(v[0], v[1]); w.y = pk2(v[2], v[3]); return w; }
__device__ __forceinline__ float silu_f(float v) { return v / (1.f + __expf(-v)); }
__device__ __forceinline__ f32x4 silu4(f32x4 v) { return (f32x4){silu_f(v[0]), silu_f(v[1]), silu_f(v[2]), silu_f(v[3])}; }
__device__ __forceinline__ float logsig_f(float x) { return fminf(x, 0.f) - log1pf(expf(-fabsf(x))); }
__device__ __forceinline__ float shx(float v, int mask, int lane) { return __builtin_bit_cast(float, __builtin_amdgcn_ds_bpermute((lane ^ mask) << 2, __builtin_bit_cast(int, v))); }
__device__ __forceinline__ float shup(float v, int off, int lane) { return __builtin_bit_cast(float, __builtin_amdgcn_ds_bpermute(((lane - off) & 63) << 2, __builtin_bit_cast(int, v))); }
__device__ __forceinline__ float wave_sum(float v, int lane) {
#pragma unroll
    for (int o = 1; o < 64; o <<= 1) v += shx(v, o, lane);
    return v;
}
#define LDS_WAIT() asm volatile("s_waitcnt lgkmcnt(0)" ::: "memory")


#define XB_TMO      128
#define XB_XCNT(j)  (256  + 64 * (j))
#define XB_XSUB(j)  (1280 + 64 * (j))
#define XB_XGEN(j)  (2304 + 64 * (j))
#define XB_TOP      3328
#define XB_TOPGEN   3392
#define XCD_BAR_WORDS 3456
#define XB_SPIN_CAP (1u << 18)
__device__ __forceinline__ unsigned xb_ld(unsigned* p)              { return __hip_atomic_load(p, __ATOMIC_RELAXED, __HIP_MEMORY_SCOPE_AGENT); }
__device__ __forceinline__ unsigned xb_add(unsigned* p, unsigned v) { return __hip_atomic_fetch_add(p, v, __ATOMIC_RELAXED, __HIP_MEMORY_SCOPE_AGENT); }
__device__ __forceinline__ unsigned xb_xcc_id() { return (unsigned)__builtin_amdgcn_s_getreg((3 << 11) | 20) & 0xFu; }
#define XB_SPIN(cond, bar) do { unsigned _sp = 0; while (cond) { __builtin_amdgcn_s_sleep(1); \
    if ((++_sp & 255u) == 0u) { if (xb_ld(&(bar)[XB_TMO])) break; if (_sp > XB_SPIN_CAP) { atomicAdd(&(bar)[XB_TMO], 1u); break; } } } } while (0)
__device__ __forceinline__ void xcd_barrier_complete(unsigned* bar, unsigned x, unsigned& nloc, unsigned& nx) {
    const unsigned G = gridDim.x * gridDim.y * gridDim.z;
    unsigned sum, cnt, mine, sp = 0u;
    for (;;) {
        sum = 0u; cnt = 0u; mine = 0u;
#pragma unroll
        for (unsigned j = 0; j < 16; ++j) { const unsigned c = xb_ld(&bar[XB_XCNT(j)]); sum += c; cnt += (c > 0u) ? 1u : 0u; mine = (j == x) ? c : mine; }
        if (sum == G) break;
        __builtin_amdgcn_s_sleep(1);
        if ((++sp & 255u) == 0u) { if (xb_ld(&bar[XB_TMO])) break; if (sp > XB_SPIN_CAP) { atomicAdd(&bar[XB_TMO], 1u); break; } }
    }
    nloc = mine > 0u ? mine : 1u; nx = cnt > 0u ? cnt : 1u;
}
__device__ __forceinline__ void xcd_barrier(unsigned* bar, volatile LAS unsigned* st, int tid) {
    asm volatile("s_waitcnt vmcnt(0)" ::: "memory");
    __syncthreads();
    if (tid == 0) {
        const unsigned x = xb_xcc_id();
        __builtin_amdgcn_s_waitcnt(0);
        unsigned nloc = st[0], nx = st[1];
        if (nloc == 0u) { xcd_barrier_complete(bar, x, nloc, nx); st[0] = nloc; st[1] = nx; }
        const unsigned old = xb_add(&bar[XB_XSUB(x)], 1u);
        const unsigned gen = old / nloc;
        if (old + 1u == (gen + 1u) * nloc) {
            __builtin_amdgcn_fence(__ATOMIC_RELEASE, "agent");
            asm volatile("s_waitcnt vmcnt(0)" ::: "memory");
            const unsigned og = xb_add(&bar[XB_TOP], 1u);
            const unsigned tg = og / nx;
            if (og + 1u == (tg + 1u) * nx) xb_add(&bar[XB_TOPGEN], 1u);
            else XB_SPIN(xb_ld(&bar[XB_TOPGEN]) == tg, bar);
            __builtin_amdgcn_fence(__ATOMIC_ACQUIRE, "agent");
            xb_add(&bar[XB_XGEN(x)], 1u);
            asm volatile("s_waitcnt vmcnt(0)" ::: "memory");
        } else {
            XB_SPIN(xb_ld(&bar[XB_XGEN(x)]) == gen, bar);
            __builtin_amdgcn_fence(__ATOMIC_ACQUIRE, "agent");
            asm volatile("s_waitcnt vmcnt(0)" ::: "memory");
        }
    }
    __syncthreads();
}

using pg8::Unit;
struct EpiIn {
    static constexpr bool PERM = false, AFTER_DRAIN = false;
    unsigned char* ws; const float* BF;
    __device__ __forceinline__ void operator()(const f32x4 (&acc)[2][2][4][2], const Unit& u, int wr, int wc, int fr, int fq) const {
        const int row0 = u.pm * 256 + wr * 64 + fr;
        bf16_t* QF = (bf16_t*)(ws + WS_QF); bf16_t* GATE = (bf16_t*)(ws + WS_GATE); bf16_t* QLAT = (bf16_t*)(ws + WS_QLAT); bf16_t* KVLAT = (bf16_t*)(ws + WS_KVLAT); bf16_t* KR = (bf16_t*)(ws + WS_KR);
        float* LOGF = (float*)(ws + WS_LOGF); float* SSQQ = (float*)(ws + WS_SSQQ); float* SSQK = (float*)(ws + WS_SSQK); const float* COS = (const float*)(ws + WS_COS); const float* SIN = (const float*)(ws + WS_SIN);
        if (u.pn == 8) {
#pragma unroll
            for (int ai = 0; ai < 2; ++ai)
#pragma unroll
                for (int m = 0; m < 4; ++m) {
                    float s = 0.f;
#pragma unroll
                    for (int bj = 0; bj < 2; ++bj)
#pragma unroll
                        for (int n = 0; n < 2; ++n) { const f32x4 x = acc[ai][bj][m][n]; s += (x[0] * x[0] + x[1] * x[1]) + (x[2] * x[2] + x[3] * x[3]); }
                    s += shx(s, 16, fq * 16 + fr); s += shx(s, 32, fq * 16 + fr);
                    if (fq == 0) SSQQ[(size_t)(row0 + ai * 128 + m * 16) * 4 + wc] = s;
                }
        } else if (u.pn == 9) {
#pragma unroll
            for (int ai = 0; ai < 2; ++ai)
#pragma unroll
                for (int m = 0; m < 4; ++m) {
                    float s = 0.f;
#pragma unroll
                    for (int n = 0; n < 2; ++n) { const f32x4 x = acc[ai][0][m][n]; s += (x[0] * x[0] + x[1] * x[1]) + (x[2] * x[2] + x[3] * x[3]); }
                    s += shx(s, 16, fq * 16 + fr); s += shx(s, 32, fq * 16 + fr);
                    if (fq == 0) SSQK[(size_t)(row0 + ai * 128 + m * 16) * 4 + wc] = s;
                }
        }
#pragma unroll
        for (int bj = 0; bj < 2; ++bj) {
            const int gcol = u.pn * 256 + bj * 128 + wc * 32;
            if (gcol < 1536) {
                const int seg = gcol >> 9; bf16_t* base = QF + (size_t)seg * ((WS_KF - WS_QF) / 2); const float sc = seg == 0 ? C2F : 1.f; const int c0 = (gcol & 511) + 4 * fq;
#pragma unroll
                for (int ai = 0; ai < 2; ++ai)
#pragma unroll
                    for (int m = 0; m < 4; ++m) { bf16_t* rp = base + (size_t)(row0 + ai * 128 + m * 16) * 512 + c0;
#pragma unroll
                        for (int n = 0; n < 2; ++n) *(u32x2*)(rp + 16 * n) = pk4(acc[ai][bj][m][n] * sc); }
            } else if (gcol < 2048 || (gcol >= 2464 && gcol < 2976)) {
                const int c0 = (gcol < 2048 ? gcol - 1536 : gcol - 2464 + 512) + 4 * fq;
#pragma unroll
                for (int ai = 0; ai < 2; ++ai)
#pragma unroll
                    for (int m = 0; m < 4; ++m) { bf16_t* rp = GATE + (size_t)(row0 + ai * 128 + m * 16) * 1024 + c0;
#pragma unroll
                        for (int n = 0; n < 2; ++n) *(u32x2*)(rp + 16 * n) = pk4(silu4(acc[ai][bj][m][n])); }
            } else if (gcol < 2304) {
                const int c0 = gcol - 2048 + 4 * fq;
#pragma unroll
                for (int ai = 0; ai < 2; ++ai)
#pragma unroll
                    for (int m = 0; m < 4; ++m) { bf16_t* rp = QLAT + (size_t)(row0 + ai * 128 + m * 16) * 256 + c0;
#pragma unroll
                        for (int n = 0; n < 2; ++n) *(u32x2*)(rp + 16 * n) = pk4(acc[ai][bj][m][n]); }
            } else if (gcol < 2432) {
                const int c0 = gcol - 2304 + 4 * fq;
#pragma unroll
                for (int ai = 0; ai < 2; ++ai)
#pragma unroll
                    for (int m = 0; m < 4; ++m) { bf16_t* rp = KVLAT + (size_t)(row0 + ai * 128 + m * 16) * 128 + c0;
#pragma unroll
                        for (int n = 0; n < 2; ++n) *(u32x2*)(rp + 16 * n) = pk4(acc[ai][bj][m][n]); }
            } else if (gcol < 2464) {
#pragma unroll
                for (int ai = 0; ai < 2; ++ai)
#pragma unroll
                    for (int m = 0; m < 4; ++m) { const size_t row = (size_t)(row0 + ai * 128 + m * 16);
                        const f32x4 cs = *(const f32x4*)(COS + row * 16 + 4 * fq), sn = *(const f32x4*)(SIN + row * 16 + 4 * fq);
                        const f32x4 t1 = acc[ai][bj][m][0], t2 = acc[ai][bj][m][1];
                        const f32x4 o1 = t1 * cs - t2 * sn, o2 = t2 * cs + t1 * sn;
                        bf16_t* rp = KR + row * 32 + 4 * fq; *(u32x2*)(rp) = pk4(o1); *(u32x2*)(rp + 16) = pk4(o2); if (m & 1) asm volatile("" ::: "memory"); }
            } else if (gcol == 2976) {
                if (fq < 2) {
                    const f32x4 bfv = *(const f32x4*)(BF + 4 * fq);
#pragma unroll
                    for (int ai = 0; ai < 2; ++ai)
#pragma unroll
                        for (int m = 0; m < 4; ++m) { const size_t row = (size_t)(row0 + ai * 128 + m * 16); const f32x4 v = acc[ai][bj][m][0] + bfv;
                            *(f32x4*)(LOGF + row * 8 + 4 * fq) = (f32x4){logsig_f(v[0]), logsig_f(v[1]), logsig_f(v[2]), logsig_f(v[3])}; }
                }
            }
        }
    }
};
struct EpiQ {
    static constexpr bool PERM = false, AFTER_DRAIN = false;
    unsigned char* ws;
    __device__ __forceinline__ void operator()(const f32x4 (&acc)[2][2][4][2], const Unit& u, int wr, int wc, int fr, int fq) const {
        const int row0 = u.pm * 256 + wr * 64 + fr;
        const float* SSQ = (const float*)(ws + WS_SSQQ); const float* COS = (const float*)(ws + WS_COS); const float* SIN = (const float*)(ws + WS_SIN); bf16_t* QM = (bf16_t*)(ws + WS_QM);
        float rs[2][4];
#pragma unroll
        for (int ai = 0; ai < 2; ++ai)
#pragma unroll
            for (int m = 0; m < 4; ++m) { const f32x4 s = *(const f32x4*)(SSQ + (size_t)(row0 + ai * 128 + m * 16) * 4); rs[ai][m] = rsqrtf(((s[0] + s[1]) + (s[2] + s[3])) * (1.f / 256.f) + EPS_) * C2M; }
#pragma unroll
        for (int bj = 0; bj < 2; ++bj) {
            const int gcol = u.pn * 256 + bj * 128 + wc * 32; const bool rope = ((gcol >> 5) % 3) == 2;
#pragma unroll
            for (int ai = 0; ai < 2; ++ai)
#pragma unroll
                for (int m = 0; m < 4; ++m) { const size_t row = (size_t)(row0 + ai * 128 + m * 16);
                    f32x4 v0 = acc[ai][bj][m][0] * rs[ai][m], v1 = acc[ai][bj][m][1] * rs[ai][m];
                    if (rope) { const f32x4 cs = *(const f32x4*)(COS + row * 16 + 4 * fq), sn = *(const f32x4*)(SIN + row * 16 + 4 * fq);
                        const f32x4 o1 = v0 * cs - v1 * sn, o2 = v1 * cs + v0 * sn; v0 = o1; v1 = o2; }
                    bf16_t* rp = QM + row * 768 + gcol + 4 * fq; *(u32x2*)(rp) = pk4(v0); *(u32x2*)(rp + 16) = pk4(v1); if (m & 1) asm volatile("" ::: "memory"); }
        }
    }
};
struct EpiKV {
    static constexpr bool PERM = false, AFTER_DRAIN = false;
    unsigned char* ws;
    __device__ __forceinline__ void operator()(const f32x4 (&acc)[2][2][4][2], const Unit& u, int wr, int wc, int fr, int fq) const {
        const int row0 = u.pm * 256 + wr * 64 + fr;
        const float* SSQ = (const float*)(ws + WS_SSQK); bf16_t* KM = (bf16_t*)(ws + WS_KM);
        float rs[2][4];
#pragma unroll
        for (int ai = 0; ai < 2; ++ai)
#pragma unroll
            for (int m = 0; m < 4; ++m) { const f32x4 s = *(const f32x4*)(SSQ + (size_t)(row0 + ai * 128 + m * 16) * 4); rs[ai][m] = rsqrtf(((s[0] + s[1]) + (s[2] + s[3])) * (1.f / 128.f) + EPS_); }
#pragma unroll
        for (int bj = 0; bj < 2; ++bj) {
            const int gcol = u.pn * 256 + bj * 128 + wc * 32; const int head = gcol >> 7, within = gcol & 127;
            bf16_t* base = KM + (within < 64 ? (size_t)0 : (size_t)((WS_VM - WS_KM) / 2)); const int c0 = head * 64 + (within & 63) + 4 * fq;
#pragma unroll
            for (int ai = 0; ai < 2; ++ai)
#pragma unroll
                for (int m = 0; m < 4; ++m) { bf16_t* rp = base + (size_t)(row0 + ai * 128 + m * 16) * 512 + c0;
#pragma unroll
                    for (int n = 0; n < 2; ++n) *(u32x2*)(rp + 16 * n) = pk4(acc[ai][bj][m][n] * rs[ai][m]); }
        }
    }
};
struct EpiOut {
    static constexpr bool PERM = false, AFTER_DRAIN = false;
    const float* XIN; float* XOUT; const float* MODG;
    __device__ __forceinline__ void operator()(const f32x4 (&acc)[2][2][4][2], const Unit& u, int wr, int wc, int fr, int fq) const {
        const int row0 = u.pm * 256 + wr * 64 + fr; const int b = (u.pm * 256) >> 12;
#pragma unroll
        for (int bj = 0; bj < 2; ++bj)
#pragma unroll
            for (int n = 0; n < 2; ++n) { const int col = u.pn * 256 + bj * 128 + wc * 32 + 16 * n + 4 * fq; const f32x4 g4 = *(const f32x4*)(MODG + (size_t)b * 3072 + col);
#pragma unroll
                for (int ai = 0; ai < 2; ++ai)
#pragma unroll
                    for (int m = 0; m < 4; ++m) { const size_t off = (size_t)(row0 + ai * 128 + m * 16) * 1024 + col; const f32x4 xi = *(const f32x4*)(XIN + off); *(f32x4*)(XOUT + off) = xi + g4 * acc[ai][bj][m][n]; } asm volatile("" ::: "memory"); }
    }
};

__device__ __forceinline__ int crow(int r, int hi) { return (r & 3) + 8 * (r >> 2) + 4 * hi; }
__device__ __forceinline__ bf16x8 vtr2(const LAS unsigned char* p) {
    const v4i16_t lo = __builtin_amdgcn_ds_read_tr16_b64_v4i16((LAS v4i16_t*)p), hi = __builtin_amdgcn_ds_read_tr16_b64_v4i16((LAS v4i16_t*)(p + 512));
    return (bf16x8){lo[0], lo[1], lo[2], lo[3], hi[0], hi[1], hi[2], hi[3]};
}
typedef float f32x2_t __attribute__((ext_vector_type(2))); typedef __bf16 bf16x2_t __attribute__((ext_vector_type(2)));
__device__ __forceinline__ unsigned cvtpk_s(float lo, float hi) { f32x2_t v = {lo, hi}; bf16x2_t b = __builtin_convertvector(v, bf16x2_t); return __builtin_bit_cast(unsigned, b); }
constexpr int AT_KBUF = 13312, AT_OFF_V = 2 * AT_KBUF, AT_OFF_CK = AT_OFF_V + 2 * 8192, AT_OFF_WS = AT_OFF_CK + 512;

template <bool MLA>
__device__ __forceinline__ void attn_unit(LAS unsigned char* lds, int b, int h, int qb, unsigned char* ws, int wave_s) {
    constexpr int DQK = MLA ? 96 : 64, NDS = DQK / 16, KROW = MLA ? 208 : 144, QP = MLA ? 768 : 512;
    const bf16_t* Q = (const bf16_t*)(ws + (MLA ? WS_QM : WS_QF)); const bf16_t* K = (const bf16_t*)(ws + (MLA ? WS_KM : WS_KF)); const bf16_t* V = (const bf16_t*)(ws + (MLA ? WS_VM : WS_VF));
    const bf16_t* KRp = (const bf16_t*)(ws + WS_KR); const float* CUM = (const float*)(ws + WS_CUM); const bf16_t* GATE = (const bf16_t*)(ws + WS_GATE); bf16_t* Y = (bf16_t*)(ws + WS_H);
    const int tid = otid(wave_s), lane = tid & 63, r32 = lane & 31, hi = lane >> 5; const int wid = __builtin_amdgcn_readfirstlane(tid >> 6);
    const int q0 = qb * 256, qw0 = q0 + wid * 32; const size_t rowbase = (size_t)b * SEQ;
    const int NT = q0 / 64 + 4;
    bf16x8 qr[NDS];
    { const bf16_t* qp = Q + (rowbase + qw0 + r32) * QP + h * DQK + hi * 8;
#pragma unroll
      for (int ds = 0; ds < NDS; ++ds) qr[ds] = *(const bf16x8*)(qp + ds * 16); }
    float cq = 0.f; if (!MLA) cq = CUM[(size_t)(b * 8 + h) * SEQ + qw0 + r32];
    const int krow = tid >> 3, kch = tid & 7;
    const bf16_t* kg = K + (rowbase + krow) * 512 + h * 64 + kch * 8; const int kdst = krow * KROW + kch * 16;
    const bf16_t* krg = KRp + (rowbase + (tid >> 2)) * 32 + (tid & 3) * 8; const int krdst = (tid >> 2) * KROW + 128 + (tid & 3) * 16;
    const int vdh = tid >> 8, vrow = (tid >> 2) & 63, vc4 = tid & 3;
    const bf16_t* vg = V + (rowbase + vrow) * 512 + h * 64 + vdh * 32 + vc4 * 8; const int vdst = AT_OFF_V + vdh * 4096 + vrow * 64 + vc4 * 16;
    const float* ckg = CUM + (size_t)(b * 8 + h) * SEQ + (tid & 63);
    u32x4 kreg, krreg = (u32x4){0u, 0u, 0u, 0u}, vreg; float ckreg = 0.f;
#define AT_LOAD(t) do { kreg = *(const u32x4*)(kg + (size_t)(t) * 64 * 512); vreg = *(const u32x4*)(vg + (size_t)(t) * 64 * 512); \
        if (MLA) { if (tid < 256) krreg = *(const u32x4*)(krg + (size_t)(t) * 64 * 32); } else { if (tid < 64) ckreg = ckg[(t) * 64]; } } while (0)
#define AT_STORE(bf) do { *(LAS u32x4*)(lds + (bf) * AT_KBUF + kdst) = kreg; *(LAS u32x4*)(lds + (bf) * 8192 + vdst) = vreg; \
        if (MLA) { if (tid < 256) *(LAS u32x4*)(lds + (bf) * AT_KBUF + krdst) = krreg; } else { if (tid < 64) *(LAS float*)(lds + AT_OFF_CK + (bf) * 256 + tid * 4) = ckreg; } } while (0)
    __syncthreads();
    AT_LOAD(0); AT_STORE(0);
    __syncthreads();
    float mhat = -1e30f, lsum = 0.f; f32x16 o0 = {}, o1 = {};
    LAS float* wsf = (LAS float*)(lds + AT_OFF_WS) + wid * 64;
    const int vb = AT_OFF_V + ((lane >> 4) & 1) * 32 + (lane & 3) * 8 + (4 * hi + ((lane & 15) >> 2)) * 64;
    for (int t = 0; t < NT; ++t) {
        const int buf = t & 1;
        if (t + 1 < NT) AT_LOAD(t + 1);
        const int ks = t * 64;
        if (ks <= qw0) {
            f32x16 p0, p1;
            if (!MLA) {
#pragma unroll
                for (int g = 0; g < 4; ++g) { const f32x4 c0 = *(const LAS f32x4*)(lds + AT_OFF_CK + buf * 256 + (8 * g + 4 * hi) * 4), c1 = *(const LAS f32x4*)(lds + AT_OFF_CK + buf * 256 + (32 + 8 * g + 4 * hi) * 4);
#pragma unroll
                    for (int e = 0; e < 4; ++e) { p0[4 * g + e] = cq - c0[e]; p1[4 * g + e] = cq - c1[e]; } }
            } else { p0 = (f32x16){}; p1 = (f32x16){}; }
            const LAS unsigned char* kb = lds + buf * AT_KBUF + r32 * KROW + hi * 16;
#pragma unroll
            for (int ds = 0; ds < NDS; ++ds) {
                const bf16x8 kf0 = *(const LAS bf16x8*)(kb + ds * 32), kf1 = *(const LAS bf16x8*)(kb + 32 * KROW + ds * 32);
                p0 = __builtin_amdgcn_mfma_f32_32x32x16_bf16(kf0, qr[ds], p0, 0, 0, 0);
                p1 = __builtin_amdgcn_mfma_f32_32x32x16_bf16(kf1, qr[ds], p1, 0, 0, 0);
            }
            if (!MLA && ks + 63 > qw0) {
                const int q = qw0 + r32;
#pragma unroll
                for (int r = 0; r < 16; ++r) { const int kv = ks + crow(r, hi); if (kv > q) p0[r] = -INFINITY; if (kv + 32 > q) p1[r] = -INFINITY; }
            }
            float rm = fmaxf(p0[0], p1[0]);
#pragma unroll
            for (int r = 1; r < 16; ++r) rm = fmaxf(rm, fmaxf(p0[r], p1[r]));
            rm = fmaxf(rm, shx(rm, 32, lane));
            if (__any(rm > mhat + 8.f)) {
                const float mnew = fmaxf(mhat, rm), alpha = __builtin_amdgcn_exp2f(mhat - mnew);
                lsum *= alpha; mhat = mnew;
                if (hi == 0) wsf[r32] = alpha;
                LDS_WAIT();
#pragma unroll
                for (int g = 0; g < 4; ++g) { const f32x4 a = *(const LAS f32x4*)(wsf + 8 * g + 4 * hi);
#pragma unroll
                    for (int e = 0; e < 4; ++e) { o0[4 * g + e] *= a[e]; o1[4 * g + e] *= a[e]; } }
                LDS_WAIT();
            }
            float sacc = 0.f;
#pragma unroll
            for (int r = 0; r < 16; ++r) { p0[r] = __builtin_amdgcn_exp2f(p0[r] - mhat); p1[r] = __builtin_amdgcn_exp2f(p1[r] - mhat); sacc += p0[r] + p1[r]; }
            lsum += sacc;
            u32x4 pw[4];
#pragma unroll
            for (int s = 0; s < 2; ++s) {
                pw[s]     = (u32x4){cvtpk_s(p0[8 * s], p0[8 * s + 1]), cvtpk_s(p0[8 * s + 2], p0[8 * s + 3]), cvtpk_s(p0[8 * s + 4], p0[8 * s + 5]), cvtpk_s(p0[8 * s + 6], p0[8 * s + 7])};
                pw[2 + s] = (u32x4){cvtpk_s(p1[8 * s], p1[8 * s + 1]), cvtpk_s(p1[8 * s + 2], p1[8 * s + 3]), cvtpk_s(p1[8 * s + 4], p1[8 * s + 5]), cvtpk_s(p1[8 * s + 6], p1[8 * s + 7])};
            }
            const LAS unsigned char* vp = lds + vb + buf * 8192;
#pragma unroll
            for (int s = 0; s < 4; ++s) {
                const bf16x8 pa = __builtin_bit_cast(bf16x8, pw[s]);
                const bf16x8 v0 = vtr2(vp + s * 1024), v1 = vtr2(vp + 4096 + s * 1024);
                o0 = __builtin_amdgcn_mfma_f32_32x32x16_bf16(pa, v0, o0, 0, 0, 0);
                o1 = __builtin_amdgcn_mfma_f32_32x32x16_bf16(pa, v1, o1, 0, 0, 0);
            }
        }
        if (t + 1 < NT) AT_STORE(buf ^ 1);
        __syncthreads();
    }
#undef AT_LOAD
#undef AT_STORE
    const float lt = lsum + shx(lsum, 32, lane);
    if (hi == 0) wsf[r32] = 1.f / lt;
    LDS_WAIT();
    float rli[16];
#pragma unroll
    for (int g = 0; g < 4; ++g) { const f32x4 a = *(const LAS f32x4*)(wsf + 8 * g + 4 * hi);
#pragma unroll
        for (int e = 0; e < 4; ++e) rli[4 * g + e] = a[e]; }
    LDS_WAIT();
    const int cb = (MLA ? 512 : 0) + h * 64 + r32;
#pragma unroll
    for (int r = 0; r < 16; ++r) { const size_t off = (rowbase + qw0 + crow(r, hi)) * 1024 + cb;
        const float g0 = bf2f(GATE[off]), g1 = bf2f(GATE[off + 32]);
        Y[off] = (bf16_t)f2bf(o0[r] * rli[r] * g0); Y[off + 32] = (bf16_t)f2bf(o1[r] * rli[r] * g1); }
}

template <int MODE>
__device__ __forceinline__ void transpose_item(const float* __restrict__ W, int K, int Nsrc, int Ndst, bf16_t* __restrict__ WT, const float* __restrict__ kscale, LAS float* scr, int item, int lane) {
    const int nblk = Ndst / 32, kb = item / nblk, nb = item % nblk, k0 = 64 * kb, n0 = 32 * nb;
    const int nd = n0 + (lane & 31); int ns = nd; bool valid = true;
    if (MODE == 1) { if (nd < 1536) ns = nd; else if (nd < 2976) ns = nd + 8; else if (nd < 2984) ns = nd - 1440; else { ns = 0; valid = false; } }
#pragma unroll 8
    for (int i = 0; i < 32; ++i) { const int kk = 2 * i + (lane >> 5); float v = valid ? W[(size_t)(k0 + kk) * Nsrc + ns] : 0.f; if (kscale) v *= kscale[k0 + kk]; scr[kk * 33 + (lane & 31)] = v; }
    LDS_WAIT();
    const int c = lane & 7;
#pragma unroll
    for (int j = 0; j < 4; ++j) { const int n = (lane >> 3) + 8 * j; const LAS float* s = scr + (8 * c) * 33 + n;
        u32x4 o; o.x = pk2(s[0 * 33], s[1 * 33]); o.y = pk2(s[2 * 33], s[3 * 33]); o.z = pk2(s[4 * 33], s[5 * 33]); o.w = pk2(s[6 * 33], s[7 * 33]);
        *(u32x4*)(WT + (size_t)(n0 + n) * K + k0 + 8 * c) = o; }
    LDS_WAIT();
}

struct Args { const void* in[14]; float* out; unsigned char* ws; };

__global__ void __launch_bounds__(512) mk_fwd(Args args) {
    extern __shared__ __attribute__((aligned(16))) unsigned char smem[];
    LAS unsigned char* lds = (LAS unsigned char*)smem;
    cg::grid_group grid = cg::this_grid();
    const int wave_s = __builtin_amdgcn_readfirstlane((int)threadIdx.x >> 6);
    const int G = gridDim.x, bx = blockIdx.x, NGW = G * 8;
    unsigned char* ws = args.ws; float* X = args.out;
    float* MOD = (float*)(ws + WS_MOD);
    unsigned* bar = (unsigned*)ws;
    volatile LAS unsigned* bst = (volatile LAS unsigned*)(lds + 131072);
    { const int t0 = otid(wave_s); if (t0 < 2) bst[t0] = 0u; __syncthreads(); if (t0 == 0) (void)xb_add(&bar[XB_XCNT(xb_xcc_id())], 1u); }
#define GRID_BAR() xcd_barrier(bar, bst, otid(wave_s))

    {
        const int tid = otid(wave_s), lane = tid & 63; const int wave = __builtin_amdgcn_readfirstlane(tid >> 6); const int gw = bx * 8 + wave;
        const float* c_in = (const float*)args.in[1]; const int* pos_in = (const int*)args.in[2];
        const float* w_ada = (const float*)args.in[4]; const float* b_ada = (const float*)args.in[5];
        const float* w_in = (const float*)args.in[6]; const float* q_norm_g = (const float*)args.in[8];
        const float* w_uq = (const float*)args.in[9]; const float* kv_norm_g = (const float*)args.in[10]; const float* w_ukv = (const float*)args.in[11];
        const float* w_out = (const float*)args.in[12];
        bf16_t* WIN = (bf16_t*)(ws + WS_WIN); bf16_t* WOUT = (bf16_t*)(ws + WS_WOUT); bf16_t* WUQ = (bf16_t*)(ws + WS_WUQ); bf16_t* WUKV = (bf16_t*)(ws + WS_WUKV);
        float* COS = (float*)(ws + WS_COS); float* SIN = (float*)(ws + WS_SIN);
        for (int unit = bx; unit < DEPTH * 48; unit += G) {
            LAS float* cact = (LAS float*)lds; LAS float* red = (LAS float*)(lds + 32768);
            const int l = unit / 48, n = (unit % 48) * 64 + lane;
            for (int i = tid; i < NB * DM; i += 512) cact[i] = silu_f(c_in[i]);
            __syncthreads();
            float a[8];
#pragma unroll
            for (int b = 0; b < 8; ++b) a[b] = 0.f;
            const float* wp = w_ada + ((size_t)l * DM + 128 * wave) * 3072 + n;
#pragma unroll 4
            for (int kk = 0; kk < 128; ++kk) { const float wv = wp[(size_t)kk * 3072];
#pragma unroll
                for (int b = 0; b < 8; ++b) a[b] += cact[b * DM + 128 * wave + kk] * wv; }
#pragma unroll
            for (int b = 0; b < 8; ++b) red[(wave * 8 + b) * 64 + lane] = a[b];
            __syncthreads();
            { float s = b_ada[l * 3072 + n];
#pragma unroll
              for (int w2 = 0; w2 < 8; ++w2) s += red[(w2 * 8 + wave) * 64 + lane];
              MOD[(size_t)(l * 8 + wave) * 3072 + n] = s; }
            __syncthreads();
        }
        { LAS float* scr = (LAS float*)(lds + 49152) + wave * (64 * 33);
          constexpr int I_IN = 16 * 96, I_OUT = 16 * 32, I_UQ = 4 * 24, I_UKV = 2 * 32, I_L = I_IN + I_OUT + I_UQ + I_UKV;
          for (int it = gw; it < DEPTH * I_L; it += NGW) {
              const int l = it / I_L; int r = it % I_L;
              if (r < I_IN) { transpose_item<1>(w_in + (size_t)l * DM * NIN, DM, NIN, NINP, WIN + (size_t)l * NINP * DM, nullptr, scr, r, lane); continue; } r -= I_IN;
              if (r < I_OUT) { transpose_item<0>(w_out + (size_t)l * DM * DM, DM, DM, DM, WOUT + (size_t)l * DM * DM, nullptr, scr, r, lane); continue; } r -= I_OUT;
              if (r < I_UQ) { transpose_item<0>(w_uq + (size_t)l * 256 * 768, 256, 768, 768, WUQ + (size_t)l * 768 * 256, q_norm_g + l * 256, scr, r, lane); continue; } r -= I_UQ;
              transpose_item<0>(w_ukv + (size_t)l * 128 * 1024, 128, 1024, 1024, WUKV + (size_t)l * 1024 * 128, kv_norm_g + l * 128, scr, r, lane);
          } }
        for (int idx = bx * 512 + tid; idx < MTOK * 16; idx += G * 512) {
            const int tok = idx >> 4, i = idx & 15;
            const float inv = 1.0f / powf(10000.0f, (float)(2 * i) * (1.0f / 32.0f));
            const float ang = (float)pos_in[tok] * inv; float sn, cs; sincosf(ang, &sn, &cs);
            COS[idx] = cs; SIN[idx] = sn;
        }
    }

    grid.sync();
    for (int l = 0; l <= DEPTH; ++l) {
        if (l > 0) GRID_BAR();
        {
            const int tid = otid(wave_s), lane = tid & 63; const int wave = __builtin_amdgcn_readfirstlane(tid >> 6); const int gw = bx * 8 + wave;
            const bool fin = (l == DEPTH);
            const float* xs = (l == 0) ? (const float*)args.in[0] : X; const float* gsrc = fin ? (const float*)args.in[13] : (const float*)args.in[3] + l * DM;
            bf16_t* H = (bf16_t*)(ws + WS_H);
            for (int r0 = gw * 16; r0 < MTOK; r0 += NGW * 16) {
                const int b = r0 >> 12;
                f32x4 gs[4], sh[4];
#pragma unroll
                for (int j = 0; j < 4; ++j) { const int col = 4 * lane + 256 * j; const f32x4 g = *(const f32x4*)(gsrc + col);
                    if (fin) { gs[j] = g; sh[j] = (f32x4){0.f, 0.f, 0.f, 0.f}; }
                    else { const f32x4 sc = *(const f32x4*)(MOD + (size_t)(l * 8 + b) * 3072 + 1024 + col); gs[j] = g * (sc + 1.0f); sh[j] = *(const f32x4*)(MOD + (size_t)(l * 8 + b) * 3072 + col); } }
                for (int rr = 0; rr < 16; ++rr) {
                    const size_t row = (size_t)(r0 + rr);
                    f32x4 v[4]; float ss = 0.f;
#pragma unroll
                    for (int j = 0; j < 4; ++j) { v[j] = *(const f32x4*)(xs + row * DM + 4 * lane + 256 * j); ss += (v[j][0] * v[j][0] + v[j][1] * v[j][1]) + (v[j][2] * v[j][2] + v[j][3] * v[j][3]); }
                    const float rstd = rsqrtf(wave_sum(ss, lane) * (1.f / DM) + EPS_);
                    if (fin) {
#pragma unroll
                        for (int j = 0; j < 4; ++j) *(f32x4*)(X + row * DM + 4 * lane + 256 * j) = v[j] * rstd * gs[j];
                    } else {
#pragma unroll
                        for (int j = 0; j < 4; ++j) *(u32x2*)(H + row * DM + 4 * lane + 256 * j) = pk4(v[j] * rstd * gs[j] + sh[j]);
                    }
                }
            }
        }
        if (l == DEPTH) break;
        GRID_BAR();
        {
            pg8::Gemm g{(const bf16_t*)(ws + WS_H), (const bf16_t*)(ws + WS_WIN) + (size_t)l * NINP * DM, MTOK, NINP, DM}; pg8::StaticOrder S; S.init(MTOK, NINP, G, bx);
            EpiIn E{ws, (const float*)args.in[7] + l * 8};
            pg8::gemm_phase<EpiIn, pg8::StaticOrder, true, true>(lds, g, S, E, wave_s);
        }
        GRID_BAR();
        {
            const int tid = otid(wave_s), lane = tid & 63; const int wave = __builtin_amdgcn_readfirstlane(tid >> 6);
            const float* LOGF = (const float*)(ws + WS_LOGF); float* CUM = (float*)(ws + WS_CUM);
            for (int u = bx; u < 64; u += G) {
                LAS float* wsum = (LAS float*)lds;
                const float* lf = LOGF + (size_t)(u >> 3) * SEQ * 8 + (u & 7);
                float v[8]; float s = 0.f;
#pragma unroll
                for (int i = 0; i < 8; ++i) { s += lf[(size_t)(8 * tid + i) * 8]; v[i] = s; }
                float incl = s;
#pragma unroll
                for (int off = 1; off < 64; off <<= 1) { const float t = shup(incl, off, lane); if (lane >= off) incl += t; }
                if (lane == 63) wsum[wave] = incl;
                __syncthreads();
                float base = 0.f;
                for (int w2 = 0; w2 < wave; ++w2) base += wsum[w2];
                const float excl = base + incl - s;
#pragma unroll
                for (int i = 0; i < 8; ++i) CUM[(size_t)u * SEQ + 8 * tid + i] = (excl + v[i]) * LOG2E;
                __syncthreads();
            }
        }
        { pg8::Gemm g{(const bf16_t*)(ws + WS_QLAT), (const bf16_t*)(ws + WS_WUQ) + (size_t)l * 768 * 256, MTOK, 768, 256}; pg8::StaticOrder S; S.init(MTOK, 768, G, bx);
          EpiQ E{ws};
          pg8::gemm_phase<EpiQ, pg8::StaticOrder, true, true>(lds, g, S, E, wave_s); }
        __syncthreads();
        { pg8::Gemm g{(const bf16_t*)(ws + WS_KVLAT), (const bf16_t*)(ws + WS_WUKV) + (size_t)l * 1024 * 128, MTOK, 1024, 128}; pg8::StaticOrder S; S.init(MTOK, 1024, G, bx);
          EpiKV E{ws};
          pg8::gemm_phase<EpiKV, pg8::StaticOrder, true, true>(lds, g, S, E, wave_s); }
        GRID_BAR();
        {
            const int vcu = (G % 8 == 0) ? (bx % 8) * (G / 8) + bx / 8 : bx;
            for (int u = vcu; u < 2048; u += G) {
                const int i = u & 255, j = u >> 8; const int bh = i >> 2, s = i & 3, jj = j & 3;
                const int qb = (jj == 0) ? 15 - s : (jj == 1) ? 8 + s : (jj == 2) ? 7 - s : s;
                if (j < 4) attn_unit<true>(lds, bh >> 3, bh & 7, qb, ws, wave_s);
                else attn_unit<false>(lds, bh >> 3, bh & 7, qb, ws, wave_s);
            }
        }
        GRID_BAR();
        {
            pg8::Gemm g{(const bf16_t*)(ws + WS_H), (const bf16_t*)(ws + WS_WOUT) + (size_t)l * DM * DM, MTOK, DM, DM}; pg8::StaticOrder S; S.init(MTOK, DM, G, bx);
            EpiOut E{l == 0 ? (const float*)args.in[0] : X, X, MOD + (size_t)l * 8 * 3072 + 2048};
            pg8::gemm_phase<EpiOut, pg8::StaticOrder, true, true>(lds, g, S, E, wave_s);
        }
    }
}

extern "C" void kernel_launch(void* const* d_in, const int* in_sizes, int n_in, void* d_out, int out_size, void* d_ws, size_t ws_size, hipStream_t stream) {
    static int grid = 0;
    if (grid == 0) {
        if (n_in != 14 || out_size != MTOK * DM || ws_size < WS_END) { fprintf(stderr, "kernel_launch: unexpected shapes (n_in %d, out %d, ws %zu)\n", n_in, out_size, ws_size); grid = -1; return; }
        int dev = 0, cus = 0, per_cu = 0;
        (void)hipGetDevice(&dev); (void)hipDeviceGetAttribute(&cus, hipDeviceAttributeMultiprocessorCount, dev);
        (void)hipFuncSetAttribute((const void*)mk_fwd, hipFuncAttributeMaxDynamicSharedMemorySize, LDS_BYTES);
        if (hipOccupancyMaxActiveBlocksPerMultiprocessor(&per_cu, (const void*)mk_fwd, 512, LDS_BYTES) != hipSuccess || per_cu < 1) per_cu = 1;
        (void)hipGetLastError();
        grid = cus * per_cu;
    }
    if (grid < 0) return;
    (void)hipMemsetAsync(d_ws, 0, 16384, stream);
    Args a{};
    for (int i = 0; i < 14; ++i) a.in[i] = d_in[i];
    a.out = (float*)d_out; a.ws = (unsigned char*)d_ws;
    void* kargs[] = {&a};
    hipError_t e = hipLaunchCooperativeKernel((const void*)mk_fwd, dim3(grid), dim3(512), kargs, LDS_BYTES, stream);
    if (e != hipSuccess) fprintf(stderr, "cooperative launch failed: %s (grid %d)\n", hipGetErrorString(e), grid);
}
```

```cpp
#include <hip/hip_runtime.h>
#include <hip/hip_cooperative_groups.h>
#include <cstdio>
#include <cstdint>
#include <cmath>
namespace cg = cooperative_groups;
__device__ __forceinline__ int otid(int wave_s) { int l; asm volatile("v_mbcnt_lo_u32_b32 %0, -1, 0\n\tv_mbcnt_hi_u32_b32 %0, -1, %0" : "=v"(l)); int w = wave_s; asm volatile("" : "+s"(w)); return (w << 6) | l; }
namespace pg8 {
#define PG8_LAS __attribute__((address_space(3)))
typedef unsigned short bf16_t;
typedef short bf16x8 __attribute__((ext_vector_type(8)));
typedef float f32x4 __attribute__((ext_vector_type(4)));
typedef unsigned u32x4 __attribute__((ext_vector_type(4)));
constexpr int BM = 256, BK = 64, HALF = 128, HTB = HALF * BK * 2  , STAGE_BYTES = 8 * HTB, NXCD = 8, WGM = 8;

__host__ __device__ __forceinline__ int lds_byte(int r, int c) { const int st = (r >> 4) * 2 + (c >> 5), rr = r & 15, cc = c & 31, ob = rr * 64 + cc * 2; return st * 1024 + (ob ^ (((ob >> 9) & 1) << 5)); }
__host__ __device__ __forceinline__ void stage_rc(int b, int& R, int& C) { const int st = b / 1024, sb = b % 1024, swz = sb ^ (((sb >> 9) & 1) << 5); R = (st >> 1) * 16 + swz / 64; C = (st & 1) * 32 + (swz % 64) / 2; }
__host__ __device__ __forceinline__ int perm32(int rho) { const int n = rho >> 4, i = rho & 15; return 8 * (i >> 2) + 4 * n + (i & 3); }

struct Unit { int pm, pn; };
struct Gemm { const bf16_t* A; const bf16_t* Bt; int M, N, K; };

struct StaticOrder {
    int nM, nN, nwg, G, c;
    __host__ __device__ void init(int M, int N, int G_, int c_) { nM = M / BM; nN = N / BM; nwg = nM * nN; G = G_; c = c_; }
    __host__ __device__ bool next(int i, Unit& u) const {
        const long L = (long)i * G + c; if (L >= nwg) return false;
        int wgid = (int)L; { const int q = nwg / NXCD, r = nwg % NXCD, xcd = wgid % NXCD, off = wgid / NXCD; wgid = (xcd < r ? xcd * (q + 1) : r * (q + 1) + (xcd - r) * q) + off; }
        const int nig = WGM * nN, gid = wgid / nig, fm = gid * WGM, gsz = (nM - fm) < WGM ? (nM - fm) : WGM;
        u.pm = fm + ((wgid % nig) % gsz); u.pn = (wgid % nig) / gsz; return true;
    }
    __device__ __forceinline__ void a_ready(const Unit&) const {}
    __device__ __forceinline__ void done(const Unit&) const {}
};

__device__ __forceinline__ unsigned cvt_pk_bf16(float lo, float hi) { unsigned r; asm volatile("v_cvt_pk_bf16_f32 %0, %1, %2" : "=v"(r) : "v"(lo), "v"(hi)); return r; }
template <class Epi, class Sched, bool ALIGN_EPI = false, bool SP2 = false>
__device__ __forceinline__ void gemm_phase(PG8_LAS unsigned char* lds, const Gemm g, const Sched& S, const Epi& E, int wave_s) {
    const int tid = otid(wave_s), wid = __builtin_amdgcn_readfirstlane(tid >> 6), lane = tid & 63, wr = wid >> 2, wc = wid & 3, fr = lane & 15, fq = lane >> 4;
    const int K = g.K, nt = K / BK;
    unsigned voffA[2], voffB[2];
#pragma unroll
    for (int i = 0; i < 2; ++i) { int R, C; stage_rc(tid * 16 + i * 8192, R, C); const int Rb = Epi::PERM ? ((R & ~31) + perm32(R & 31)) : R;
        voffA[i] = (unsigned)(R * K + C) * 2u; voffB[i] = (unsigned)(Rb * K + C) * 2u; }
    const size_t kstep = (size_t)(BK * 2);
    const size_t hstep = (size_t)HALF * K * 2;
    const size_t tstep = 2 * hstep;
    const unsigned ldsw = (unsigned)wid * 1024u;
    const int aoff = lds_byte(wr * 64 + fr, fq * 8), boff = lds_byte(wc * 32 + fr, fq * 8);
#define PG8_SA(b, h) (((b) * 2 + (h)) * HTB)
#define PG8_SB(b, h) ((4 + (b) * 2 + (h)) * HTB)
#define PG8_STAGE(bufoff, gbase, voff) do { _Pragma("unroll") for (int _i = 0; _i < 2; ++_i) \
        __builtin_amdgcn_global_load_lds((const unsigned*)((const char*)(gbase) + (voff)[_i]), (PG8_LAS unsigned*)(lds + (bufoff) + ldsw + _i * 8192), 16, 0, 0); } while (0)
#define PG8_LDA(dst, b, h) do { _Pragma("unroll") for (int m = 0; m < 4; ++m) _Pragma("unroll") for (int k = 0; k < 2; ++k) dst[m][k] = *(const PG8_LAS bf16x8*)(lds + PG8_SA(b, h) + aoff + m * 2048 + k * 1024); } while (0)
#define PG8_LDB(dst, b, h) do { _Pragma("unroll") for (int n = 0; n < 2; ++n) _Pragma("unroll") for (int k = 0; k < 2; ++k) dst[n][k] = *(const PG8_LAS bf16x8*)(lds + PG8_SB(b, h) + boff + n * 2048 + k * 1024); } while (0)
#define PG8_MMA(ai, bj, At, Bt) do { __builtin_amdgcn_s_setprio(1); _Pragma("unroll") for (int m = 0; m < 4; ++m) _Pragma("unroll") for (int n = 0; n < 2; ++n) _Pragma("unroll") for (int k = 0; k < 2; ++k) \
        acc[ai][bj][m][n] = __builtin_amdgcn_mfma_f32_16x16x32_bf16(Bt[n][k], At[m][k], acc[ai][bj][m][n], 0, 0, 0); __builtin_amdgcn_s_setprio(0); } while (0)
#define PG8_WAIT_V(n) asm volatile("s_waitcnt vmcnt(" #n ")" ::: "memory")
#define PG8_WAIT_L(n) asm volatile("s_waitcnt lgkmcnt(" #n ")" ::: "memory")
#define PG8_BAR __builtin_amdgcn_s_barrier()
#define PG8_SCHED __builtin_amdgcn_sched_barrier(0)
    Unit cur, nxt; int ui = 0;
    if (!S.next(0, cur)) return;
    f32x4 acc[2][2][4][2];
#pragma unroll
    for (int a = 0; a < 2; ++a)
#pragma unroll
        for (int b = 0; b < 2; ++b)
#pragma unroll
            for (int m = 0; m < 4; ++m)
#pragma unroll
                for (int n = 0; n < 2; ++n) acc[a][b][m][n] = (f32x4){0.f, 0.f, 0.f, 0.f};
    bf16x8 At[4][2], B0[2][2], B1[2][2];
    const char* cA = (const char*)g.A + (size_t)cur.pm * tstep; const char* cB = (const char*)g.Bt + (size_t)cur.pn * tstep;
    S.a_ready(cur);
    if constexpr (SP2) {
        PG8_STAGE(PG8_SB(0, 0), cB, voffB); PG8_STAGE(PG8_SB(0, 1), cB + hstep, voffB); PG8_STAGE(PG8_SA(0, 0), cA, voffA); PG8_STAGE(PG8_SA(0, 1), cA + hstep, voffA);
        if (wr == 1) PG8_BAR;
        PG8_WAIT_V(2); PG8_BAR;
        PG8_STAGE(PG8_SB(1, 0), cB + kstep, voffB); PG8_STAGE(PG8_SA(1, 0), cA + kstep, voffA); PG8_STAGE(PG8_SB(1, 1), cB + hstep + kstep, voffB);
        PG8_WAIT_V(6); PG8_BAR;
    } else {
        PG8_STAGE(PG8_SB(0, 0), cB, voffB); PG8_STAGE(PG8_SA(0, 0), cA, voffA); PG8_STAGE(PG8_SB(0, 1), cB + hstep, voffB); PG8_STAGE(PG8_SA(0, 1), cA + hstep, voffA);
        if (wr == 1) PG8_BAR;
        PG8_WAIT_V(4); PG8_BAR;
        PG8_STAGE(PG8_SB(1, 0), cB + kstep, voffB); PG8_STAGE(PG8_SA(1, 0), cA + kstep, voffA); PG8_STAGE(PG8_SB(1, 1), cB + hstep + kstep, voffB);
        PG8_WAIT_V(6); PG8_BAR;
    }
    for (;;) {
        const bool has_next = S.next(ui + 1, nxt);
        const char* nA = has_next ? (const char*)g.A + (size_t)nxt.pm * tstep : cA; const char* nB = has_next ? (const char*)g.Bt + (size_t)nxt.pn * tstep : cB;
        for (int t = 0; t < nt; t += 2) {
            const bool last = (t == nt - 2);
            const char* a1 = cA + (size_t)(t + 1) * kstep;
            const char* a2 = last ? nA : cA + (size_t)(t + 2) * kstep; const char* b2 = last ? nB : cB + (size_t)(t + 2) * kstep;
            const char* a3 = a2 + kstep; const char* b3 = b2 + kstep;
            if (last && has_next) S.a_ready(nxt);
            if constexpr (SP2) {
            PG8_LDB(B0, 0, 0); PG8_LDB(B1, 0, 1); PG8_SCHED; PG8_LDA(At, 0, 0); PG8_STAGE(PG8_SA(1, 1), a1 + hstep, voffA);
            PG8_WAIT_V(8); PG8_WAIT_L(0); PG8_BAR; PG8_MMA(0, 0, At, B0); PG8_MMA(0, 1, At, B1); PG8_BAR; PG8_SCHED;
            PG8_LDA(At, 0, 1); PG8_STAGE(PG8_SB(0, 0), b2, voffB); PG8_STAGE(PG8_SB(0, 1), b2 + hstep, voffB); PG8_STAGE(PG8_SA(0, 0), a2, voffA);
            PG8_WAIT_V(8); PG8_WAIT_L(0); PG8_BAR; PG8_MMA(1, 0, At, B0); PG8_MMA(1, 1, At, B1); PG8_BAR; PG8_SCHED;
            PG8_LDB(B0, 1, 0); PG8_LDB(B1, 1, 1); PG8_SCHED; PG8_LDA(At, 1, 0); PG8_STAGE(PG8_SA(0, 1), a2 + hstep, voffA);
            PG8_WAIT_V(8); PG8_WAIT_L(0); PG8_BAR; PG8_MMA(0, 0, At, B0); PG8_MMA(0, 1, At, B1); PG8_BAR; PG8_SCHED;
            PG8_LDA(At, 1, 1); PG8_STAGE(PG8_SB(1, 0), b3, voffB); PG8_STAGE(PG8_SB(1, 1), b3 + hstep, voffB); PG8_STAGE(PG8_SA(1, 0), a3, voffA);
            PG8_WAIT_V(8); PG8_WAIT_L(0); PG8_BAR; PG8_MMA(1, 0, At, B0); PG8_MMA(1, 1, At, B1); PG8_BAR; PG8_SCHED;
            } else {
            PG8_LDB(B0, 0, 0); PG8_SCHED; PG8_LDA(At, 0, 0); PG8_STAGE(PG8_SA(1, 1), a1 + hstep, voffA);
            PG8_WAIT_L(8); PG8_BAR; PG8_WAIT_L(0); PG8_MMA(0, 0, At, B0); PG8_BAR; PG8_SCHED;
            PG8_LDB(B1, 0, 1); PG8_STAGE(PG8_SB(0, 0), b2, voffB);
            PG8_BAR; PG8_WAIT_L(0); PG8_MMA(0, 1, At, B1); PG8_BAR;
            PG8_LDA(At, 0, 1); PG8_STAGE(PG8_SA(0, 0), a2, voffA);
            PG8_BAR; PG8_WAIT_L(0); PG8_MMA(1, 0, At, B0); PG8_BAR; PG8_SCHED;
            PG8_STAGE(PG8_SB(0, 1), b2 + hstep, voffB);
            PG8_WAIT_V(6); PG8_BAR; PG8_MMA(1, 1, At, B1); PG8_BAR;
            PG8_LDB(B0, 1, 0); PG8_SCHED; PG8_LDA(At, 1, 0); PG8_STAGE(PG8_SA(0, 1), a2 + hstep, voffA);
            PG8_WAIT_L(8); PG8_BAR; PG8_WAIT_L(0); PG8_MMA(0, 0, At, B0); PG8_BAR; PG8_SCHED;
            PG8_LDB(B1, 1, 1); PG8_STAGE(PG8_SB(1, 0), b3, voffB);
            PG8_BAR; PG8_WAIT_L(0); PG8_MMA(0, 1, At, B1); PG8_BAR;
            PG8_LDA(At, 1, 1); PG8_STAGE(PG8_SA(1, 0), a3, voffA);
            PG8_BAR; PG8_WAIT_L(0); PG8_MMA(1, 0, At, B0); PG8_BAR; PG8_SCHED;
            PG8_STAGE(PG8_SB(1, 1), b3 + hstep, voffB);
            PG8_WAIT_V(6); PG8_BAR; PG8_MMA(1, 1, At, B1); PG8_BAR;
            }
        }
        if constexpr (ALIGN_EPI) { if (wr == 0) PG8_BAR; }
        if constexpr (!Epi::AFTER_DRAIN) { int fr2 = fr, fq2 = fq; asm volatile("" : "+v"(fr2), "+v"(fq2)); E(acc, cur, wr, wc, fr2, fq2); S.done(cur); }
        if (!has_next) break;
#pragma unroll
        for (int a = 0; a < 2; ++a)
#pragma unroll
            for (int b = 0; b < 2; ++b)
#pragma unroll
                for (int m = 0; m < 4; ++m)
#pragma unroll
                    for (int n = 0; n < 2; ++n) acc[a][b][m][n] = (f32x4){0.f, 0.f, 0.f, 0.f};
        cur = nxt; cA = nA; cB = nB; ++ui;
        if constexpr (ALIGN_EPI) { if (wr == 1) PG8_BAR; }
    }
    PG8_WAIT_V(0);
    if constexpr (!ALIGN_EPI) { if (wr == 0) PG8_BAR; }
    PG8_BAR;
    if constexpr (Epi::AFTER_DRAIN) { E.fused(acc, cur, wr, wc, fr, fq, lds, wid, lane); S.done(cur); }
#undef PG8_SA
#undef PG8_SB
#undef PG8_STAGE
#undef PG8_LDA
#undef PG8_LDB
#undef PG8_MMA
#undef PG8_WAIT_V
#undef PG8_WAIT_L
#undef PG8_BAR
#undef PG8_SCHED
}
}

#define LAS __attribute__((address_space(3)))
typedef unsigned short bf16_t;
typedef short bf16x8 __attribute__((ext_vector_type(8)));
typedef float f32x4 __attribute__((ext_vector_type(4)));
typedef float f32x16 __attribute__((ext_vector_type(16)));
typedef unsigned u32x4 __attribute__((ext_vector_type(4)));
typedef unsigned u32x2 __attribute__((ext_vector_type(2)));
typedef short v4i16_t __attribute__((ext_vector_type(4)));

constexpr int NB = 8, SEQ = 4096, DM = 1024, DEPTH = 4, MTOK = NB * SEQ, NIN = 2984, NINP = 3072;
constexpr float EPS_ = 1e-6f, LOG2E = 1.4426950408889634f;
constexpr float C2F = 0.125f * LOG2E;
constexpr float C2M = 0.10206207261596575f * LOG2E;
constexpr int LDS_BYTES = 132096;

constexpr size_t MiB = 1u << 20;
constexpr size_t WS_WIN = 2 * MiB, WS_WOUT = 26 * MiB, WS_WUQ = 34 * MiB, WS_WUKV = 36 * MiB, WS_MOD = 37 * MiB, WS_COS = 38 * MiB, WS_SIN = 40 * MiB,
                 WS_LOGF = 42 * MiB, WS_CUM = 43 * MiB, WS_SSQQ = 44 * MiB, WS_SSQK = 45 * MiB, WS_H = 48 * MiB, WS_QF = 112 * MiB, WS_KF = 144 * MiB,
                 WS_VF = 176 * MiB, WS_GATE = 208 * MiB, WS_QLAT = 272 * MiB, WS_KVLAT = 288 * MiB, WS_KR = 296 * MiB, WS_QM = 298 * MiB, WS_KM = 346 * MiB,
                 WS_VM = 378 * MiB, WS_END = 410 * MiB;

__device__ __forceinline__ unsigned f2bf(float f) { unsigned u = __builtin_bit_cast(unsigned, f); return (u + 0x7fffu + ((u >> 16) & 1u)) >> 16; }
typedef float f32x2_t __attribute__((ext_vector_type(2))); typedef __bf16 bf16x2_t __attribute__((ext_vector_type(2)));
__device__ __forceinline__ unsigned cvtpk_s(float lo, float hi) { f32x2_t v = {lo, hi}; bf16x2_t b = __builtin_convertvector(v, bf16x2_t); return __builtin_bit_cast(unsigned, b); }
__device__ __forceinline__ unsigned pk2(float lo, float hi) { return cvtpk_s(lo, hi); }
__device__ __forceinline__ float bf2f(bf16_t v) { return __builtin_bit_cast(float, (unsigned)v << 16); }
__device__ __forceinline__ u32x2 pk4(f32x4 v) { u32x2 w; w.x = pk2(v[0], v[1]); w.y = pk2(v[2], v[3]); return w; }
__device__ __forceinline__ float silu_f(float v) { return v / (1.f + __expf(-v)); }
__device__ __forceinline__ f32x4 silu4(f32x4 v) { return (f32x4){silu_f(v[0]), silu_f(v[1]), silu_f(v[2]), silu_f(v[3])}; }
__device__ __forceinline__ float logsig_f(float x) { return fminf(x, 0.f) - log1pf(expf(-fabsf(x))); }
__device__ __forceinline__ float shx(float v, int mask, int lane) { return __builtin_bit_cast(float, __builtin_amdgcn_ds_bpermute((lane ^ mask) << 2, __builtin_bit_cast(int, v))); }
__device__ __forceinline__ float shup(float v, int off, int lane) { return __builtin_bit_cast(float, __builtin_amdgcn_ds_bpermute(((lane - off) & 63) << 2, __builtin_bit_cast(int, v))); }
__device__ __forceinline__ float wave_sum(float v, int lane) {
#pragma unroll
    for (int o = 1; o < 64; o <<= 1) v += shx(v, o, lane);
    return v;
}
#define LDS_WAIT() asm volatile("s_waitcnt lgkmcnt(0)" ::: "memory")


#define XB_TMO      128
#define XB_XCNT(j)  (256  + 64 * (j))
#define XB_XSUB(j)  (1280 + 64 * (j))
#define XB_XGEN(j)  (2304 + 64 * (j))
#define XB_TOP      3328
#define XB_TOPGEN   3392
#define XCD_BAR_WORDS 3456
#define XB_SPIN_CAP (1u << 18)
__device__ __forceinline__ unsigned xb_ld(unsigned* p)              { return __hip_atomic_load(p, __ATOMIC_RELAXED, __HIP_MEMORY_SCOPE_AGENT); }
__device__ __forceinline__ unsigned xb_add(unsigned* p, unsigned v) { return __hip_atomic_fetch_add(p, v, __ATOMIC_RELAXED, __HIP_MEMORY_SCOPE_AGENT); }
__device__ __forceinline__ unsigned xb_xcc_id() { return (unsigned)__builtin_amdgcn_s_getreg((3 << 11) | 20) & 0xFu; }
#define XB_SPIN(cond, bar) do { unsigned _sp = 0; while (cond) { __builtin_amdgcn_s_sleep(1); \
    if ((++_sp & 255u) == 0u) { if (xb_ld(&(bar)[XB_TMO])) break; if (_sp > XB_SPIN_CAP) { atomicAdd(&(bar)[XB_TMO], 1u); break; } } } } while (0)
__device__ __forceinline__ void xcd_barrier_complete(unsigned* bar, unsigned x, unsigned& nloc, unsigned& nx) {
    const unsigned G = gridDim.x * gridDim.y * gridDim.z;
    unsigned sum, cnt, mine, sp = 0u;
    for (;;) {
        sum = 0u; cnt = 0u; mine = 0u;
#pragma unroll
        for (unsigned j = 0; j < 16; ++j) { const unsigned c = xb_ld(&bar[XB_XCNT(j)]); sum += c; cnt += (c > 0u) ? 1u : 0u; mine = (j == x) ? c : mine; }
        if (sum == G) break;
        __builtin_amdgcn_s_sleep(1);
        if ((++sp & 255u) == 0u) { if (xb_ld(&bar[XB_TMO])) break; if (sp > XB_SPIN_CAP) { atomicAdd(&bar[XB_TMO], 1u); break; } }
    }
    nloc = mine > 0u ? mine : 1u; nx = cnt > 0u ? cnt : 1u;
}
__device__ __forceinline__ void xcd_barrier(unsigned* bar, volatile LAS unsigned* st, int tid) {
    asm volatile("s_waitcnt vmcnt(0)" ::: "memory");
    __syncthreads();
    if (tid == 0) {
        const unsigned x = xb_xcc_id();
        __builtin_amdgcn_s_waitcnt(0);
        unsigned nloc = st[0], nx = st[1];
        if (nloc == 0u) { xcd_barrier_complete(bar, x, nloc, nx); st[0] = nloc; st[1] = nx; }
        const unsigned old = xb_add(&bar[XB_XSUB(x)], 1u);
        const unsigned gen = old / nloc;
        if (old + 1u == (gen + 1u) * nloc) {
            __builtin_amdgcn_fence(__ATOMIC_RELEASE, "agent");
            asm volatile("s_waitcnt vmcnt(0)" ::: "memory");
            const unsigned og = xb_add(&bar[XB_TOP], 1u);
            const unsigned tg = og / nx;
            if (og + 1u == (tg + 1u) * nx) xb_add(&bar[XB_TOPGEN], 1u);
            else XB_SPIN(xb_ld(&bar[XB_TOPGEN]) == tg, bar);
            __builtin_amdgcn_fence(__ATOMIC_ACQUIRE, "agent");
            xb_add(&bar[XB_XGEN(x)], 1u);
            asm volatile("s_waitcnt vmcnt(0)" ::: "memory");
        } else {
            XB_SPIN(xb_ld(&bar[XB_XGEN(x)]) == gen, bar);
            __builtin_amdgcn_fence(__ATOMIC_ACQUIRE, "agent");
            asm volatile("s_waitcnt vmcnt(0)" ::: "memory");
        }
    }
    __syncthreads();
}

using pg8::Unit;
struct EpiIn {
    static constexpr bool PERM = false, AFTER_DRAIN = false;
    unsigned char* ws; const float* BF;
    __device__ __forceinline__ void operator()(const f32x4 (&acc)[2][2][4][2], const Unit& u, int wr, int wc, int fr, int fq) const {
        const int row0 = u.pm * 256 + wr * 64 + fr;
        bf16_t* QF = (bf16_t*)(ws + WS_QF); bf16_t* GATE = (bf16_t*)(ws + WS_GATE); bf16_t* QLAT = (bf16_t*)(ws + WS_QLAT); bf16_t* KVLAT = (bf16_t*)(ws + WS_KVLAT); bf16_t* KR = (bf16_t*)(ws + WS_KR);
        float* LOGF = (float*)(ws + WS_LOGF); float* SSQQ = (float*)(ws + WS_SSQQ); float* SSQK = (float*)(ws + WS_SSQK); const float* COS = (const float*)(ws + WS_COS); const float* SIN = (const float*)(ws + WS_SIN);
        if (u.pn == 8) {
#pragma unroll
            for (int ai = 0; ai < 2; ++ai)
#pragma unroll
                for (int m = 0; m < 4; ++m) {
                    float s = 0.f;
#pragma unroll
                    for (int bj = 0; bj < 2; ++bj)
#pragma unroll
                        for (int n = 0; n < 2; ++n) { const f32x4 x = acc[ai][bj][m][n]; s += (x[0] * x[0] + x[1] * x[1]) + (x[2] * x[2] + x[3] * x[3]); }
                    s += shx(s, 16, fq * 16 + fr); s += shx(s, 32, fq * 16 + fr);
                    if (fq == 0) SSQQ[(size_t)(row0 + ai * 128 + m * 16) * 4 + wc] = s;
                }
        } else if (u.pn == 9) {
#pragma unroll
            for (int ai = 0; ai < 2; ++ai)
#pragma unroll
                for (int m = 0; m < 4; ++m) {
                    float s = 0.f;
#pragma unroll
                    for (int n = 0; n < 2; ++n) { const f32x4 x = acc[ai][0][m][n]; s += (x[0] * x[0] + x[1] * x[1]) + (x[2] * x[2] + x[3] * x[3]); }
                    s += shx(s, 16, fq * 16 + fr); s += shx(s, 32, fq * 16 + fr);
                    if (fq == 0) SSQK[(size_t)(row0 + ai * 128 + m * 16) * 4 + wc] = s;
                }
        }
#pragma unroll
        for (int bj = 0; bj < 2; ++bj) {
            const int gcol = u.pn * 256 + bj * 128 + wc * 32;
            if (gcol < 1536) {
                const int seg = gcol >> 9; bf16_t* base = QF + (size_t)seg * ((WS_KF - WS_QF) / 2); const float sc = seg == 0 ? C2F : 1.f; const int c0 = (gcol & 511) + 4 * fq;
#pragma unroll
                for (int ai = 0; ai < 2; ++ai)
#pragma unroll
                    for (int m = 0; m < 4; ++m) { bf16_t* rp = base + (size_t)(row0 + ai * 128 + m * 16) * 512 + c0;
#pragma unroll
                        for (int n = 0; n < 2; ++n) *(u32x2*)(rp + 16 * n) = pk4(acc[ai][bj][m][n] * sc); }
            } else if (gcol < 2048 || (gcol >= 2464 && gcol < 2976)) {
                const int c0 = (gcol < 2048 ? gcol - 1536 : gcol - 2464 + 512) + 4 * fq;
#pragma unroll
                for (int ai = 0; ai < 2; ++ai)
#pragma unroll
                    for (int m = 0; m < 4; ++m) { bf16_t* rp = GATE + (size_t)(row0 + ai * 128 + m * 16) * 1024 + c0;
#pragma unroll
                        for (int n = 0; n < 2; ++n) *(u32x2*)(rp + 16 * n) = pk4(silu4(acc[ai][bj][m][n])); }
            } else if (gcol < 2304) {
                const int c0 = gcol - 2048 + 4 * fq;
#pragma unroll
                for (int ai = 0; ai < 2; ++ai)
#pragma unroll
                    for (int m = 0; m < 4; ++m) { bf16_t* rp = QLAT + (size_t)(row0 + ai * 128 + m * 16) * 256 + c0;
#pragma unroll
                        for (int n = 0; n < 2; ++n) *(u32x2*)(rp + 16 * n) = pk4(acc[ai][bj][m][n]); }
            } else if (gcol < 2432) {
                const int c0 = gcol - 2304 + 4 * fq;
#pragma unroll
                for (int ai = 0; ai < 2; ++ai)
#pragma unroll
                    for (int m = 0; m < 4; ++m) { bf16_t* rp = KVLAT + (size_t)(row0 + ai * 128 + m * 16) * 128 + c0;
#pragma unroll
                        for (int n = 0; n < 2; ++n) *(u32x2*)(rp + 16 * n) = pk4(acc[ai][bj][m][n]); }
            } else if (gcol < 2464) {
#pragma unroll
                for (int ai = 0; ai < 2; ++ai)
#pragma unroll
                    for (int m = 0; m < 4; ++m) { const size_t row = (size_t)(row0 + ai * 128 + m * 16);
                        const f32x4 cs = *(const f32x4*)(COS + row * 16 + 4 * fq), sn = *(const f32x4*)(SIN + row * 16 + 4 * fq);
                        const f32x4 t1 = acc[ai][bj][m][0], t2 = acc[ai][bj][m][1];
                        const f32x4 o1 = t1 * cs - t2 * sn, o2 = t2 * cs + t1 * sn;
                        bf16_t* rp = KR + row * 32 + 4 * fq; *(u32x2*)(rp) = pk4(o1); *(u32x2*)(rp + 16) = pk4(o2); if (m & 1) asm volatile("" ::: "memory"); }
            } else if (gcol == 2976) {
                if (fq < 2) {
                    const f32x4 bfv = *(const f32x4*)(BF + 4 * fq);
#pragma unroll
                    for (int ai = 0; ai < 2; ++ai)
#pragma unroll
                        for (int m = 0; m < 4; ++m) { const size_t row = (size_t)(row0 + ai * 128 + m * 16); const f32x4 v = acc[ai][bj][m][0] + bfv;
                            *(f32x4*)(LOGF + row * 8 + 4 * fq) = (f32x4){logsig_f(v[0]), logsig_f(v[1]), logsig_f(v[2]), logsig_f(v[3])}; }
                }
            }
        }
    }
};
struct EpiQ {
    static constexpr bool PERM = false, AFTER_DRAIN = false;
    unsigned char* ws;
    __device__ __forceinline__ void operator()(const f32x4 (&acc)[2][2][4][2], const Unit& u, int wr, int wc, int fr, int fq) const {
        const int row0 = u.pm * 256 + wr * 64 + fr;
        const float* SSQ = (const float*)(ws + WS_SSQQ); const float* COS = (const float*)(ws + WS_COS); const float* SIN = (const float*)(ws + WS_SIN); bf16_t* QM = (bf16_t*)(ws + WS_QM);
        float rs[2][4];
#pragma unroll
        for (int ai = 0; ai < 2; ++ai)
#pragma unroll
            for (int m = 0; m < 4; ++m) { const f32x4 s = *(const f32x4*)(SSQ + (size_t)(row0 + ai * 128 + m * 16) * 4); rs[ai][m] = rsqrtf(((s[0] + s[1]) + (s[2] + s[3])) * (1.f / 256.f) + EPS_) * C2M; }
#pragma unroll
        for (int bj = 0; bj < 2; ++bj) {
            const int gcol = u.pn * 256 + bj * 128 + wc * 32; const bool rope = ((gcol >> 5) % 3) == 2;
#pragma unroll
            for (int ai = 0; ai < 2; ++ai)
#pragma unroll
                for (int m = 0; m < 4; ++m) { const size_t row = (size_t)(row0 + ai * 128 + m * 16);
                    f32x4 v0 = acc[ai][bj][m][0] * rs[ai][m], v1 = acc[ai][bj][m][1] * rs[ai][m];
                    if (rope) { const f32x4 cs = *(const f32x4*)(COS + row * 16 + 4 * fq), sn = *(const f32x4*)(SIN + row * 16 + 4 * fq);
                        const f32x4 o1 = v0 * cs - v1 * sn, o2 = v1 * cs + v0 * sn; v0 = o1; v1 = o2; }
                    bf16_t* rp = QM + row * 768 + gcol + 4 * fq; *(u32x2*)(rp) = pk4(v0); *(u32x2*)(rp + 16) = pk4(v1); if (m & 1) asm volatile("" ::: "memory"); }
        }
    }
};
struct EpiKV {
    static constexpr bool PERM = false, AFTER_DRAIN = false;
    unsigned char* ws;
    __device__ __forceinline__ void operator()(const f32x4 (&acc)[2][2][4][2], const Unit& u, int wr, int wc, int fr, int fq) const {
        const int row0 = u.pm * 256 + wr * 64 + fr;
        const float* SSQ = (const float*)(ws + WS_SSQK); bf16_t* KM = (bf16_t*)(ws + WS_KM);
        float rs[2][4];
#pragma unroll
        for (int ai = 0; ai < 2; ++ai)
#pragma unroll
            for (int m = 0; m < 4; ++m) { const f32x4 s = *(const f32x4*)(SSQ + (size_t)(row0 + ai * 128 + m * 16) * 4); rs[ai][m] = rsqrtf(((s[0] + s[1]) + (s[2] + s[3])) * (1.f / 128.f) + EPS_); }
#pragma unroll
        for (int bj = 0; bj < 2; ++bj) {
            const int gcol = u.pn * 256 + bj * 128 + wc * 32; const int head = gcol >> 7, within = gcol & 127;
            bf16_t* base = KM + (within < 64 ? (size_t)0 : (size_t)((WS_VM - WS_KM) / 2)); const int c0 = head * 64 + (within & 63) + 4 * fq;
#pragma unroll
            for (int ai = 0; ai < 2; ++ai)
#pragma unroll
                for (int m = 0; m < 4; ++m) { bf16_t* rp = base + (size_t)(row0 + ai * 128 + m * 16) * 512 + c0;
#pragma unroll
                    for (int n = 0; n < 2; ++n) *(u32x2*)(rp + 16 * n) = pk4(acc[ai][bj][m][n] * rs[ai][m]); }
        }
    }
};
struct EpiOut {
    static constexpr bool PERM = false, AFTER_DRAIN = false;
    const float* XIN; float* XOUT; const float* MODG;
    __device__ __forceinline__ void operator()(const f32x4 (&acc)[2][2][4][2], const Unit& u, int wr, int wc, int fr, int fq) const {
        const int row0 = u.pm * 256 + wr * 64 + fr; const int b = (u.pm * 256) >> 12;
#pragma unroll
        for (int bj = 0; bj < 2; ++bj)
#pragma unroll
            for (int n = 0; n < 2; ++n) { const int col = u.pn * 256 + bj * 128 + wc * 32 + 16 * n + 4 * fq; const f32x4 g4 = *(const f32x4*)(MODG + (size_t)b * 3072 + col);
#pragma unroll
                for (int ai = 0; ai < 2; ++ai)
#pragma unroll
                    for (int m = 0; m < 4; ++m) { const size_t off = (size_t)(row0 + ai * 128 + m * 16) * 1024 + col; const f32x4 xi = *(const f32x4*)(XIN + off); *(f32x4*)(XOUT + off) = xi + g4 * acc[ai][bj][m][n]; } asm volatile("" ::: "memory"); }
    }
};

__device__ __forceinline__ int crow(int r, int hi) { return (r & 3) + 8 * (r >> 2) + 4 * hi; }
__device__ __forceinline__ bf16x8 vtr2(const LAS unsigned char* p) {
    const v4i16_t lo = __builtin_amdgcn_ds_read_tr16_b64_v4i16((LAS v4i16_t*)p), hi = __builtin_amdgcn_ds_read_tr16_b64_v4i16((LAS v4i16_t*)(p + 512));
    return (bf16x8){lo[0], lo[1], lo[2], lo[3], hi[0], hi[1], hi[2], hi[3]};
}
constexpr int AT_KBUF = 13312, AT_OFF_V = 2 * AT_KBUF, AT_OFF_CK = AT_OFF_V + 2 * 8192, AT_OFF_WS = AT_OFF_CK + 512;

template <bool MLA>
__device__ __forceinline__ void attn_unit(LAS unsigned char* lds, int b, int h, int qb, unsigned char* ws, int wave_s) {
    constexpr int DQK = MLA ? 96 : 64, NDS = DQK / 16, KROW = MLA ? 208 : 144, QP = MLA ? 768 : 512;
    const bf16_t* Q = (const bf16_t*)(ws + (MLA ? WS_QM : WS_QF)); const bf16_t* K = (const bf16_t*)(ws + (MLA ? WS_KM : WS_KF)); const bf16_t* V = (const bf16_t*)(ws + (MLA ? WS_VM : WS_VF));
    const bf16_t* KRp = (const bf16_t*)(ws + WS_KR); const float* CUM = (const float*)(ws + WS_CUM); const bf16_t* GATE = (const bf16_t*)(ws + WS_GATE); bf16_t* Y = (bf16_t*)(ws + WS_H);
    const int tid = otid(wave_s), lane = tid & 63, r32 = lane & 31, hi = lane >> 5; const int wid = __builtin_amdgcn_readfirstlane(tid >> 6);
    const int par = (wid >> 2) & 1;
    const int q0 = qb * 256, qw0 = q0 + wid * 32; const size_t rowbase = (size_t)b * SEQ;
    const int NT = q0 / 64 + 4;
    bf16x8 qr[NDS];
    { const bf16_t* qp = Q + (rowbase + qw0 + r32) * QP + h * DQK + hi * 8;
#pragma unroll
      for (int ds = 0; ds < NDS; ++ds) qr[ds] = *(const bf16x8*)(qp + ds * 16); }
    const int krow = tid >> 3, kch = tid & 7;
    const bf16_t* kg = K + (rowbase + krow) * 512 + h * 64 + kch * 8; const int kdst = krow * KROW + kch * 16;
    const bf16_t* krg = KRp + (rowbase + (tid >> 2)) * 32 + (tid & 3) * 8; const int krdst = (tid >> 2) * KROW + 128 + (tid & 3) * 16;
    const int vdh = tid >> 8, vrow = (tid >> 2) & 63, vc4 = tid & 3;
    const bf16_t* vg = V + (rowbase + vrow) * 512 + h * 64 + vdh * 32 + vc4 * 8; const int vdst = AT_OFF_V + vdh * 4096 + vrow * 64 + vc4 * 16;
    const float* ckg = CUM + (size_t)(b * 8 + h) * SEQ + (tid & 63);
    u32x4 kreg, krreg = (u32x4){0u, 0u, 0u, 0u}, vreg; float ckreg = 0.f;
#define AT_LOADK(t) do { kreg = *(const u32x4*)(kg + (size_t)(t) * 64 * 512); \
        if (MLA) { if (tid < 256) krreg = *(const u32x4*)(krg + (size_t)(t) * 64 * 32); } else { if (tid < 64) ckreg = -ckg[(t) * 64]; } } while (0)
#define AT_STOREK(bf) do { *(LAS u32x4*)(lds + (bf) * AT_KBUF + kdst) = kreg; \
        if (MLA) { if (tid < 256) *(LAS u32x4*)(lds + (bf) * AT_KBUF + krdst) = krreg; } else { if (tid < 64) *(LAS float*)(lds + AT_OFF_CK + (bf) * 256 + tid * 4) = ckreg; } } while (0)
#define AT_LOADV(t) do { vreg = *(const u32x4*)(vg + (size_t)(t) * 64 * 512); } while (0)
#define AT_STOREV(bf) do { *(LAS u32x4*)(lds + (bf) * 8192 + vdst) = vreg; } while (0)
    float mhat = -1e30f, lsum = 0.f; f32x16 o0 = {}, o1 = {};
    const int vb = AT_OFF_V + ((lane >> 4) & 1) * 32 + (lane & 3) * 8 + (4 * hi + ((lane & 15) >> 2)) * 64;
#define AT_QK(P0, P1, t_) do { const int bf_ = (t_) & 1; \
        if (!MLA) { _Pragma("unroll") for (int g = 0; g < 4; ++g) { const f32x4 c0 = *(const LAS f32x4*)(lds + AT_OFF_CK + bf_ * 256 + (8 * g + 4 * hi) * 4), c1 = *(const LAS f32x4*)(lds + AT_OFF_CK + bf_ * 256 + (32 + 8 * g + 4 * hi) * 4); \
                _Pragma("unroll") for (int e = 0; e < 4; ++e) { P0[4 * g + e] = c0[e]; P1[4 * g + e] = c1[e]; } } } \
        else { P0 = (f32x16){}; P1 = (f32x16){}; } \
        const LAS unsigned char* kb_ = lds + bf_ * AT_KBUF + r32 * KROW + hi * 16; \
        _Pragma("unroll") for (int ds = 0; ds < NDS; ++ds) { \
            const bf16x8 kf0 = *(const LAS bf16x8*)(kb_ + ds * 32), kf1 = *(const LAS bf16x8*)(kb_ + 32 * KROW + ds * 32); \
            P0 = __builtin_amdgcn_mfma_f32_32x32x16_bf16(kf0, qr[ds], P0, 0, 0, 0); \
            P1 = __builtin_amdgcn_mfma_f32_32x32x16_bf16(kf1, qr[ds], P1, 0, 0, 0); if (ds & 1) __builtin_amdgcn_sched_barrier(0); } \
        if (!MLA && (t_) * 64 + 63 > qw0) { const int q_ = qw0 + r32; \
            _Pragma("unroll") for (int r = 0; r < 16; ++r) { const int kv = (t_) * 64 + crow(r, hi); if (kv > q_) P0[r] = -INFINITY; if (kv + 32 > q_) P1[r] = -INFINITY; } } } while (0)
#define AT_SMPV(P0, P1, t_) do { const int bf_ = (t_) & 1; \
        float ra = fmaxf(fmaxf(P0[0], P0[1]), P1[0]), rb = fmaxf(fmaxf(P0[2], P0[3]), P1[1]); ra = fmaxf(fmaxf(ra, P1[2]), P1[3]); \
        _Pragma("unroll") for (int r = 4; r < 16; r += 4) { ra = fmaxf(fmaxf(ra, P0[r]), P0[r + 1]); rb = fmaxf(fmaxf(rb, P0[r + 2]), P0[r + 3]); ra = fmaxf(fmaxf(ra, P1[r]), P1[r + 1]); rb = fmaxf(fmaxf(rb, P1[r + 2]), P1[r + 3]); } \
        float rm = fmaxf(ra, rb); { auto rr = __builtin_amdgcn_permlane32_swap(__float_as_uint(rm), __float_as_uint(rm), false, false); rm = fmaxf(__uint_as_float(rr[0]), __uint_as_float(rr[1])); } \
        if (__any(rm > mhat + 16.f)) { \
            const float mnew = fmaxf(mhat, rm), alpha = __builtin_amdgcn_exp2f(mhat - mnew); \
            lsum *= alpha; mhat = mnew; \
            _Pragma("unroll") for (int r = 0; r < 16; ++r) { o0[r] *= alpha; o1[r] *= alpha; } } \
        float sacc = 0.f; \
        _Pragma("unroll") for (int r = 0; r < 16; ++r) { P0[r] = __builtin_amdgcn_exp2f(P0[r] - mhat); P1[r] = __builtin_amdgcn_exp2f(P1[r] - mhat); sacc += P0[r] + P1[r]; } \
        lsum += sacc; \
        u32x4 pw[4]; \
        _Pragma("unroll") for (int s = 0; s < 2; ++s) { \
            pw[s]     = (u32x4){cvtpk_s(P0[8 * s], P0[8 * s + 1]), cvtpk_s(P0[8 * s + 2], P0[8 * s + 3]), cvtpk_s(P0[8 * s + 4], P0[8 * s + 5]), cvtpk_s(P0[8 * s + 6], P0[8 * s + 7])}; \
            pw[2 + s] = (u32x4){cvtpk_s(P1[8 * s], P1[8 * s + 1]), cvtpk_s(P1[8 * s + 2], P1[8 * s + 3]), cvtpk_s(P1[8 * s + 4], P1[8 * s + 5]), cvtpk_s(P1[8 * s + 6], P1[8 * s + 7])}; } \
        const LAS unsigned char* vp_ = lds + vb + bf_ * 8192; \
        __builtin_amdgcn_sched_barrier(0); \
        _Pragma("unroll") for (int s = 0; s < 4; ++s) { \
            const bf16x8 pa = __builtin_bit_cast(bf16x8, pw[s]); \
            const bf16x8 v0 = vtr2(vp_ + s * 1024), v1 = vtr2(vp_ + 4096 + s * 1024); \
            o0 = __builtin_amdgcn_mfma_f32_32x32x16_bf16(v0, pa, o0, 0, 0, 0); \
            o1 = __builtin_amdgcn_mfma_f32_32x32x16_bf16(v1, pa, o1, 0, 0, 0); if (s & 1) __builtin_amdgcn_sched_barrier(0); } } while (0)
#define AT_STEP(PAR, C0, C1, N0, N1, t_) do { \
        if ((t_) + 2 < NT) AT_LOADK((t_) + 2); if ((t_) + 1 < NT) AT_LOADV((t_) + 1); \
        const bool actN_ = ((t_) + 1 < NT) && (((t_) + 1) * 64 <= qw0), actC_ = ((t_) * 64 <= qw0); \
        __builtin_amdgcn_sched_barrier(0); \
        if (PAR == 0) { if (actN_) AT_QK(N0, N1, (t_) + 1); __builtin_amdgcn_sched_barrier(0); if (actC_) AT_SMPV(C0, C1, t_); } \
        else          { if (actC_) AT_SMPV(C0, C1, t_); __builtin_amdgcn_sched_barrier(0); if (actN_) AT_QK(N0, N1, (t_) + 1); } \
        __builtin_amdgcn_sched_barrier(0); \
        if ((t_) + 2 < NT) AT_STOREK((t_) & 1); if ((t_) + 1 < NT) AT_STOREV(((t_) + 1) & 1); \
        __syncthreads(); } while (0)
    f32x16 sa0, sa1, sb0, sb1;
    __syncthreads();
    AT_LOADK(0); AT_LOADV(0); AT_STOREK(0); AT_STOREV(0); AT_LOADK(1); AT_STOREK(1);
    __syncthreads();
    AT_QK(sa0, sa1, 0);
    __syncthreads();
    if (par == 0) {
        for (int t = 0; t < NT; t += 2) { AT_STEP(0, sa0, sa1, sb0, sb1, t); AT_STEP(0, sb0, sb1, sa0, sa1, t + 1); }
    } else {
        for (int t = 0; t < NT; t += 2) { AT_STEP(1, sa0, sa1, sb0, sb1, t); AT_STEP(1, sb0, sb1, sa0, sa1, t + 1); }
    }
#undef AT_LOADK
#undef AT_STOREK
#undef AT_LOADV
#undef AT_STOREV
#undef AT_QK
#undef AT_SMPV
#undef AT_STEP
    float lt; { auto rr = __builtin_amdgcn_permlane32_swap(__float_as_uint(lsum), __float_as_uint(lsum), false, false); lt = __uint_as_float(rr[0]) + __uint_as_float(rr[1]); }
    const float rl = 1.f / lt;
    const size_t ob = (rowbase + qw0 + r32) * 1024 + (MLA ? 512 : 0) + h * 64 + 4 * hi;
#pragma unroll
    for (int g = 0; g < 4; ++g) {
        const u32x2 ga = *(const u32x2*)(GATE + ob + 8 * g), gb = *(const u32x2*)(GATE + ob + 32 + 8 * g);
        f32x4 a = (f32x4){o0[4 * g], o0[4 * g + 1], o0[4 * g + 2], o0[4 * g + 3]} * rl, c = (f32x4){o1[4 * g], o1[4 * g + 1], o1[4 * g + 2], o1[4 * g + 3]} * rl;
        a = a * (f32x4){__builtin_bit_cast(float, ga.x << 16), __builtin_bit_cast(float, ga.x & 0xffff0000u), __builtin_bit_cast(float, ga.y << 16), __builtin_bit_cast(float, ga.y & 0xffff0000u)};
        c = c * (f32x4){__builtin_bit_cast(float, gb.x << 16), __builtin_bit_cast(float, gb.x & 0xffff0000u), __builtin_bit_cast(float, gb.y << 16), __builtin_bit_cast(float, gb.y & 0xffff0000u)};
        *(u32x2*)(Y + ob + 8 * g) = pk4(a); *(u32x2*)(Y + ob + 32 + 8 * g) = pk4(c);
    }
}

template <int MODE>
__device__ __forceinline__ void transpose_item(const float* __restrict__ W, int K, int Nsrc, int Ndst, bf16_t* __restrict__ WT, const float* __restrict__ kscale, LAS float* scr, int item, int lane) {
    const int nblk = Ndst / 32, kb = item / nblk, nb = item % nblk, k0 = 64 * kb, n0 = 32 * nb;
    const int nd = n0 + (lane & 31); int ns = nd; bool valid = true;
    if (MODE == 1) { if (nd < 1536) ns = nd; else if (nd < 2976) ns = nd + 8; else if (nd < 2984) ns = nd - 1440; else { ns = 0; valid = false; } }
#pragma unroll 8
    for (int i = 0; i < 32; ++i) { const int kk = 2 * i + (lane >> 5); float v = valid ? W[(size_t)(k0 + kk) * Nsrc + ns] : 0.f; if (kscale) v *= kscale[k0 + kk]; scr[kk * 33 + (lane & 31)] = v; }
    LDS_WAIT();
    const int c = lane & 7;
#pragma unroll
    for (int j = 0; j < 4; ++j) { const int n = (lane >> 3) + 8 * j; const LAS float* s = scr + (8 * c) * 33 + n;
        u32x4 o; o.x = pk2(s[0 * 33], s[1 * 33]); o.y = pk2(s[2 * 33], s[3 * 33]); o.z = pk2(s[4 * 33], s[5 * 33]); o.w = pk2(s[6 * 33], s[7 * 33]);
        *(u32x4*)(WT + (size_t)(n0 + n) * K + k0 + 8 * c) = o; }
    LDS_WAIT();
}

struct Args { const void* in[14]; float* out; unsigned char* ws; };

__global__ void __launch_bounds__(512) mk_fwd(Args args) {
    extern __shared__ __attribute__((aligned(16))) unsigned char smem[];
    LAS unsigned char* lds = (LAS unsigned char*)smem;
    cg::grid_group grid = cg::this_grid();
    const int wave_s = __builtin_amdgcn_readfirstlane((int)threadIdx.x >> 6);
    const int G = gridDim.x, bx = blockIdx.x, NGW = G * 8;
    unsigned char* ws = args.ws; float* X = args.out;
    float* MOD = (float*)(ws + WS_MOD);
    unsigned* bar = (unsigned*)ws;
    volatile LAS unsigned* bst = (volatile LAS unsigned*)(lds + 131072);
    { const int t0 = otid(wave_s); if (t0 < 2) bst[t0] = 0u; __syncthreads(); if (t0 == 0) (void)xb_add(&bar[XB_XCNT(xb_xcc_id())], 1u); }
#define GRID_BAR() xcd_barrier(bar, bst, otid(wave_s))

    {
        const int tid = otid(wave_s), lane = tid & 63; const int wave = __builtin_amdgcn_readfirstlane(tid >> 6); const int gw = bx * 8 + wave;
        const float* c_in = (const float*)args.in[1]; const int* pos_in = (const int*)args.in[2];
        const float* w_ada = (const float*)args.in[4]; const float* b_ada = (const float*)args.in[5];
        const float* w_in = (const float*)args.in[6]; const float* q_norm_g = (const float*)args.in[8];
        const float* w_uq = (const float*)args.in[9]; const float* kv_norm_g = (const float*)args.in[10]; const float* w_ukv = (const float*)args.in[11];
        const float* w_out = (const float*)args.in[12];
        bf16_t* WIN = (bf16_t*)(ws + WS_WIN); bf16_t* WOUT = (bf16_t*)(ws + WS_WOUT); bf16_t* WUQ = (bf16_t*)(ws + WS_WUQ); bf16_t* WUKV = (bf16_t*)(ws + WS_WUKV);
        float* COS = (float*)(ws + WS_COS); float* SIN = (float*)(ws + WS_SIN);
        for (int unit = bx; unit < DEPTH * 48; unit += G) {
            LAS float* cact = (LAS float*)lds; LAS float* red = (LAS float*)(lds + 32768);
            const int l = unit / 48, n = (unit % 48) * 64 + lane;
            for (int i = tid; i < NB * DM; i += 512) cact[i] = silu_f(c_in[i]);
            __syncthreads();
            float a[8];
#pragma unroll
            for (int b = 0; b < 8; ++b) a[b] = 0.f;
            const float* wp = w_ada + ((size_t)l * DM + 128 * wave) * 3072 + n;
#pragma unroll 4
            for (int kk = 0; kk < 128; ++kk) { const float wv = wp[(size_t)kk * 3072];
#pragma unroll
                for (int b = 0; b < 8; ++b) a[b] += cact[b * DM + 128 * wave + kk] * wv; }
#pragma unroll
            for (int b = 0; b < 8; ++b) red[(wave * 8 + b) * 64 + lane] = a[b];
            __syncthreads();
            { float s = b_ada[l * 3072 + n];
#pragma unroll
              for (int w2 = 0; w2 < 8; ++w2) s += red[(w2 * 8 + wave) * 64 + lane];
              MOD[(size_t)(l * 8 + wave) * 3072 + n] = s; }
            __syncthreads();
        }
        { LAS float* scr = (LAS float*)(lds + 49152) + wave * (64 * 33);
          constexpr int I_IN = 16 * 96, I_OUT = 16 * 32, I_UQ = 4 * 24, I_UKV = 2 * 32, I_L = I_IN + I_OUT + I_UQ + I_UKV;
          for (int it = gw; it < DEPTH * I_L; it += NGW) {
              const int l = it / I_L; int r = it % I_L;
              if (r < I_IN) { transpose_item<1>(w_in + (size_t)l * DM * NIN, DM, NIN, NINP, WIN + (size_t)l * NINP * DM, nullptr, scr, r, lane); continue; } r -= I_IN;
              if (r < I_OUT) { transpose_item<0>(w_out + (size_t)l * DM * DM, DM, DM, DM, WOUT + (size_t)l * DM * DM, nullptr, scr, r, lane); continue; } r -= I_OUT;
              if (r < I_UQ) { transpose_item<0>(w_uq + (size_t)l * 256 * 768, 256, 768, 768, WUQ + (size_t)l * 768 * 256, q_norm_g + l * 256, scr, r, lane); continue; } r -= I_UQ;
              transpose_item<0>(w_ukv + (size_t)l * 128 * 1024, 128, 1024, 1024, WUKV + (size_t)l * 1024 * 128, kv_norm_g + l * 128, scr, r, lane);
          } }
        for (int idx = bx * 512 + tid; idx < MTOK * 16; idx += G * 512) {
            const int tok = idx >> 4, i = idx & 15;
            const float inv = 1.0f / powf(10000.0f, (float)(2 * i) * (1.0f / 32.0f));
            const float ang = (float)pos_in[tok] * inv; float sn, cs; sincosf(ang, &sn, &cs);
            COS[idx] = cs; SIN[idx] = sn;
        }
    }

    grid.sync();
    for (int l = 0; l <= DEPTH; ++l) {
        if (l > 0) GRID_BAR();
        {
            const int tid = otid(wave_s), lane = tid & 63; const int wave = __builtin_amdgcn_readfirstlane(tid >> 6); const int gw = bx * 8 + wave;
            const bool fin = (l == DEPTH);
            const float* xs = (l == 0) ? (const float*)args.in[0] : X; const float* gsrc = fin ? (const float*)args.in[13] : (const float*)args.in[3] + l * DM;
            bf16_t* H = (bf16_t*)(ws + WS_H);
            for (int r0 = gw * 16; r0 < MTOK; r0 += NGW * 16) {
                const int b = r0 >> 12;
                f32x4 gs[4], sh[4];
#pragma unroll
                for (int j = 0; j < 4; ++j) { const int col = 4 * lane + 256 * j; const f32x4 g = *(const f32x4*)(gsrc + col);
                    if (fin) { gs[j] = g; sh[j] = (f32x4){0.f, 0.f, 0.f, 0.f}; }
                    else { const f32x4 sc = *(const f32x4*)(MOD + (size_t)(l * 8 + b) * 3072 + 1024 + col); gs[j] = g * (sc + 1.0f); sh[j] = *(const f32x4*)(MOD + (size_t)(l * 8 + b) * 3072 + col); } }
                for (int rr = 0; rr < 16; ++rr) {
                    const size_t row = (size_t)(r0 + rr);
                    f32x4 v[4]; float ss = 0.f;
#pragma unroll
                    for (int j = 0; j < 4; ++j) { v[j] = *(const f32x4*)(xs + row * DM + 4 * lane + 256 * j); ss += (v[j][0] * v[j][0] + v[j][1] * v[j][1]) + (v[j][2] * v[j][2] + v[j][3] * v[j][3]); }
                    const float rstd = rsqrtf(wave_sum(ss, lane) * (1.f / DM) + EPS_);
                    if (fin) {
#pragma unroll
                        for (int j = 0; j < 4; ++j) *(f32x4*)(X + row * DM + 4 * lane + 256 * j) = v[j] * rstd * gs[j];
                    } else {
#pragma unroll
                        for (int j = 0; j < 4; ++j) *(u32x2*)(H + row * DM + 4 * lane + 256 * j) = pk4(v[j] * rstd * gs[j] + sh[j]);
                    }
                }
            }
        }
        if (l == DEPTH) break;
        GRID_BAR();
        {
            pg8::Gemm g{(const bf16_t*)(ws + WS_H), (const bf16_t*)(ws + WS_WIN) + (size_t)l * NINP * DM, MTOK, NINP, DM}; pg8::StaticOrder S; S.init(MTOK, NINP, G, bx);
            EpiIn E{ws, (const float*)args.in[7] + l * 8};
            pg8::gemm_phase<EpiIn, pg8::StaticOrder, true, true>(lds, g, S, E, wave_s);
        }
        GRID_BAR();
        {
            const int tid = otid(wave_s), lane = tid & 63; const int wave = __builtin_amdgcn_readfirstlane(tid >> 6);
            const float* LOGF = (const float*)(ws + WS_LOGF); float* CUM = (float*)(ws + WS_CUM);
            for (int u = bx; u < 64; u += G) {
                LAS float* wsum = (LAS float*)lds;
                const float* lf = LOGF + (size_t)(u >> 3) * SEQ * 8 + (u & 7);
                float v[8]; float s = 0.f;
#pragma unroll
                for (int i = 0; i < 8; ++i) { s += lf[(size_t)(8 * tid + i) * 8]; v[i] = s; }
                float incl = s;
#pragma unroll
                for (int off = 1; off < 64; off <<= 1) { const float t = shup(incl, off, lane); if (lane >= off) incl += t; }
                if (lane == 63) wsum[wave] = incl;
                __syncthreads();
                float base = 0.f;
                for (int w2 = 0; w2 < wave; ++w2) base += wsum[w2];
                const float excl = base + incl - s;
#pragma unroll
                for (int i = 0; i < 8; ++i) CUM[(size_t)u * SEQ + 8 * tid + i] = (excl + v[i]) * LOG2E;
                __syncthreads();
            }
        }
        { pg8::Gemm g{(const bf16_t*)(ws + WS_QLAT), (const bf16_t*)(ws + WS_WUQ) + (size_t)l * 768 * 256, MTOK, 768, 256}; pg8::StaticOrder S; S.init(MTOK, 768, G, bx);
          EpiQ E{ws};
          pg8::gemm_phase<EpiQ, pg8::StaticOrder, true, true>(lds, g, S, E, wave_s); }
        __syncthreads();
        { pg8::Gemm g{(const bf16_t*)(ws + WS_KVLAT), (const bf16_t*)(ws + WS_WUKV) + (size_t)l * 1024 * 128, MTOK, 1024, 128}; pg8::StaticOrder S; S.init(MTOK, 1024, G, bx);
          EpiKV E{ws};
          pg8::gemm_phase<EpiKV, pg8::StaticOrder, true, true>(lds, g, S, E, wave_s); }
        GRID_BAR();
        {
            const int vcu = (G % 8 == 0) ? (bx % 8) * (G / 8) + bx / 8 : bx;
            for (int u = vcu; u < 2048; u += G) {
                const int i = u & 255, j = u >> 8; const int bh = i >> 2, s = i & 3, jj = j & 3;
                const int qb = (jj == 0) ? 15 - s : (jj == 1) ? 8 + s : (jj == 2) ? 7 - s : s;
                if (j < 4) attn_unit<true>(lds, bh >> 3, bh & 7, qb, ws, wave_s);
                else attn_unit<false>(lds, bh >> 3, bh & 7, qb, ws, wave_s);
            }
        }
        GRID_BAR();
        {
            pg8::Gemm g{(const bf16_t*)(ws + WS_H), (const bf16_t*)(ws + WS_WOUT) + (size_t)l * DM * DM, MTOK, DM, DM}; pg8::StaticOrder S; S.init(MTOK, DM, G, bx);
            EpiOut E{l == 0 ? (const float*)args.in[0] : X, X, MOD + (size_t)l * 8 * 3072 + 2048};
            pg8::gemm_phase<EpiOut, pg8::StaticOrder, true, true>(lds, g, S, E, wave_s);
        }
    }
}

extern "C" void kernel_launch(void* const* d_in, const int* in_sizes, int n_in, void* d_out, int out_size, void* d_ws, size_t ws_size, hipStream_t stream) {
    static int grid = 0;
    if (grid == 0) {
        if (n_in != 14 || out_size != MTOK * DM || ws_size < WS_END) { fprintf(stderr, "kernel_launch: unexpected shapes (n_in %d, out %d, ws %zu)\n", n_in, out_size, ws_size); grid = -1; return; }
        int dev = 0, cus = 0, per_cu = 0;
        (void)hipGetDevice(&dev); (void)hipDeviceGetAttribute(&cus, hipDeviceAttributeMultiprocessorCount, dev);
        (void)hipFuncSetAttribute((const void*)mk_fwd, hipFuncAttributeMaxDynamicSharedMemorySize, LDS_BYTES);
        if (hipOccupancyMaxActiveBlocksPerMultiprocessor(&per_cu, (const void*)mk_fwd, 512, LDS_BYTES) != hipSuccess || per_cu < 1) per_cu = 1;
        (void)hipGetLastError();
        grid = cus * per_cu;
    }
    if (grid < 0) return;
    (void)hipMemsetAsync(d_ws, 0, 16384, stream);
    Args a{};
    for (int i = 0; i < 14; ++i) a.in[i] = d_in[i];
    a.out = (float*)d_out; a.ws = (unsigned char*)d_ws;
    void* kargs[] = {&a};
    hipError_t e = hipLaunchCooperativeKernel((const void*)mk_fwd, dim3(grid), dim3(512), kargs, LDS_BYTES, stream);
    if (e != hipSuccess) fprintf(stderr, "cooperative launch failed: %s (grid %d)\n", hipGetErrorString(e), grid);
}
```

```cpp
#include <hip/hip_runtime.h>
#include <hip/hip_cooperative_groups.h>
#include <cstdio>
#include <cstdint>
#include <cmath>
namespace cg = cooperative_groups;
__device__ __forceinline__ int otid(int wave_s) { int l; asm volatile("v_mbcnt_lo_u32_b32 %0, -1, 0\n\tv_mbcnt_hi_u32_b32 %0, -1, %0" : "=v"(l)); int w = wave_s; asm volatile("" : "+s"(w)); return (w << 6) | l; }
namespace pg8 {
#define PG8_LAS __attribute__((address_space(3)))
typedef unsigned short bf16_t;
typedef short bf16x8 __attribute__((ext_vector_type(8)));
typedef float f32x4 __attribute__((ext_vector_type(4)));
typedef unsigned u32x4 __attribute__((ext_vector_type(4)));
constexpr int BM = 256, BK = 64, HALF = 128, HTB = HALF * BK * 2  , STAGE_BYTES = 8 * HTB, NXCD = 8, WGM = 8;

__host__ __device__ __forceinline__ int lds_byte(int r, int c) { const int st = (r >> 4) * 2 + (c >> 5), rr = r & 15, cc = c & 31, ob = rr * 64 + cc * 2; return st * 1024 + (ob ^ (((ob >> 9) & 1) << 5)); }
__host__ __device__ __forceinline__ void stage_rc(int b, int& R, int& C) { const int st = b / 1024, sb = b % 1024, swz = sb ^ (((sb >> 9) & 1) << 5); R = (st >> 1) * 16 + swz / 64; C = (st & 1) * 32 + (swz % 64) / 2; }
__host__ __device__ __forceinline__ int perm32(int rho) { const int n = rho >> 4, i = rho & 15; return 8 * (i >> 2) + 4 * n + (i & 3); }

struct Unit { int pm, pn; };
struct Gemm { const bf16_t* A; const bf16_t* Bt; int M, N, K; };

struct StaticOrder {
    int nM, nN, nwg, G, c;
    __host__ __device__ void init(int M, int N, int G_, int c_) { nM = M / BM; nN = N / BM; nwg = nM * nN; G = G_; c = c_; }
    __host__ __device__ bool next(int i, Unit& u) const {
        const long L = (long)i * G + c; if (L >= nwg) return false;
        int wgid = (int)L; { const int q = nwg / NXCD, r = nwg % NXCD, xcd = wgid % NXCD, off = wgid / NXCD; wgid = (xcd < r ? xcd * (q + 1) : r * (q + 1) + (xcd - r) * q) + off; }
        const int nig = WGM * nN, gid = wgid / nig, fm = gid * WGM, gsz = (nM - fm) < WGM ? (nM - fm) : WGM;
        u.pm = fm + ((wgid % nig) % gsz); u.pn = (wgid % nig) / gsz; return true;
    }
    __device__ __forceinline__ void a_ready(const Unit&) const {}
    __device__ __forceinline__ void done(const Unit&) const {}
};

__device__ __forceinline__ unsigned cvt_pk_bf16(float lo, float hi) { unsigned r; asm volatile("v_cvt_pk_bf16_f32 %0, %1, %2" : "=v"(r) : "v"(lo), "v"(hi)); return r; }
template <class Epi, class Sched, bool ALIGN_EPI = false, bool SP2 = false>
__device__ __forceinline__ void gemm_phase(PG8_LAS unsigned char* lds, const Gemm g, const Sched& S, const Epi& E, int wave_s) {
    const int tid = otid(wave_s), wid = __builtin_amdgcn_readfirstlane(tid >> 6), lane = tid & 63, wr = wid >> 2, wc = wid & 3, fr = lane & 15, fq = lane >> 4;
    const int K = g.K, nt = K / BK;
    unsigned voffA[2], voffB[2];
#pragma unroll
    for (int i = 0; i < 2; ++i) { int R, C; stage_rc(tid * 16 + i * 8192, R, C); const int Rb = Epi::PERM ? ((R & ~31) + perm32(R & 31)) : R;
        voffA[i] = (unsigned)(R * K + C) * 2u; voffB[i] = (unsigned)(Rb * K + C) * 2u; }
    const size_t kstep = (size_t)(BK * 2);
    const size_t hstep = (size_t)HALF * K * 2;
    const size_t tstep = 2 * hstep;
    const unsigned ldsw = (unsigned)wid * 1024u;
    const int aoff = lds_byte(wr * 64 + fr, fq * 8), boff = lds_byte(wc * 32 + fr, fq * 8);
#define PG8_SA(b, h) (((b) * 2 + (h)) * HTB)
#define PG8_SB(b, h) ((4 + (b) * 2 + (h)) * HTB)
#define PG8_STAGE(bufoff, gbase, voff) do { _Pragma("unroll") for (int _i = 0; _i < 2; ++_i) \
        __builtin_amdgcn_global_load_lds((const unsigned*)((const char*)(gbase) + (voff)[_i]), (PG8_LAS unsigned*)(lds + (bufoff) + ldsw + _i * 8192), 16, 0, 0); } while (0)
#define PG8_LDA(dst, b, h) do { _Pragma("unroll") for (int m = 0; m < 4; ++m) _Pragma("unroll") for (int k = 0; k < 2; ++k) dst[m][k] = *(const PG8_LAS bf16x8*)(lds + PG8_SA(b, h) + aoff + m * 2048 + k * 1024); } while (0)
#define PG8_LDB(dst, b, h) do { _Pragma("unroll") for (int n = 0; n < 2; ++n) _Pragma("unroll") for (int k = 0; k < 2; ++k) dst[n][k] = *(const PG8_LAS bf16x8*)(lds + PG8_SB(b, h) + boff + n * 2048 + k * 1024); } while (0)
#define PG8_MMA(ai, bj, At, Bt) do { __builtin_amdgcn_s_setprio(1); _Pragma("unroll") for (int m = 0; m < 4; ++m) _Pragma("unroll") for (int n = 0; n < 2; ++n) _Pragma("unroll") for (int k = 0; k < 2; ++k) \
        acc[ai][bj][m][n] = __builtin_amdgcn_mfma_f32_16x16x32_bf16(Bt[n][k], At[m][k], acc[ai][bj][m][n], 0, 0, 0); __builtin_amdgcn_s_setprio(0); } while (0)
#define PG8_WAIT_V(n) asm volatile("s_waitcnt vmcnt(" #n ")" ::: "memory")
#define PG8_WAIT_L(n) asm volatile("s_waitcnt lgkmcnt(" #n ")" ::: "memory")
#define PG8_BAR __builtin_amdgcn_s_barrier()
#define PG8_SCHED __builtin_amdgcn_sched_barrier(0)
    Unit cur, nxt; int ui = 0;
    if (!S.next(0, cur)) return;
    f32x4 acc[2][2][4][2];
#pragma unroll
    for (int a = 0; a < 2; ++a)
#pragma unroll
        for (int b = 0; b < 2; ++b)
#pragma unroll
            for (int m = 0; m < 4; ++m)
#pragma unroll
                for (int n = 0; n < 2; ++n) acc[a][b][m][n] = (f32x4){0.f, 0.f, 0.f, 0.f};
    bf16x8 At[4][2], B0[2][2], B1[2][2];
    const char* cA = (const char*)g.A + (size_t)cur.pm * tstep; const char* cB = (const char*)g.Bt + (size_t)cur.pn * tstep;
    S.a_ready(cur);
    if constexpr (SP2) {
        PG8_STAGE(PG8_SB(0, 0), cB, voffB); PG8_STAGE(PG8_SB(0, 1), cB + hstep, voffB); PG8_STAGE(PG8_SA(0, 0), cA, voffA); PG8_STAGE(PG8_SA(0, 1), cA + hstep, voffA);
        if (wr == 1) PG8_BAR;
        PG8_WAIT_V(2); PG8_BAR;
        PG8_STAGE(PG8_SB(1, 0), cB + kstep, voffB); PG8_STAGE(PG8_SA(1, 0), cA + kstep, voffA); PG8_STAGE(PG8_SB(1, 1), cB + hstep + kstep, voffB);
        PG8_WAIT_V(6); PG8_BAR;
    } else {
        PG8_STAGE(PG8_SB(0, 0), cB, voffB); PG8_STAGE(PG8_SA(0, 0), cA, voffA); PG8_STAGE(PG8_SB(0, 1), cB + hstep, voffB); PG8_STAGE(PG8_SA(0, 1), cA + hstep, voffA);
        if (wr == 1) PG8_BAR;
        PG8_WAIT_V(4); PG8_BAR;
        PG8_STAGE(PG8_SB(1, 0), cB + kstep, voffB); PG8_STAGE(PG8_SA(1, 0), cA + kstep, voffA); PG8_STAGE(PG8_SB(1, 1), cB + hstep + kstep, voffB);
        PG8_WAIT_V(6); PG8_BAR;
    }
    for (;;) {
        const bool has_next = S.next(ui + 1, nxt);
        const char* nA = has_next ? (const char*)g.A + (size_t)nxt.pm * tstep : cA; const char* nB = has_next ? (const char*)g.Bt + (size_t)nxt.pn * tstep : cB;
        for (int t = 0; t < nt; t += 2) {
            const bool last = (t == nt - 2);
            const char* a1 = cA + (size_t)(t + 1) * kstep;
            const char* a2 = last ? nA : cA + (size_t)(t + 2) * kstep; const char* b2 = last ? nB : cB + (size_t)(t + 2) * kstep;
            const char* a3 = a2 + kstep; const char* b3 = b2 + kstep;
            if (last && has_next) S.a_ready(nxt);
            if constexpr (SP2) {
            PG8_LDB(B0, 0, 0); PG8_LDB(B1, 0, 1); PG8_SCHED; PG8_LDA(At, 0, 0); PG8_STAGE(PG8_SA(1, 1), a1 + hstep, voffA);
            PG8_WAIT_V(8); PG8_WAIT_L(0); PG8_BAR; PG8_MMA(0, 0, At, B0); PG8_MMA(0, 1, At, B1); PG8_BAR; PG8_SCHED;
            PG8_LDA(At, 0, 1); PG8_STAGE(PG8_SB(0, 0), b2, voffB); PG8_STAGE(PG8_SB(0, 1), b2 + hstep, voffB); PG8_STAGE(PG8_SA(0, 0), a2, voffA);
            PG8_WAIT_V(8); PG8_WAIT_L(0); PG8_BAR; PG8_MMA(1, 0, At, B0); PG8_MMA(1, 1, At, B1); PG8_BAR; PG8_SCHED;
            PG8_LDB(B0, 1, 0); PG8_LDB(B1, 1, 1); PG8_SCHED; PG8_LDA(At, 1, 0); PG8_STAGE(PG8_SA(0, 1), a2 + hstep, voffA);
            PG8_WAIT_V(8); PG8_WAIT_L(0); PG8_BAR; PG8_MMA(0, 0, At, B0); PG8_MMA(0, 1, At, B1); PG8_BAR; PG8_SCHED;
            PG8_LDA(At, 1, 1); PG8_STAGE(PG8_SB(1, 0), b3, voffB); PG8_STAGE(PG8_SB(1, 1), b3 + hstep, voffB); PG8_STAGE(PG8_SA(1, 0), a3, voffA);
            PG8_WAIT_V(8); PG8_WAIT_L(0); PG8_BAR; PG8_MMA(1, 0, At, B0); PG8_MMA(1, 1, At, B1); PG8_BAR; PG8_SCHED;
            } else {
            PG8_LDB(B0, 0, 0); PG8_SCHED; PG8_LDA(At, 0, 0); PG8_STAGE(PG8_SA(1, 1), a1 + hstep, voffA);
            PG8_WAIT_L(8); PG8_BAR; PG8_WAIT_L(0); PG8_MMA(0, 0, At, B0); PG8_BAR; PG8_SCHED;
            PG8_LDB(B1, 0, 1); PG8_STAGE(PG8_SB(0, 0), b2, voffB);
            PG8_BAR; PG8_WAIT_L(0); PG8_MMA(0, 1, At, B1); PG8_BAR;
            PG8_LDA(At, 0, 1); PG8_STAGE(PG8_SA(0, 0), a2, voffA);
            PG8_BAR; PG8_WAIT_L(0); PG8_MMA(1, 0, At, B0); PG8_BAR; PG8_SCHED;
            PG8_STAGE(PG8_SB(0, 1), b2 + hstep, voffB);
            PG8_WAIT_V(6); PG8_BAR; PG8_MMA(1, 1, At, B1); PG8_BAR;
            PG8_LDB(B0, 1, 0); PG8_SCHED; PG8_LDA(At, 1, 0); PG8_STAGE(PG8_SA(0, 1), a2 + hstep, voffA);
            PG8_WAIT_L(8); PG8_BAR; PG8_WAIT_L(0); PG8_MMA(0, 0, At, B0); PG8_BAR; PG8_SCHED;
            PG8_LDB(B1, 1, 1); PG8_STAGE(PG8_SB(1, 0), b3, voffB);
            PG8_BAR; PG8_WAIT_L(0); PG8_MMA(0, 1, At, B1); PG8_BAR;
            PG8_LDA(At, 1, 1); PG8_STAGE(PG8_SA(1, 0), a3, voffA);
            PG8_BAR; PG8_WAIT_L(0); PG8_MMA(1, 0, At, B0); PG8_BAR; PG8_SCHED;
            PG8_STAGE(PG8_SB(1, 1), b3 + hstep, voffB);
            PG8_WAIT_V(6); PG8_BAR; PG8_MMA(1, 1, At, B1); PG8_BAR;
            }
        }
        if constexpr (ALIGN_EPI) { if (wr == 0) PG8_BAR; }
        if constexpr (!Epi::AFTER_DRAIN) { int fr2 = fr, fq2 = fq; asm volatile("" : "+v"(fr2), "+v"(fq2)); E(acc, cur, wr, wc, fr2, fq2); S.done(cur); }
        if (!has_next) break;
#pragma unroll
        for (int a = 0; a < 2; ++a)
#pragma unroll
            for (int b = 0; b < 2; ++b)
#pragma unroll
                for (int m = 0; m < 4; ++m)
#pragma unroll
                    for (int n = 0; n < 2; ++n) acc[a][b][m][n] = (f32x4){0.f, 0.f, 0.f, 0.f};
        cur = nxt; cA = nA; cB = nB; ++ui;
        if constexpr (ALIGN_EPI) { if (wr == 1) PG8_BAR; }
    }
    PG8_WAIT_V(0);
    if constexpr (!ALIGN_EPI) { if (wr == 0) PG8_BAR; }
    PG8_BAR;
    if constexpr (Epi::AFTER_DRAIN) { E.fused(acc, cur, wr, wc, fr, fq, lds, wid, lane); S.done(cur); }
#undef PG8_SA
#undef PG8_SB
#undef PG8_STAGE
#undef PG8_LDA
#undef PG8_LDB
#undef PG8_MMA
#undef PG8_WAIT_V
#undef PG8_WAIT_L
#undef PG8_BAR
#undef PG8_SCHED
}
}

#define LAS __attribute__((address_space(3)))
typedef unsigned short bf16_t;
typedef short bf16x8 __attribute__((ext_vector_type(8)));
typedef float f32x4 __attribute__((ext_vector_type(4)));
typedef float f32x16 __attribute__((ext_vector_type(16)));
typedef unsigned u32x4 __attribute__((ext_vector_type(4)));
typedef unsigned u32x2 __attribute__((ext_vector_type(2)));
typedef short v4i16_t __attribute__((ext_vector_type(4)));

constexpr int NB = 8, SEQ = 4096, DM = 1024, DEPTH = 4, MTOK = NB * SEQ, NIN = 2984, NINP = 3072;
constexpr float EPS_ = 1e-6f, LOG2E = 1.4426950408889634f;
constexpr float C2F = 0.125f * LOG2E;
constexpr float C2M = 0.10206207261596575f * LOG2E;
constexpr int LDS_BYTES = 132096;

constexpr size_t MiB = 1u << 20;
constexpr size_t WS_WIN = 2 * MiB, WS_WOUT = 26 * MiB, WS_WUQ = 34 * MiB, WS_WUKV = 36 * MiB, WS_MOD = 37 * MiB, WS_COS = 38 * MiB, WS_SIN = 40 * MiB,
                 WS_LOGF = 42 * MiB, WS_CUM = 43 * MiB, WS_SSQQ = 44 * MiB, WS_SSQK = 45 * MiB, WS_H = 48 * MiB, WS_QF = 112 * MiB, WS_KF = 144 * MiB,
                 WS_VF = 176 * MiB, WS_GATE = 208 * MiB, WS_QLAT = 272 * MiB, WS_KVLAT = 288 * MiB, WS_KR = 296 * MiB, WS_QM = 298 * MiB, WS_KM = 346 * MiB,
                 WS_VM = 378 * MiB, WS_END = 410 * MiB;

__device__ __forceinline__ unsigned f2bf(float f) { unsigned u = __builtin_bit_cast(unsigned, f); return (u + 0x7fffu + ((u >> 16) & 1u)) >> 16; }
typedef float f32x2_t __attribute__((ext_vector_type(2))); typedef __bf16 bf16x2_t __attribute__((ext_vector_type(2)));
__device__ __forceinline__ unsigned cvtpk_s(float lo, float hi) { f32x2_t v = {lo, hi}; bf16x2_t b = __builtin_convertvector(v, bf16x2_t); return __builtin_bit_cast(unsigned, b); }
__device__ __forceinline__ unsigned pk2(float lo, float hi) { return cvtpk_s(lo, hi); }
__device__ __forceinline__ float bf2f(bf16_t v) { return __builtin_bit_cast(float, (unsigned)v << 16); }
__device__ __forceinline__ u32x2 pk4(f32x4 v) { u32x2 w; w.x = pk2(v[0], v[1]); w.y = pk2(v[2], v[3]); return w; }
__device__ __forceinline__ float silu_f(float v) { return v / (1.f + __expf(-v)); }
__device__ __forceinline__ f32x4 silu4(f32x4 v) { return (f32x4){silu_f(v[0]), silu_f(v[1]), silu_f(v[2]), silu_f(v[3])}; }
__device__ __forceinline__ float logsig_f(float x) { return fminf(x, 0.f) - log1pf(expf(-fabsf(x))); }
__device__ __forceinline__ float shx(float v, int mask, int lane) { return __builtin_bit_cast(float, __builtin_amdgcn_ds_bpermute((lane ^ mask) << 2, __builtin_bit_cast(int, v))); }
__device__ __forceinline__ float shup(float v, int off, int lane) { return __builtin_bit_cast(float, __builtin_amdgcn_ds_bpermute(((lane - off) & 63) << 2, __builtin_bit_cast(int, v))); }
__device__ __forceinline__ float wave_sum(float v, int lane) {
#pragma unroll
    for (int o = 1; o < 64; o <<= 1) v += shx(v, o, lane);
    return v;
}
#define LDS_WAIT() asm volatile("s_waitcnt lgkmcnt(0)" ::: "memory")


#define XB_TMO      128
#define XB_XCNT(j)  (256  + 64 * (j))
#define XB_XSUB(j)  (1280 + 64 * (j))
#define XB_XGEN(j)  (2304 + 64 * (j))
#define XB_TOP      3328
#define XB_TOPGEN   3392
#define XCD_BAR_WORDS 3456
#define XB_SPIN_CAP (1u << 18)
__device__ __forceinline__ unsigned xb_ld(unsigned* p)              { return __hip_atomic_load(p, __ATOMIC_RELAXED, __HIP_MEMORY_SCOPE_AGENT); }
__device__ __forceinline__ unsigned xb_add(unsigned* p, unsigned v) { return __hip_atomic_fetch_add(p, v, __ATOMIC_RELAXED, __HIP_MEMORY_SCOPE_AGENT); }
__device__ __forceinline__ unsigned xb_xcc_id() { return (unsigned)__builtin_amdgcn_s_getreg((3 << 11) | 20) & 0xFu; }
#define XB_SPIN(cond, bar) do { unsigned _sp = 0; while (cond) { __builtin_amdgcn_s_sleep(1); \
    if ((++_sp & 255u) == 0u) { if (xb_ld(&(bar)[XB_TMO])) break; if (_sp > XB_SPIN_CAP) { atomicAdd(&(bar)[XB_TMO], 1u); break; } } } } while (0)
__device__ __forceinline__ void xcd_barrier_complete(unsigned* bar, unsigned x, unsigned& nloc, unsigned& nx) {
    const unsigned G = gridDim.x * gridDim.y * gridDim.z;
    unsigned sum, cnt, mine, sp = 0u;
    for (;;) {
        sum = 0u; cnt = 0u; mine = 0u;
#pragma unroll
        for (unsigned j = 0; j < 16; ++j) { const unsigned c = xb_ld(&bar[XB_XCNT(j)]); sum += c; cnt += (c > 0u) ? 1u : 0u; mine = (j == x) ? c : mine; }
        if (sum == G) break;
        __builtin_amdgcn_s_sleep(1);
        if ((++sp & 255u) == 0u) { if (xb_ld(&bar[XB_TMO])) break; if (sp > XB_SPIN_CAP) { atomicAdd(&bar[XB_TMO], 1u); break; } }
    }
    nloc = mine > 0u ? mine : 1u; nx = cnt > 0u ? cnt : 1u;
}
__device__ __forceinline__ void xcd_barrier(unsigned* bar, volatile LAS unsigned* st, int tid) {
    asm volatile("s_waitcnt vmcnt(0)" ::: "memory");
    __syncthreads();
    if (tid == 0) {
        const unsigned x = xb_xcc_id();
        __builtin_amdgcn_s_waitcnt(0);
        unsigned nloc = st[0], nx = st[1];
        if (nloc == 0u) { xcd_barrier_complete(bar, x, nloc, nx); st[0] = nloc; st[1] = nx; }
        const unsigned old = xb_add(&bar[XB_XSUB(x)], 1u);
        const unsigned gen = old / nloc;
        if (old + 1u == (gen + 1u) * nloc) {
            __builtin_amdgcn_fence(__ATOMIC_RELEASE, "agent");
            asm volatile("s_waitcnt vmcnt(0)" ::: "memory");
            const unsigned og = xb_add(&bar[XB_TOP], 1u);
            const unsigned tg = og / nx;
            if (og + 1u == (tg + 1u) * nx) xb_add(&bar[XB_TOPGEN], 1u);
            else XB_SPIN(xb_ld(&bar[XB_TOPGEN]) == tg, bar);
            __builtin_amdgcn_fence(__ATOMIC_ACQUIRE, "agent");
            xb_add(&bar[XB_XGEN(x)], 1u);
            asm volatile("s_waitcnt vmcnt(0)" ::: "memory");
        } else {
            XB_SPIN(xb_ld(&bar[XB_XGEN(x)]) == gen, bar);
            __builtin_amdgcn_fence(__ATOMIC_ACQUIRE, "agent");
            asm volatile("s_waitcnt vmcnt(0)" ::: "memory");
        }
    }
    __syncthreads();
}

using pg8::Unit;
struct EpiIn {
    static constexpr bool PERM = false, AFTER_DRAIN = false;
    unsigned char* ws; const float* BF;
    __device__ __forceinline__ void operator()(const f32x4 (&acc)[2][2][4][2], const Unit& u, int wr, int wc, int fr, int fq) const {
        const int row0 = u.pm * 256 + wr * 64 + fr;
        bf16_t* QF = (bf16_t*)(ws + WS_QF); bf16_t* GATE = (bf16_t*)(ws + WS_GATE); bf16_t* QLAT = (bf16_t*)(ws + WS_QLAT); bf16_t* KVLAT = (bf16_t*)(ws + WS_KVLAT); bf16_t* KR = (bf16_t*)(ws + WS_KR);
        float* LOGF = (float*)(ws + WS_LOGF); float* SSQQ = (float*)(ws + WS_SSQQ); float* SSQK = (float*)(ws + WS_SSQK); const float* COS = (const float*)(ws + WS_COS); const float* SIN = (const float*)(ws + WS_SIN);
        if (u.pn == 8) {
#pragma unroll
            for (int ai = 0; ai < 2; ++ai)
#pragma unroll
                for (int m = 0; m < 4; ++m) {
                    float s = 0.f;
#pragma unroll
                    for (int bj = 0; bj < 2; ++bj)
#pragma unroll
                        for (int n = 0; n < 2; ++n) { const f32x4 x = acc[ai][bj][m][n]; s += (x[0] * x[0] + x[1] * x[1]) + (x[2] * x[2] + x[3] * x[3]); }
                    s += shx(s, 16, fq * 16 + fr); s += shx(s, 32, fq * 16 + fr);
                    if (fq == 0) SSQQ[(size_t)(row0 + ai * 128 + m * 16) * 4 + wc] = s;
                }
        } else if (u.pn == 9) {
#pragma unroll
            for (int ai = 0; ai < 2; ++ai)
#pragma unroll
                for (int m = 0; m < 4; ++m) {
                    float s = 0.f;
#pragma unroll
                    for (int n = 0; n < 2; ++n) { const f32x4 x = acc[ai][0][m][n]; s += (x[0] * x[0] + x[1] * x[1]) + (x[2] * x[2] + x[3] * x[3]); }
                    s += shx(s, 16, fq * 16 + fr); s += shx(s, 32, fq * 16 + fr);
                    if (fq == 0) SSQK[(size_t)(row0 + ai * 128 + m * 16) * 4 + wc] = s;
                }
        }
#pragma unroll
        for (int bj = 0; bj < 2; ++bj) {
            const int gcol = u.pn * 256 + bj * 128 + wc * 32;
            if (gcol < 1536) {
                const int seg = gcol >> 9; bf16_t* base = QF + (size_t)seg * ((WS_KF - WS_QF) / 2); const float sc = seg == 0 ? C2F : 1.f; const int c0 = (gcol & 511) + 4 * fq;
#pragma unroll
                for (int ai = 0; ai < 2; ++ai)
#pragma unroll
                    for (int m = 0; m < 4; ++m) { bf16_t* rp = base + (size_t)(row0 + ai * 128 + m * 16) * 512 + c0;
#pragma unroll
                        for (int n = 0; n < 2; ++n) *(u32x2*)(rp + 16 * n) = pk4(acc[ai][bj][m][n] * sc); }
            } else if (gcol < 2048 || (gcol >= 2464 && gcol < 2976)) {
                const int c0 = (gcol < 2048 ? gcol - 1536 : gcol - 2464 + 512) + 4 * fq;
#pragma unroll
                for (int ai = 0; ai < 2; ++ai)
#pragma unroll
                    for (int m = 0; m < 4; ++m) { bf16_t* rp = GATE + (size_t)(row0 + ai * 128 + m * 16) * 1024 + c0;
#pragma unroll
                        for (int n = 0; n < 2; ++n) *(u32x2*)(rp + 16 * n) = pk4(silu4(acc[ai][bj][m][n])); }
            } else if (gcol < 2304) {
                const int c0 = gcol - 2048 + 4 * fq;
#pragma unroll
                for (int ai = 0; ai < 2; ++ai)
#pragma unroll
                    for (int m = 0; m < 4; ++m) { bf16_t* rp = QLAT + (size_t)(row0 + ai * 128 + m * 16) * 256 + c0;
#pragma unroll
                        for (int n = 0; n < 2; ++n) *(u32x2*)(rp + 16 * n) = pk4(acc[ai][bj][m][n]); }
            } else if (gcol < 2432) {
                const int c0 = gcol - 2304 + 4 * fq;
#pragma unroll
                for (int ai = 0; ai < 2; ++ai)
#pragma unroll
                    for (int m = 0; m < 4; ++m) { bf16_t* rp = KVLAT + (size_t)(row0 + ai * 128 + m * 16) * 128 + c0;
#pragma unroll
                        for (int n = 0; n < 2; ++n) *(u32x2*)(rp + 16 * n) = pk4(acc[ai][bj][m][n]); }
            } else if (gcol < 2464) {
#pragma unroll
                for (int ai = 0; ai < 2; ++ai)
#pragma unroll
                    for (int m = 0; m < 4; ++m) { const size_t row = (size_t)(row0 + ai * 128 + m * 16);
                        const f32x4 cs = *(const f32x4*)(COS + row * 16 + 4 * fq), sn = *(const f32x4*)(SIN + row * 16 + 4 * fq);
                        const f32x4 t1 = acc[ai][bj][m][0], t2 = acc[ai][bj][m][1];
                        const f32x4 o1 = t1 * cs - t2 * sn, o2 = t2 * cs + t1 * sn;
                        bf16_t* rp = KR + row * 32 + 4 * fq; *(u32x2*)(rp) = pk4(o1); *(u32x2*)(rp + 16) = pk4(o2); if (m & 1) asm volatile("" ::: "memory"); }
            } else if (gcol == 2976) {
                if (fq < 2) {
                    const f32x4 bfv = *(const f32x4*)(BF + 4 * fq);
#pragma unroll
                    for (int ai = 0; ai < 2; ++ai)
#pragma unroll
                        for (int m = 0; m < 4; ++m) { const size_t row = (size_t)(row0 + ai * 128 + m * 16); const f32x4 v = acc[ai][bj][m][0] + bfv;
                            *(f32x4*)(LOGF + row * 8 + 4 * fq) = (f32x4){logsig_f(v[0]), logsig_f(v[1]), logsig_f(v[2]), logsig_f(v[3])}; }
                }
            }
        }
    }
};
struct EpiQ {
    static constexpr bool PERM = false, AFTER_DRAIN = false;
    unsigned char* ws;
    __device__ __forceinline__ void operator()(const f32x4 (&acc)[2][2][4][2], const Unit& u, int wr, int wc, int fr, int fq) const {
        const int row0 = u.pm * 256 + wr * 64 + fr;
        const float* SSQ = (const float*)(ws + WS_SSQQ); const float* COS = (const float*)(ws + WS_COS); const float* SIN = (const float*)(ws + WS_SIN); bf16_t* QM = (bf16_t*)(ws + WS_QM);
        float rs[2][4];
#pragma unroll
        for (int ai = 0; ai < 2; ++ai)
#pragma unroll
            for (int m = 0; m < 4; ++m) { const f32x4 s = *(const f32x4*)(SSQ + (size_t)(row0 + ai * 128 + m * 16) * 4); rs[ai][m] = rsqrtf(((s[0] + s[1]) + (s[2] + s[3])) * (1.f / 256.f) + EPS_) * C2M; }
#pragma unroll
        for (int bj = 0; bj < 2; ++bj) {
            const int gcol = u.pn * 256 + bj * 128 + wc * 32; const bool rope = ((gcol >> 5) % 3) == 2;
#pragma unroll
            for (int ai = 0; ai < 2; ++ai)
#pragma unroll
                for (int m = 0; m < 4; ++m) { const size_t row = (size_t)(row0 + ai * 128 + m * 16);
                    f32x4 v0 = acc[ai][bj][m][0] * rs[ai][m], v1 = acc[ai][bj][m][1] * rs[ai][m];
                    if (rope) { const f32x4 cs = *(const f32x4*)(COS + row * 16 + 4 * fq), sn = *(const f32x4*)(SIN + row * 16 + 4 * fq);
                        const f32x4 o1 = v0 * cs - v1 * sn, o2 = v1 * cs + v0 * sn; v0 = o1; v1 = o2; }
                    bf16_t* rp = QM + row * 768 + gcol + 4 * fq; *(u32x2*)(rp) = pk4(v0); *(u32x2*)(rp + 16) = pk4(v1); if (m & 1) asm volatile("" ::: "memory"); }
        }
    }
};
struct EpiKV {
    static constexpr bool PERM = false, AFTER_DRAIN = false;
    unsigned char* ws;
    __device__ __forceinline__ void operator()(const f32x4 (&acc)[2][2][4][2], const Unit& u, int wr, int wc, int fr, int fq) const {
        const int row0 = u.pm * 256 + wr * 64 + fr;
        const float* SSQ = (const float*)(ws + WS_SSQK); bf16_t* KM = (bf16_t*)(ws + WS_KM);
        float rs[2][4];
#pragma unroll
        for (int ai = 0; ai < 2; ++ai)
#pragma unroll
            for (int m = 0; m < 4; ++m) { const f32x4 s = *(const f32x4*)(SSQ + (size_t)(row0 + ai * 128 + m * 16) * 4); rs[ai][m] = rsqrtf(((s[0] + s[1]) + (s[2] + s[3])) * (1.f / 128.f) + EPS_); }
#pragma unroll
        for (int bj = 0; bj < 2; ++bj) {
            const int gcol = u.pn * 256 + bj * 128 + wc * 32; const int head = gcol >> 7, within = gcol & 127;
            bf16_t* base = KM + (within < 64 ? (size_t)0 : (size_t)((WS_VM - WS_KM) / 2)); const int c0 = head * 64 + (within & 63) + 4 * fq;
#pragma unroll
            for (int ai = 0; ai < 2; ++ai)
#pragma unroll
                for (int m = 0; m < 4; ++m) { bf16_t* rp = base + (size_t)(row0 + ai * 128 + m * 16) * 512 + c0;
#pragma unroll
                    for (int n = 0; n < 2; ++n) *(u32x2*)(rp + 16 * n) = pk4(acc[ai][bj][m][n] * rs[ai][m]); }
        }
    }
};
struct EpiOut {
    static constexpr bool PERM = false, AFTER_DRAIN = false;
    const float* XIN; float* XOUT; const float* MODG;
    __device__ __forceinline__ void operator()(const f32x4 (&acc)[2][2][4][2], const Unit& u, int wr, int wc, int fr, int fq) const {
        const int row0 = u.pm * 256 + wr * 64 + fr; const int b = (u.pm * 256) >> 12;
#pragma unroll
        for (int bj = 0; bj < 2; ++bj)
#pragma unroll
            for (int n = 0; n < 2; ++n) { const int col = u.pn * 256 + bj * 128 + wc * 32 + 16 * n + 4 * fq; const f32x4 g4 = *(const f32x4*)(MODG + (size_t)b * 3072 + col);
#pragma unroll
                for (int ai = 0; ai < 2; ++ai)
#pragma unroll
                    for (int m = 0; m < 4; ++m) { const size_t off = (size_t)(row0 + ai * 128 + m * 16) * 1024 + col; const f32x4 xi = *(const f32x4*)(XIN + off); *(f32x4*)(XOUT + off) = xi + g4 * acc[ai][bj][m][n]; } asm volatile("" ::: "memory"); }
    }
};

__device__ __forceinline__ int crow(int r, int hi) { return (r & 3) + 8 * (r >> 2) + 4 * hi; }
__device__ __forceinline__ bf16x8 vtr2(const LAS unsigned char* p) {
    const v4i16_t lo = __builtin_amdgcn_ds_read_tr16_b64_v4i16((LAS v4i16_t*)p), hi = __builtin_amdgcn_ds_read_tr16_b64_v4i16((LAS v4i16_t*)(p + 512));
    return (bf16x8){lo[0], lo[1], lo[2], lo[3], hi[0], hi[1], hi[2], hi[3]};
}
constexpr int AT_KBUF = 13312, AT_OFF_V = 2 * AT_KBUF, AT_OFF_CK = AT_OFF_V + 2 * 8192, AT_OFF_WS = AT_OFF_CK + 512;

template <bool MLA>
__device__ __forceinline__ void attn_unit(LAS unsigned char* lds, int b, int h, int qb, unsigned char* ws, int wave_s) {
    constexpr int DQK = MLA ? 96 : 64, NDS = DQK / 16, KROW = MLA ? 208 : 144, QP = MLA ? 768 : 512;
    const bf16_t* Q = (const bf16_t*)(ws + (MLA ? WS_QM : WS_QF)); const bf16_t* K = (const bf16_t*)(ws + (MLA ? WS_KM : WS_KF)); const bf16_t* V = (const bf16_t*)(ws + (MLA ? WS_VM : WS_VF));
    const bf16_t* KRp = (const bf16_t*)(ws + WS_KR); const float* CUM = (const float*)(ws + WS_CUM); const bf16_t* GATE = (const bf16_t*)(ws + WS_GATE); bf16_t* Y = (bf16_t*)(ws + WS_H);
    const int tid = otid(wave_s), lane = tid & 63, r32 = lane & 31, hi = lane >> 5; const int wid = __builtin_amdgcn_readfirstlane(tid >> 6);
    const int par = (wid >> 2) & 1;
    const int q0 = qb * 256, qw0 = q0 + wid * 32; const size_t rowbase = (size_t)b * SEQ;
    const int NT = q0 / 64 + 4;
    bf16x8 qr[NDS];
    { const bf16_t* qp = Q + (rowbase + qw0 + r32) * QP + h * DQK + hi * 8;
#pragma unroll
      for (int ds = 0; ds < NDS; ++ds) qr[ds] = *(const bf16x8*)(qp + ds * 16); }
    const int krow = tid >> 3, kch = tid & 7;
    const bf16_t* kgu = K + rowbase * 512 + h * 64; const unsigned koff = (unsigned)(krow * 512 + kch * 8); const int kdst = krow * KROW + kch * 16;
    const bf16_t* krgu = KRp + rowbase * 32; const unsigned kroff = (unsigned)((tid >> 2) * 32 + (tid & 3) * 8); const int krdst = (tid >> 2) * KROW + 128 + (tid & 3) * 16;
    const int vdh = tid >> 8, vrow = (tid >> 2) & 63, vc4 = tid & 3;
    const bf16_t* vgu = V + rowbase * 512 + h * 64; const unsigned voff = (unsigned)(vrow * 512 + vdh * 32 + vc4 * 8); const int vdst = AT_OFF_V + vdh * 4096 + vrow * 64 + vc4 * 16;
    const float* ckgu = CUM + (size_t)(b * 8 + h) * SEQ; const unsigned ckoff = (unsigned)(tid & 63);
    u32x4 kreg, krreg = (u32x4){0u, 0u, 0u, 0u}, vreg; float ckreg = 0.f;
#define AT_LOADK(t) do { kreg = *(const u32x4*)(kgu + (size_t)(t) * 64 * 512 + koff); \
        if (MLA) { if (tid < 256) krreg = *(const u32x4*)(krgu + (size_t)(t) * 64 * 32 + kroff); } else { if (tid < 64) ckreg = -ckgu[(size_t)(t) * 64 + ckoff]; } } while (0)
#define AT_STOREK(bf) do { *(LAS u32x4*)(lds + (bf) * AT_KBUF + kdst) = kreg; \
        if (MLA) { if (tid < 256) *(LAS u32x4*)(lds + (bf) * AT_KBUF + krdst) = krreg; } else { if (tid < 64) *(LAS float*)(lds + AT_OFF_CK + (bf) * 256 + tid * 4) = ckreg; } } while (0)
#define AT_LOADV(t) do { vreg = *(const u32x4*)(vgu + (size_t)(t) * 64 * 512 + voff); } while (0)
#define AT_STOREV(bf) do { *(LAS u32x4*)(lds + (bf) * 8192 + vdst) = vreg; } while (0)
    float mhat = -1e30f, lsum = 0.f; f32x16 o0 = {}, o1 = {};
    const int vb = AT_OFF_V + ((lane >> 4) & 1) * 32 + (lane & 3) * 8 + (4 * hi + ((lane & 15) >> 2)) * 64;
#define AT_QK(P0, P1, t_, MASKOK) do { const int bf_ = (t_) & 1; \
        if (!MLA) { _Pragma("unroll") for (int g = 0; g < 4; ++g) { const f32x4 c0 = *(const LAS f32x4*)(lds + AT_OFF_CK + bf_ * 256 + (8 * g + 4 * hi) * 4), c1 = *(const LAS f32x4*)(lds + AT_OFF_CK + bf_ * 256 + (32 + 8 * g + 4 * hi) * 4); \
                _Pragma("unroll") for (int e = 0; e < 4; ++e) { P0[4 * g + e] = c0[e]; P1[4 * g + e] = c1[e]; } } } \
        else { P0 = (f32x16){}; P1 = (f32x16){}; } \
        const LAS unsigned char* kb_ = lds + bf_ * AT_KBUF + r32 * KROW + hi * 16; \
        _Pragma("unroll") for (int ds = 0; ds < NDS; ++ds) { \
            const bf16x8 kf0 = *(const LAS bf16x8*)(kb_ + ds * 32), kf1 = *(const LAS bf16x8*)(kb_ + 32 * KROW + ds * 32); \
            P0 = __builtin_amdgcn_mfma_f32_32x32x16_bf16(kf0, qr[ds], P0, 0, 0, 0); \
            P1 = __builtin_amdgcn_mfma_f32_32x32x16_bf16(kf1, qr[ds], P1, 0, 0, 0); } \
        if (MASKOK && !MLA && (t_) * 64 + 63 > qw0) { const int q_ = qw0 + r32; \
            _Pragma("unroll") for (int r = 0; r < 16; ++r) { const int kv = (t_) * 64 + crow(r, hi); if (kv > q_) P0[r] = -INFINITY; if (kv + 32 > q_) P1[r] = -INFINITY; } } } while (0)
#define AT_SMPV(P0, P1, t_) do { const int bf_ = (t_) & 1; \
        float ra = fmaxf(fmaxf(P0[0], P0[1]), P1[0]), rb = fmaxf(fmaxf(P0[2], P0[3]), P1[1]); ra = fmaxf(fmaxf(ra, P1[2]), P1[3]); \
        _Pragma("unroll") for (int r = 4; r < 16; r += 4) { ra = fmaxf(fmaxf(ra, P0[r]), P0[r + 1]); rb = fmaxf(fmaxf(rb, P0[r + 2]), P0[r + 3]); ra = fmaxf(fmaxf(ra, P1[r]), P1[r + 1]); rb = fmaxf(fmaxf(rb, P1[r + 2]), P1[r + 3]); } \
        float rm = fmaxf(ra, rb); { auto rr = __builtin_amdgcn_permlane32_swap(__float_as_uint(rm), __float_as_uint(rm), false, false); rm = fmaxf(__uint_as_float(rr[0]), __uint_as_float(rr[1])); } \
        if (__any(rm > mhat + 16.f)) { \
            const float mnew = fmaxf(mhat, rm), alpha = __builtin_amdgcn_exp2f(mhat - mnew); \
            lsum *= alpha; mhat = mnew; \
            _Pragma("unroll") for (int r = 0; r < 16; ++r) { o0[r] *= alpha; o1[r] *= alpha; } } \
        float sacc = 0.f; \
        _Pragma("unroll") for (int r = 0; r < 16; ++r) { P0[r] = __builtin_amdgcn_exp2f(P0[r] - mhat); P1[r] = __builtin_amdgcn_exp2f(P1[r] - mhat); sacc += P0[r] + P1[r]; } \
        lsum += sacc; \
        u32x4 pw[4]; \
        _Pragma("unroll") for (int s = 0; s < 2; ++s) { \
            pw[s]     = (u32x4){cvtpk_s(P0[8 * s], P0[8 * s + 1]), cvtpk_s(P0[8 * s + 2], P0[8 * s + 3]), cvtpk_s(P0[8 * s + 4], P0[8 * s + 5]), cvtpk_s(P0[8 * s + 6], P0[8 * s + 7])}; \
            pw[2 + s] = (u32x4){cvtpk_s(P1[8 * s], P1[8 * s + 1]), cvtpk_s(P1[8 * s + 2], P1[8 * s + 3]), cvtpk_s(P1[8 * s + 4], P1[8 * s + 5]), cvtpk_s(P1[8 * s + 6], P1[8 * s + 7])}; } \
        const LAS unsigned char* vp_ = lds + vb + bf_ * 8192; \
        _Pragma("unroll") for (int s = 0; s < 4; ++s) { \
            const bf16x8 pa = __builtin_bit_cast(bf16x8, pw[s]); \
            const bf16x8 v0 = vtr2(vp_ + s * 1024), v1 = vtr2(vp_ + 4096 + s * 1024); \
            o0 = __builtin_amdgcn_mfma_f32_32x32x16_bf16(v0, pa, o0, 0, 0, 0); \
            o1 = __builtin_amdgcn_mfma_f32_32x32x16_bf16(v1, pa, o1, 0, 0, 0); } } while (0)
#define AT_STEP(PAR, C0, C1, N0, N1, t_) do { \
        if ((t_) + 2 < NT) AT_LOADK((t_) + 2); if ((t_) + 1 < NT) AT_LOADV((t_) + 1); \
        const bool actN_ = ((t_) + 1 < NT) && (((t_) + 1) * 64 <= qw0), actC_ = ((t_) * 64 <= qw0); \
        __builtin_amdgcn_sched_barrier(0); \
        if (PAR == 0) { if (actN_) AT_QK(N0, N1, (t_) + 1, true); if (actC_) AT_SMPV(C0, C1, t_); } \
        else          { if (actC_) AT_SMPV(C0, C1, t_); if (actN_) AT_QK(N0, N1, (t_) + 1, true); } \
        __builtin_amdgcn_sched_barrier(0); \
        if ((t_) + 2 < NT) AT_STOREK((t_) & 1); if ((t_) + 1 < NT) AT_STOREV(((t_) + 1) & 1); \
        __syncthreads(); } while (0)
#define AT_STEADY(PAR, C0, C1, N0, N1, t_) do { \
        AT_LOADK((t_) + 2); AT_LOADV((t_) + 1); \
        __builtin_amdgcn_sched_barrier(0); \
        if (PAR == 0) { AT_QK(N0, N1, (t_) + 1, false); AT_SMPV(C0, C1, t_); } \
        else          { AT_SMPV(C0, C1, t_); AT_QK(N0, N1, (t_) + 1, false); } \
        __builtin_amdgcn_sched_barrier(0); \
        AT_STOREK((t_) & 1); AT_STOREV(((t_) + 1) & 1); \
        __syncthreads(); } while (0)
    f32x16 sa0, sa1, sb0, sb1;
    __syncthreads();
    AT_LOADK(0); AT_LOADV(0); AT_STOREK(0); AT_STOREV(0); AT_LOADK(1); AT_STOREK(1);
    __syncthreads();
    AT_QK(sa0, sa1, 0, true);
    __syncthreads();
    int t = 0;
    if (par == 0) {
        for (; t + 6 < NT; t += 2) { AT_STEADY(0, sa0, sa1, sb0, sb1, t); AT_STEADY(0, sb0, sb1, sa0, sa1, t + 1); }
        for (; t < NT; t += 2) { AT_STEP(0, sa0, sa1, sb0, sb1, t); AT_STEP(0, sb0, sb1, sa0, sa1, t + 1); }
    } else {
        for (; t + 6 < NT; t += 2) { AT_STEADY(1, sa0, sa1, sb0, sb1, t); AT_STEADY(1, sb0, sb1, sa0, sa1, t + 1); }
        for (; t < NT; t += 2) { AT_STEP(1, sa0, sa1, sb0, sb1, t); AT_STEP(1, sb0, sb1, sa0, sa1, t + 1); }
    }
#undef AT_LOADK
#undef AT_STOREK
#undef AT_LOADV
#undef AT_STOREV
#undef AT_QK
#undef AT_SMPV
#undef AT_STEP
#undef AT_STEADY
    float lt; { auto rr = __builtin_amdgcn_permlane32_swap(__float_as_uint(lsum), __float_as_uint(lsum), false, false); lt = __uint_as_float(rr[0]) + __uint_as_float(rr[1]); }
    const float rl = 1.f / lt;
    const size_t ob = (rowbase + qw0 + r32) * 1024 + (MLA ? 512 : 0) + h * 64 + 4 * hi;
#pragma unroll
    for (int g = 0; g < 4; ++g) {
        const u32x2 ga = *(const u32x2*)(GATE + ob + 8 * g), gb = *(const u32x2*)(GATE + ob + 32 + 8 * g);
        f32x4 a = (f32x4){o0[4 * g], o0[4 * g + 1], o0[4 * g + 2], o0[4 * g + 3]} * rl, c = (f32x4){o1[4 * g], o1[4 * g + 1], o1[4 * g + 2], o1[4 * g + 3]} * rl;
        a = a * (f32x4){__builtin_bit_cast(float, ga.x << 16), __builtin_bit_cast(float, ga.x & 0xffff0000u), __builtin_bit_cast(float, ga.y << 16), __builtin_bit_cast(float, ga.y & 0xffff0000u)};
        c = c * (f32x4){__builtin_bit_cast(float, gb.x << 16), __builtin_bit_cast(float, gb.x & 0xffff0000u), __builtin_bit_cast(float, gb.y << 16), __builtin_bit_cast(float, gb.y & 0xffff0000u)};
        *(u32x2*)(Y + ob + 8 * g) = pk4(a); *(u32x2*)(Y + ob + 32 + 8 * g) = pk4(c);
    }
}

template <int MODE>
__device__ __forceinline__ void transpose_item(const float* __restrict__ W, int K, int Nsrc, int Ndst, bf16_t* __restrict__ WT, const float* __restrict__ kscale, LAS float* scr, int item, int lane) {
    const int nblk = Ndst / 32, kb = item / nblk, nb = item % nblk, k0 = 64 * kb, n0 = 32 * nb;
    const int nd = n0 + (lane & 31); int ns = nd; bool valid = true;
    if (MODE == 1) { if (nd < 1536) ns = nd; else if (nd < 2976) ns = nd + 8; else if (nd < 2984) ns = nd - 1440; else { ns = 0; valid = false; } }
#pragma unroll 8
    for (int i = 0; i < 32; ++i) { const int kk = 2 * i + (lane >> 5); float v = valid ? W[(size_t)(k0 + kk) * Nsrc + ns] : 0.f; if (kscale) v *= kscale[k0 + kk]; scr[kk * 33 + (lane & 31)] = v; }
    LDS_WAIT();
    const int c = lane & 7;
#pragma unroll
    for (int j = 0; j < 4; ++j) { const int n = (lane >> 3) + 8 * j; const LAS float* s = scr + (8 * c) * 33 + n;
        u32x4 o; o.x = pk2(s[0 * 33], s[1 * 33]); o.y = pk2(s[2 * 33], s[3 * 33]); o.z = pk2(s[4 * 33], s[5 * 33]); o.w = pk2(s[6 * 33], s[7 * 33]);
        *(u32x4*)(WT + (size_t)(n0 + n) * K + k0 + 8 * c) = o; }
    LDS_WAIT();
}

struct Args { const void* in[14]; float* out; unsigned char* ws; };

__global__ void __launch_bounds__(512) mk_fwd(Args args) {
    extern __shared__ __attribute__((aligned(16))) unsigned char smem[];
    LAS unsigned char* lds = (LAS unsigned char*)smem;
    cg::grid_group grid = cg::this_grid();
    const int wave_s = __builtin_amdgcn_readfirstlane((int)threadIdx.x >> 6);
    const int G = gridDim.x, bx = blockIdx.x, NGW = G * 8;
    unsigned char* ws = args.ws; float* X = args.out;
    float* MOD = (float*)(ws + WS_MOD);
    unsigned* bar = (unsigned*)ws;
    volatile LAS unsigned* bst = (volatile LAS unsigned*)(lds + 131072);
    { const int t0 = otid(wave_s); if (t0 < 2) bst[t0] = 0u; __syncthreads(); if (t0 == 0) (void)xb_add(&bar[XB_XCNT(xb_xcc_id())], 1u); }
#define GRID_BAR() xcd_barrier(bar, bst, otid(wave_s))

    {
        const int tid = otid(wave_s), lane = tid & 63; const int wave = __builtin_amdgcn_readfirstlane(tid >> 6); const int gw = bx * 8 + wave;
        const float* c_in = (const float*)args.in[1]; const int* pos_in = (const int*)args.in[2];
        const float* w_ada = (const float*)args.in[4]; const float* b_ada = (const float*)args.in[5];
        const float* w_in = (const float*)args.in[6]; const float* q_norm_g = (const float*)args.in[8];
        const float* w_uq = (const float*)args.in[9]; const float* kv_norm_g = (const float*)args.in[10]; const float* w_ukv = (const float*)args.in[11];
        const float* w_out = (const float*)args.in[12];
        bf16_t* WIN = (bf16_t*)(ws + WS_WIN); bf16_t* WOUT = (bf16_t*)(ws + WS_WOUT); bf16_t* WUQ = (bf16_t*)(ws + WS_WUQ); bf16_t* WUKV = (bf16_t*)(ws + WS_WUKV);
        float* COS = (float*)(ws + WS_COS); float* SIN = (float*)(ws + WS_SIN);
        for (int unit = bx; unit < DEPTH * 48; unit += G) {
            LAS float* cact = (LAS float*)lds; LAS float* red = (LAS float*)(lds + 32768);
            const int l = unit / 48, n = (unit % 48) * 64 + lane;
            for (int i = tid; i < NB * DM; i += 512) cact[i] = silu_f(c_in[i]);
            __syncthreads();
            float a[8];
#pragma unroll
            for (int b = 0; b < 8; ++b) a[b] = 0.f;
            const float* wp = w_ada + ((size_t)l * DM + 128 * wave) * 3072 + n;
#pragma unroll 4
            for (int kk = 0; kk < 128; ++kk) { const float wv = wp[(size_t)kk * 3072];
#pragma unroll
                for (int b = 0; b < 8; ++b) a[b] += cact[b * DM + 128 * wave + kk] * wv; }
#pragma unroll
            for (int b = 0; b < 8; ++b) red[(wave * 8 + b) * 64 + lane] = a[b];
            __syncthreads();
            { float s = b_ada[l * 3072 + n];
#pragma unroll
              for (int w2 = 0; w2 < 8; ++w2) s += red[(w2 * 8 + wave) * 64 + lane];
              MOD[(size_t)(l * 8 + wave) * 3072 + n] = s; }
            __syncthreads();
        }
        { LAS float* scr = (LAS float*)(lds + 49152) + wave * (64 * 33);
          constexpr int I_IN = 16 * 96, I_OUT = 16 * 32, I_UQ = 4 * 24, I_UKV = 2 * 32, I_L = I_IN + I_OUT + I_UQ + I_UKV;
          for (int it = gw; it < DEPTH * I_L; it += NGW) {
              const int l = it / I_L; int r = it % I_L;
              if (r < I_IN) { transpose_item<1>(w_in + (size_t)l * DM * NIN, DM, NIN, NINP, WIN + (size_t)l * NINP * DM, nullptr, scr, r, lane); continue; } r -= I_IN;
              if (r < I_OUT) { transpose_item<0>(w_out + (size_t)l * DM * DM, DM, DM, DM, WOUT + (size_t)l * DM * DM, nullptr, scr, r, lane); continue; } r -= I_OUT;
              if (r < I_UQ) { transpose_item<0>(w_uq + (size_t)l * 256 * 768, 256, 768, 768, WUQ + (size_t)l * 768 * 256, q_norm_g + l * 256, scr, r, lane); continue; } r -= I_UQ;
              transpose_item<0>(w_ukv + (size_t)l * 128 * 1024, 128, 1024, 1024, WUKV + (size_t)l * 1024 * 128, kv_norm_g + l * 128, scr, r, lane);
          } }
        for (int idx = bx * 512 + tid; idx < MTOK * 16; idx += G * 512) {
            const int tok = idx >> 4, i = idx & 15;
            const float inv = 1.0f / powf(10000.0f, (float)(2 * i) * (1.0f / 32.0f));
            const float ang = (float)pos_in[tok] * inv; float sn, cs; sincosf(ang, &sn, &cs);
            COS[idx] = cs; SIN[idx] = sn;
        }
    }

    grid.sync();
    for (int l = 0; l <= DEPTH; ++l) {
        if (l > 0) GRID_BAR();
        {
            const int tid = otid(wave_s), lane = tid & 63; const int wave = __builtin_amdgcn_readfirstlane(tid >> 6); const int gw = bx * 8 + wave;
            const bool fin = (l == DEPTH);
            const float* xs = (l == 0) ? (const float*)args.in[0] : X; const float* gsrc = fin ? (const float*)args.in[13] : (const float*)args.in[3] + l * DM;
            bf16_t* H = (bf16_t*)(ws + WS_H);
            for (int r0 = gw * 16; r0 < MTOK; r0 += NGW * 16) {
                const int b = r0 >> 12;
                f32x4 gs[4], sh[4];
#pragma unroll
                for (int j = 0; j < 4; ++j) { const int col = 4 * lane + 256 * j; const f32x4 g = *(const f32x4*)(gsrc + col);
                    if (fin) { gs[j] = g; sh[j] = (f32x4){0.f, 0.f, 0.f, 0.f}; }
                    else { const f32x4 sc = *(const f32x4*)(MOD + (size_t)(l * 8 + b) * 3072 + 1024 + col); gs[j] = g * (sc + 1.0f); sh[j] = *(const f32x4*)(MOD + (size_t)(l * 8 + b) * 3072 + col); } }
                for (int rr = 0; rr < 16; ++rr) {
                    const size_t row = (size_t)(r0 + rr);
                    f32x4 v[4]; float ss = 0.f;
#pragma unroll
                    for (int j = 0; j < 4; ++j) { v[j] = *(const f32x4*)(xs + row * DM + 4 * lane + 256 * j); ss += (v[j][0] * v[j][0] + v[j][1] * v[j][1]) + (v[j][2] * v[j][2] + v[j][3] * v[j][3]); }
                    const float rstd = rsqrtf(wave_sum(ss, lane) * (1.f / DM) + EPS_);
                    if (fin) {
#pragma unroll
                        for (int j = 0; j < 4; ++j) *(f32x4*)(X + row * DM + 4 * lane + 256 * j) = v[j] * rstd * gs[j];
                    } else {
#pragma unroll
                        for (int j = 0; j < 4; ++j) *(u32x2*)(H + row * DM + 4 * lane + 256 * j) = pk4(v[j] * rstd * gs[j] + sh[j]);
                    }
                }
            }
        }
        if (l == DEPTH) break;
        GRID_BAR();
        {
            pg8::Gemm g{(const bf16_t*)(ws + WS_H), (const bf16_t*)(ws + WS_WIN) + (size_t)l * NINP * DM, MTOK, NINP, DM}; pg8::StaticOrder S; S.init(MTOK, NINP, G, bx);
            EpiIn E{ws, (const float*)args.in[7] + l * 8};
            pg8::gemm_phase<EpiIn, pg8::StaticOrder, true, true>(lds, g, S, E, wave_s);
        }
        GRID_BAR();
        {
            const int tid = otid(wave_s), lane = tid & 63; const int wave = __builtin_amdgcn_readfirstlane(tid >> 6);
            const float* LOGF = (const float*)(ws + WS_LOGF); float* CUM = (float*)(ws + WS_CUM);
            for (int u = bx; u < 64; u += G) {
                LAS float* wsum = (LAS float*)lds;
                const float* lf = LOGF + (size_t)(u >> 3) * SEQ * 8 + (u & 7);
                float v[8]; float s = 0.f;
#pragma unroll
                for (int i = 0; i < 8; ++i) { s += lf[(size_t)(8 * tid + i) * 8]; v[i] = s; }
                float incl = s;
#pragma unroll
                for (int off = 1; off < 64; off <<= 1) { const float t = shup(incl, off, lane); if (lane >= off) incl += t; }
                if (lane == 63) wsum[wave] = incl;
                __syncthreads();
                float base = 0.f;
                for (int w2 = 0; w2 < wave; ++w2) base += wsum[w2];
                const float excl = base + incl - s;
#pragma unroll
                for (int i = 0; i < 8; ++i) CUM[(size_t)u * SEQ + 8 * tid + i] = (excl + v[i]) * LOG2E;
                __syncthreads();
            }
        }
        { pg8::Gemm g{(const bf16_t*)(ws + WS_QLAT), (const bf16_t*)(ws + WS_WUQ) + (size_t)l * 768 * 256, MTOK, 768, 256}; pg8::StaticOrder S; S.init(MTOK, 768, G, bx);
          EpiQ E{ws};
          pg8::gemm_phase<EpiQ, pg8::StaticOrder, true, true>(lds, g, S, E, wave_s); }
        __syncthreads();
        { pg8::Gemm g{(const bf16_t*)(ws + WS_KVLAT), (const bf16_t*)(ws + WS_WUKV) + (size_t)l * 1024 * 128, MTOK, 1024, 128}; pg8::StaticOrder S; S.init(MTOK, 1024, G, bx);
          EpiKV E{ws};
          pg8::gemm_phase<EpiKV, pg8::StaticOrder, true, true>(lds, g, S, E, wave_s); }
        GRID_BAR();
        {
            const int vcu = (G % 8 == 0) ? (bx % 8) * (G / 8) + bx / 8 : bx;
            for (int u = vcu; u < 2048; u += G) {
                const int i = u & 255, j = u >> 8; const int bh = i >> 2, s = i & 3, jj = j & 3;
                const int qb = (jj == 0) ? 15 - s : (jj == 1) ? 8 + s : (jj == 2) ? 7 - s : s;
                if (j < 4) attn_unit<true>(lds, bh >> 3, bh & 7, qb, ws, wave_s);
                else attn_unit<false>(lds, bh >> 3, bh & 7, qb, ws, wave_s);
            }
        }
        GRID_BAR();
        {
            pg8::Gemm g{(const bf16_t*)(ws + WS_H), (const bf16_t*)(ws + WS_WOUT) + (size_t)l * DM * DM, MTOK, DM, DM}; pg8::StaticOrder S; S.init(MTOK, DM, G, bx);
            EpiOut E{l == 0 ? (const float*)args.in[0] : X, X, MOD + (size_t)l * 8 * 3072 + 2048};
            pg8::gemm_phase<EpiOut, pg8::StaticOrder, true, true>(lds, g, S, E, wave_s);
        }
    }
}

extern "C" void kernel_launch(void* const* d_in, const int* in_sizes, int n_in, void* d_out, int out_size, void* d_ws, size_t ws_size, hipStream_t stream) {
    static int grid = 0;
    if (grid == 0) {
        if (n_in != 14 || out_size != MTOK * DM || ws_size < WS_END) { fprintf(stderr, "kernel_launch: unexpected shapes (n_in %d, out %d, ws %zu)\n", n_in, out_size, ws_size); grid = -1; return; }
        int dev = 0, cus = 0, per_cu = 0;
        (void)hipGetDevice(&dev); (void)hipDeviceGetAttribute(&cus, hipDeviceAttributeMultiprocessorCount, dev);
        (void)hipFuncSetAttribute((const void*)mk_fwd, hipFuncAttributeMaxDynamicSharedMemorySize, LDS_BYTES);
        if (hipOccupancyMaxActiveBlocksPerMultiprocessor(&per_cu, (const void*)mk_fwd, 512, LDS_BYTES) != hipSuccess || per_cu < 1) per_cu = 1;
        (void)hipGetLastError();
        grid = cus * per_cu;
    }
    if (grid < 0) return;
    (void)hipMemsetAsync(d_ws, 0, 16384, stream);
    Args a{};
    for (int i = 0; i < 14; ++i) a.in[i] = d_in[i];
    a.out = (float*)d_out; a.ws = (unsigned char*)d_ws;
    void* kargs[] = {&a};
    hipError_t e = hipLaunchCooperativeKernel((const void*)mk_fwd, dim3(grid), dim3(512), kargs, LDS_BYTES, stream);
    if (e != hipSuccess) fprintf(stderr, "cooperative launch failed: %s (grid %d)\n", hipGetErrorString(e), grid);
}
```

```cpp
#include <hip/hip_runtime.h>
#include <hip/hip_cooperative_groups.h>
#include <cstdio>
#include <cstdint>
#include <cmath>
namespace cg = cooperative_groups;
__device__ __forceinline__ int otid(int wave_s) { int l; asm volatile("v_mbcnt_lo_u32_b32 %0, -1, 0\n\tv_mbcnt_hi_u32_b32 %0, -1, %0" : "=v"(l)); int w = wave_s; asm volatile("" : "+s"(w)); return (w << 6) | l; }
namespace pg8 {
#define PG8_LAS __attribute__((address_space(3)))
typedef unsigned short bf16_t;
typedef short bf16x8 __attribute__((ext_vector_type(8)));
typedef float f32x4 __attribute__((ext_vector_type(4)));
typedef unsigned u32x4 __attribute__((ext_vector_type(4)));
constexpr int BM = 256, BK = 64, HALF = 128, HTB = HALF * BK * 2  , STAGE_BYTES = 8 * HTB, NXCD = 8, WGM = 8;

__host__ __device__ __forceinline__ int lds_byte(int r, int c) { const int st = (r >> 4) * 2 + (c >> 5), rr = r & 15, cc = c & 31, ob = rr * 64 + cc * 2; return st * 1024 + (ob ^ (((ob >> 9) & 1) << 5)); }
__host__ __device__ __forceinline__ void stage_rc(int b, int& R, int& C) { const int st = b / 1024, sb = b % 1024, swz = sb ^ (((sb >> 9) & 1) << 5); R = (st >> 1) * 16 + swz / 64; C = (st & 1) * 32 + (swz % 64) / 2; }
__host__ __device__ __forceinline__ int perm32(int rho) { const int n = rho >> 4, i = rho & 15; return 8 * (i >> 2) + 4 * n + (i & 3); }

struct Unit { int pm, pn; };
struct Gemm { const bf16_t* A; const bf16_t* Bt; int M, N, K; };

struct StaticOrder {
    int nM, nN, nwg, G, c;
    __host__ __device__ void init(int M, int N, int G_, int c_) { nM = M / BM; nN = N / BM; nwg = nM * nN; G = G_; c = c_; }
    __host__ __device__ bool next(int i, Unit& u) const {
        const long L = (long)i * G + c; if (L >= nwg) return false;
        int wgid = (int)L; { const int q = nwg / NXCD, r = nwg % NXCD, xcd = wgid % NXCD, off = wgid / NXCD; wgid = (xcd < r ? xcd * (q + 1) : r * (q + 1) + (xcd - r) * q) + off; }
        const int nig = WGM * nN, gid = wgid / nig, fm = gid * WGM, gsz = (nM - fm) < WGM ? (nM - fm) : WGM;
        u.pm = fm + ((wgid % nig) % gsz); u.pn = (wgid % nig) / gsz; return true;
    }
    __device__ __forceinline__ void a_ready(const Unit&) const {}
    __device__ __forceinline__ void done(const Unit&) const {}
};

__device__ __forceinline__ unsigned cvt_pk_bf16(float lo, float hi) { unsigned r; asm volatile("v_cvt_pk_bf16_f32 %0, %1, %2" : "=v"(r) : "v"(lo), "v"(hi)); return r; }
template <class Epi, class Sched, bool ALIGN_EPI = false, bool SP2 = false>
__device__ __forceinline__ void gemm_phase(PG8_LAS unsigned char* lds, const Gemm g, const Sched& S, const Epi& E, int wave_s) {
    const int tid = otid(wave_s), wid = __builtin_amdgcn_readfirstlane(tid >> 6), lane = tid & 63, wr = wid >> 2, wc = wid & 3, fr = lane & 15, fq = lane >> 4;
    const int K = g.K, nt = K / BK;
    unsigned voffA[2], voffB[2];
#pragma unroll
    for (int i = 0; i < 2; ++i) { int R, C; stage_rc(tid * 16 + i * 8192, R, C); const int Rb = Epi::PERM ? ((R & ~31) + perm32(R & 31)) : R;
        voffA[i] = (unsigned)(R * K + C) * 2u; voffB[i] = (unsigned)(Rb * K + C) * 2u; }
    const size_t kstep = (size_t)(BK * 2);
    const size_t hstep = (size_t)HALF * K * 2;
    const size_t tstep = 2 * hstep;
    const unsigned ldsw = (unsigned)wid * 1024u;
    const int aoff = lds_byte(wr * 64 + fr, fq * 8), boff = lds_byte(wc * 32 + fr, fq * 8);
#define PG8_SA(b, h) (((b) * 2 + (h)) * HTB)
#define PG8_SB(b, h) ((4 + (b) * 2 + (h)) * HTB)
#define PG8_STAGE(bufoff, gbase, voff) do { _Pragma("unroll") for (int _i = 0; _i < 2; ++_i) \
        __builtin_amdgcn_global_load_lds((const unsigned*)((const char*)(gbase) + (voff)[_i]), (PG8_LAS unsigned*)(lds + (bufoff) + ldsw + _i * 8192), 16, 0, 0); } while (0)
#define PG8_LDA(dst, b, h) do { _Pragma("unroll") for (int m = 0; m < 4; ++m) _Pragma("unroll") for (int k = 0; k < 2; ++k) dst[m][k] = *(const PG8_LAS bf16x8*)(lds + PG8_SA(b, h) + aoff + m * 2048 + k * 1024); } while (0)
#define PG8_LDB(dst, b, h) do { _Pragma("unroll") for (int n = 0; n < 2; ++n) _Pragma("unroll") for (int k = 0; k < 2; ++k) dst[n][k] = *(const PG8_LAS bf16x8*)(lds + PG8_SB(b, h) + boff + n * 2048 + k * 1024); } while (0)
#define PG8_MMA(ai, bj, At, Bt) do { __builtin_amdgcn_s_setprio(1); _Pragma("unroll") for (int m = 0; m < 4; ++m) _Pragma("unroll") for (int n = 0; n < 2; ++n) _Pragma("unroll") for (int k = 0; k < 2; ++k) \
        acc[ai][bj][m][n] = __builtin_amdgcn_mfma_f32_16x16x32_bf16(Bt[n][k], At[m][k], acc[ai][bj][m][n], 0, 0, 0); __builtin_amdgcn_s_setprio(0); } while (0)
#define PG8_WAIT_V(n) asm volatile("s_waitcnt vmcnt(" #n ")" ::: "memory")
#define PG8_WAIT_L(n) asm volatile("s_waitcnt lgkmcnt(" #n ")" ::: "memory")
#define PG8_BAR __builtin_amdgcn_s_barrier()
#define PG8_SCHED __builtin_amdgcn_sched_barrier(0)
    Unit cur, nxt; int ui = 0;
    if (!S.next(0, cur)) return;
    f32x4 acc[2][2][4][2];
#pragma unroll
    for (int a = 0; a < 2; ++a)
#pragma unroll
        for (int b = 0; b < 2; ++b)
#pragma unroll
            for (int m = 0; m < 4; ++m)
#pragma unroll
                for (int n = 0; n < 2; ++n) acc[a][b][m][n] = (f32x4){0.f, 0.f, 0.f, 0.f};
    bf16x8 At[4][2], B0[2][2], B1[2][2];
    const char* cA = (const char*)g.A + (size_t)cur.pm * tstep; const char* cB = (const char*)g.Bt + (size_t)cur.pn * tstep;
    S.a_ready(cur);
    if constexpr (SP2) {
        PG8_STAGE(PG8_SB(0, 0), cB, voffB); PG8_STAGE(PG8_SB(0, 1), cB + hstep, voffB); PG8_STAGE(PG8_SA(0, 0), cA, voffA); PG8_STAGE(PG8_SA(0, 1), cA + hstep, voffA);
        if (wr == 1) PG8_BAR;
        PG8_WAIT_V(2); PG8_BAR;
        PG8_STAGE(PG8_SB(1, 0), cB + kstep, voffB); PG8_STAGE(PG8_SA(1, 0), cA + kstep, voffA); PG8_STAGE(PG8_SB(1, 1), cB + hstep + kstep, voffB);
        PG8_WAIT_V(6); PG8_BAR;
    } else {
        PG8_STAGE(PG8_SB(0, 0), cB, voffB); PG8_STAGE(PG8_SA(0, 0), cA, voffA); PG8_STAGE(PG8_SB(0, 1), cB + hstep, voffB); PG8_STAGE(PG8_SA(0, 1), cA + hstep, voffA);
        if (wr == 1) PG8_BAR;
        PG8_WAIT_V(4); PG8_BAR;
        PG8_STAGE(PG8_SB(1, 0), cB + kstep, voffB); PG8_STAGE(PG8_SA(1, 0), cA + kstep, voffA); PG8_STAGE(PG8_SB(1, 1), cB + hstep + kstep, voffB);
        PG8_WAIT_V(6); PG8_BAR;
    }
    for (;;) {
        const bool has_next = S.next(ui + 1, nxt);
        const char* nA = has_next ? (const char*)g.A + (size_t)nxt.pm * tstep : cA; const char* nB = has_next ? (const char*)g.Bt + (size_t)nxt.pn * tstep : cB;
        for (int t = 0; t < nt; t += 2) {
            const bool last = (t == nt - 2);
            const char* a1 = cA + (size_t)(t + 1) * kstep;
            const char* a2 = last ? nA : cA + (size_t)(t + 2) * kstep; const char* b2 = last ? nB : cB + (size_t)(t + 2) * kstep;
            const char* a3 = a2 + kstep; const char* b3 = b2 + kstep;
            if (last && has_next) S.a_ready(nxt);
            if constexpr (SP2) {
            PG8_LDB(B0, 0, 0); PG8_LDB(B1, 0, 1); PG8_SCHED; PG8_LDA(At, 0, 0); PG8_STAGE(PG8_SA(1, 1), a1 + hstep, voffA);
            PG8_WAIT_V(8); PG8_WAIT_L(0); PG8_BAR; PG8_MMA(0, 0, At, B0); PG8_MMA(0, 1, At, B1); PG8_BAR; PG8_SCHED;
            PG8_LDA(At, 0, 1); PG8_STAGE(PG8_SB(0, 0), b2, voffB); PG8_STAGE(PG8_SB(0, 1), b2 + hstep, voffB); PG8_STAGE(PG8_SA(0, 0), a2, voffA);
            PG8_WAIT_V(8); PG8_WAIT_L(0); PG8_BAR; PG8_MMA(1, 0, At, B0); PG8_MMA(1, 1, At, B1); PG8_BAR; PG8_SCHED;
            PG8_LDB(B0, 1, 0); PG8_LDB(B1, 1, 1); PG8_SCHED; PG8_LDA(At, 1, 0); PG8_STAGE(PG8_SA(0, 1), a2 + hstep, voffA);
            PG8_WAIT_V(8); PG8_WAIT_L(0); PG8_BAR; PG8_MMA(0, 0, At, B0); PG8_MMA(0, 1, At, B1); PG8_BAR; PG8_SCHED;
            PG8_LDA(At, 1, 1); PG8_STAGE(PG8_SB(1, 0), b3, voffB); PG8_STAGE(PG8_SB(1, 1), b3 + hstep, voffB); PG8_STAGE(PG8_SA(1, 0), a3, voffA);
            PG8_WAIT_V(8); PG8_WAIT_L(0); PG8_BAR; PG8_MMA(1, 0, At, B0); PG8_MMA(1, 1, At, B1); PG8_BAR; PG8_SCHED;
            } else {
            PG8_LDB(B0, 0, 0); PG8_SCHED; PG8_LDA(At, 0, 0); PG8_STAGE(PG8_SA(1, 1), a1 + hstep, voffA);
            PG8_WAIT_L(8); PG8_BAR; PG8_WAIT_L(0); PG8_MMA(0, 0, At, B0); PG8_BAR; PG8_SCHED;
            PG8_LDB(B1, 0, 1); PG8_STAGE(PG8_SB(0, 0), b2, voffB);
            PG8_BAR; PG8_WAIT_L(0); PG8_MMA(0, 1, At, B1); PG8_BAR;
            PG8_LDA(At, 0, 1); PG8_STAGE(PG8_SA(0, 0), a2, voffA);
            PG8_BAR; PG8_WAIT_L(0); PG8_MMA(1, 0, At, B0); PG8_BAR; PG8_SCHED;
            PG8_STAGE(PG8_SB(0, 1), b2 + hstep, voffB);
            PG8_WAIT_V(6); PG8_BAR; PG8_MMA(1, 1, At, B1); PG8_BAR;
            PG8_LDB(B0, 1, 0); PG8_SCHED; PG8_LDA(At, 1, 0); PG8_STAGE(PG8_SA(0, 1), a2 + hstep, voffA);
            PG8_WAIT_L(8); PG8_BAR; PG8_WAIT_L(0); PG8_MMA(0, 0, At, B0); PG8_BAR; PG8_SCHED;
            PG8_LDB(B1, 1, 1); PG8_STAGE(PG8_SB(1, 0), b3, voffB);
            PG8_BAR; PG8_WAIT_L(0); PG8_MMA(0, 1, At, B1); PG8_BAR;
            PG8_LDA(At, 1, 1); PG8_STAGE(PG8_SA(1, 0), a3, voffA);
            PG8_BAR; PG8_WAIT_L(0); PG8_MMA(1, 0, At, B0); PG8_BAR; PG8_SCHED;
            PG8_STAGE(PG8_SB(1, 1), b3 + hstep, voffB);
            PG8_WAIT_V(6); PG8_BAR; PG8_MMA(1, 1, At, B1); PG8_BAR;
            }
        }
        if constexpr (ALIGN_EPI) { if (wr == 0) PG8_BAR; }
        if constexpr (!Epi::AFTER_DRAIN) { int fr2 = fr, fq2 = fq; asm volatile("" : "+v"(fr2), "+v"(fq2)); E(acc, cur, wr, wc, fr2, fq2); S.done(cur); }
        if (!has_next) break;
#pragma unroll
        for (int a = 0; a < 2; ++a)
#pragma unroll
            for (int b = 0; b < 2; ++b)
#pragma unroll
                for (int m = 0; m < 4; ++m)
#pragma unroll
                    for (int n = 0; n < 2; ++n) acc[a][b][m][n] = (f32x4){0.f, 0.f, 0.f, 0.f};
        cur = nxt; cA = nA; cB = nB; ++ui;
        if constexpr (ALIGN_EPI) { if (wr == 1) PG8_BAR; }
    }
    PG8_WAIT_V(0);
    if constexpr (!ALIGN_EPI) { if (wr == 0) PG8_BAR; }
    PG8_BAR;
    if constexpr (Epi::AFTER_DRAIN) { E.fused(acc, cur, wr, wc, fr, fq, lds, wid, lane); S.done(cur); }
#undef PG8_SA
#undef PG8_SB
#undef PG8_STAGE
#undef PG8_LDA
#undef PG8_LDB
#undef PG8_MMA
#undef PG8_WAIT_V
#undef PG8_WAIT_L
#undef PG8_BAR
#undef PG8_SCHED
}
}

#define LAS __attribute__((address_space(3)))
typedef unsigned short bf16_t;
typedef short bf16x8 __attribute__((ext_vector_type(8)));
typedef float f32x4 __attribute__((ext_vector_type(4)));
typedef float f32x16 __attribute__((ext_vector_type(16)));
typedef unsigned u32x4 __attribute__((ext_vector_type(4)));
typedef unsigned u32x2 __attribute__((ext_vector_type(2)));
typedef short v4i16_t __attribute__((ext_vector_type(4)));

constexpr int NB = 8, SEQ = 4096, DM = 1024, DEPTH = 4, MTOK = NB * SEQ, NIN = 2984, NINP = 3072;
constexpr float EPS_ = 1e-6f, LOG2E = 1.4426950408889634f;
constexpr float C2F = 0.125f * LOG2E;
constexpr float C2M = 0.10206207261596575f * LOG2E;
constexpr int LDS_BYTES = 132096;

constexpr size_t MiB = 1u << 20;
constexpr size_t WS_WIN = 2 * MiB, WS_WOUT = 26 * MiB, WS_WUQ = 34 * MiB, WS_WUKV = 36 * MiB, WS_MOD = 37 * MiB, WS_COS = 38 * MiB, WS_SIN = 40 * MiB,
                 WS_LOGF = 42 * MiB, WS_CUM = 43 * MiB, WS_SSQQ = 44 * MiB, WS_SSQK = 45 * MiB, WS_H = 48 * MiB, WS_QF = 112 * MiB, WS_KF = 144 * MiB,
                 WS_VF = 176 * MiB, WS_GATE = 208 * MiB, WS_QLAT = 272 * MiB, WS_KVLAT = 288 * MiB, WS_KR = 296 * MiB, WS_QM = 298 * MiB, WS_KM = 346 * MiB,
                 WS_VM = 378 * MiB, WS_END = 410 * MiB;

__device__ __forceinline__ unsigned f2bf(float f) { unsigned u = __builtin_bit_cast(unsigned, f); return (u + 0x7fffu + ((u >> 16) & 1u)) >> 16; }
typedef float f32x2_t __attribute__((ext_vector_type(2))); typedef __bf16 bf16x2_t __attribute__((ext_vector_type(2)));
__device__ __forceinline__ unsigned cvtpk_s(float lo, float hi) { f32x2_t v = {lo, hi}; bf16x2_t b = __builtin_convertvector(v, bf16x2_t); return __builtin_bit_cast(unsigned, b); }
__device__ __forceinline__ unsigned pk2(float lo, float hi) { return cvtpk_s(lo, hi); }
__device__ __forceinline__ float bf2f(bf16_t v) { return __builtin_bit_cast(float, (unsigned)v << 16); }
__device__ __forceinline__ u32x2 pk4(f32x4 v) { u32x2 w; w.x = pk2(v[0], v[1]); w.y = pk2(v[2], v[3]); return w; }
__device__ __forceinline__ float silu_f(float v) { return v / (1.f + __expf(-v)); }
__device__ __forceinline__ f32x4 silu4(f32x4 v) { return (f32x4){silu_f(v[0]), silu_f(v[1]), silu_f(v[2]), silu_f(v[3])}; }
__device__ __forceinline__ float logsig_f(float x) { return fminf(x, 0.f) - log1pf(expf(-fabsf(x))); }
__device__ __forceinline__ float shx(float v, int mask, int lane) { return __builtin_bit_cast(float, __builtin_amdgcn_ds_bpermute((lane ^ mask) << 2, __builtin_bit_cast(int, v))); }
__device__ __forceinline__ float shup(float v, int off, int lane) { return __builtin_bit_cast(float, __builtin_amdgcn_ds_bpermute(((lane - off) & 63) << 2, __builtin_bit_cast(int, v))); }
__device__ __forceinline__ float wave_sum(float v, int lane) {
#pragma unroll
    for (int o = 1; o < 64; o <<= 1) v += shx(v, o, lane);
    return v;
}
#define LDS_WAIT() asm volatile("s_waitcnt lgkmcnt(0)" ::: "memory")


#define XB_TMO      128
#define XB_XCNT(j)  (256  + 64 * (j))
#define XB_XSUB(j)  (1280 + 64 * (j))
#define XB_XGEN(j)  (2304 + 64 * (j))
#define XB_TOP      3328
#define XB_TOPGEN   3392
#define XCD_BAR_WORDS 3456
#define XB_SPIN_CAP (1u << 18)
__device__ __forceinline__ unsigned xb_ld(unsigned* p)              { return __hip_atomic_load(p, __ATOMIC_RELAXED, __HIP_MEMORY_SCOPE_AGENT); }
__device__ __forceinline__ unsigned xb_add(unsigned* p, unsigned v) { return __hip_atomic_fetch_add(p, v, __ATOMIC_RELAXED, __HIP_MEMORY_SCOPE_AGENT); }
__device__ __forceinline__ unsigned xb_xcc_id() { return (unsigned)__builtin_amdgcn_s_getreg((3 << 11) | 20) & 0xFu; }
#define XB_SPIN(cond, bar) do { unsigned _sp = 0; while (cond) { __builtin_amdgcn_s_sleep(1); \
    if ((++_sp & 255u) == 0u) { if (xb_ld(&(bar)[XB_TMO])) break; if (_sp > XB_SPIN_CAP) { atomicAdd(&(bar)[XB_TMO], 1u); break; } } } } while (0)
__device__ __forceinline__ void xcd_barrier_complete(unsigned* bar, unsigned x, unsigned& nloc, unsigned& nx) {
    const unsigned G = gridDim.x * gridDim.y * gridDim.z;
    unsigned sum, cnt, mine, sp = 0u;
    for (;;) {
        sum = 0u; cnt = 0u; mine = 0u;
#pragma unroll
        for (unsigned j = 0; j < 16; ++j) { const unsigned c = xb_ld(&bar[XB_XCNT(j)]); sum += c; cnt += (c > 0u) ? 1u : 0u; mine = (j == x) ? c : mine; }
        if (sum == G) break;
        __builtin_amdgcn_s_sleep(1);
        if ((++sp & 255u) == 0u) { if (xb_ld(&bar[XB_TMO])) break; if (sp > XB_SPIN_CAP) { atomicAdd(&bar[XB_TMO], 1u); break; } }
    }
    nloc = mine > 0u ? mine : 1u; nx = cnt > 0u ? cnt : 1u;
}
__device__ __forceinline__ void xcd_barrier(unsigned* bar, volatile LAS unsigned* st, int tid) {
    asm volatile("s_waitcnt vmcnt(0)" ::: "memory");
    __syncthreads();
    if (tid == 0) {
        const unsigned x = xb_xcc_id();
        __builtin_amdgcn_s_waitcnt(0);
        unsigned nloc = st[0], nx = st[1];
        if (nloc == 0u) { xcd_barrier_complete(bar, x, nloc, nx); st[0] = nloc; st[1] = nx; }
        const unsigned old = xb_add(&bar[XB_XSUB(x)], 1u);
        const unsigned gen = old / nloc;
        if (old + 1u == (gen + 1u) * nloc) {
            __builtin_amdgcn_fence(__ATOMIC_RELEASE, "agent");
            asm volatile("s_waitcnt vmcnt(0)" ::: "memory");
            const unsigned og = xb_add(&bar[XB_TOP], 1u);
            const unsigned tg = og / nx;
            if (og + 1u == (tg + 1u) * nx) xb_add(&bar[XB_TOPGEN], 1u);
            else XB_SPIN(xb_ld(&bar[XB_TOPGEN]) == tg, bar);
            __builtin_amdgcn_fence(__ATOMIC_ACQUIRE, "agent");
            xb_add(&bar[XB_XGEN(x)], 1u);
            asm volatile("s_waitcnt vmcnt(0)" ::: "memory");
        } else {
            XB_SPIN(xb_ld(&bar[XB_XGEN(x)]) == gen, bar);
            __builtin_amdgcn_fence(__ATOMIC_ACQUIRE, "agent");
            asm volatile("s_waitcnt vmcnt(0)" ::: "memory");
        }
    }
    __syncthreads();
}

using pg8::Unit;
struct EpiIn {
    static constexpr bool PERM = false, AFTER_DRAIN = false;
    unsigned char* ws; const float* BF;
    __device__ __forceinline__ void operator()(const f32x4 (&acc)[2][2][4][2], const Unit& u, int wr, int wc, int fr, int fq) const {
        const int row0 = u.pm * 256 + wr * 64 + fr;
        bf16_t* QF = (bf16_t*)(ws + WS_QF); bf16_t* GATE = (bf16_t*)(ws + WS_GATE); bf16_t* QLAT = (bf16_t*)(ws + WS_QLAT); bf16_t* KVLAT = (bf16_t*)(ws + WS_KVLAT); bf16_t* KR = (bf16_t*)(ws + WS_KR);
        float* LOGF = (float*)(ws + WS_LOGF); float* SSQQ = (float*)(ws + WS_SSQQ); float* SSQK = (float*)(ws + WS_SSQK); const float* COS = (const float*)(ws + WS_COS); const float* SIN = (const float*)(ws + WS_SIN);
        if (u.pn == 8) {
#pragma unroll
            for (int ai = 0; ai < 2; ++ai)
#pragma unroll
                for (int m = 0; m < 4; ++m) {
                    float s = 0.f;
#pragma unroll
                    for (int bj = 0; bj < 2; ++bj)
#pragma unroll
                        for (int n = 0; n < 2; ++n) { const f32x4 x = acc[ai][bj][m][n]; s += (x[0] * x[0] + x[1] * x[1]) + (x[2] * x[2] + x[3] * x[3]); }
                    s += shx(s, 16, fq * 16 + fr); s += shx(s, 32, fq * 16 + fr);
                    if (fq == 0) SSQQ[(size_t)(row0 + ai * 128 + m * 16) * 4 + wc] = s;
                }
        } else if (u.pn == 9) {
#pragma unroll
            for (int ai = 0; ai < 2; ++ai)
#pragma unroll
                for (int m = 0; m < 4; ++m) {
                    float s = 0.f;
#pragma unroll
                    for (int n = 0; n < 2; ++n) { const f32x4 x = acc[ai][0][m][n]; s += (x[0] * x[0] + x[1] * x[1]) + (x[2] * x[2] + x[3] * x[3]); }
                    s += shx(s, 16, fq * 16 + fr); s += shx(s, 32, fq * 16 + fr);
                    if (fq == 0) SSQK[(size_t)(row0 + ai * 128 + m * 16) * 4 + wc] = s;
                }
        }
#pragma unroll
        for (int bj = 0; bj < 2; ++bj) {
            const int gcol = u.pn * 256 + bj * 128 + wc * 32;
            if (gcol < 1536) {
                const int seg = gcol >> 9; bf16_t* base = QF + (size_t)seg * ((WS_KF - WS_QF) / 2); const float sc = seg == 0 ? C2F : 1.f; const int c0 = (gcol & 511) + 4 * fq;
#pragma unroll
                for (int ai = 0; ai < 2; ++ai)
#pragma unroll
                    for (int m = 0; m < 4; ++m) { bf16_t* rp = base + (size_t)(row0 + ai * 128 + m * 16) * 512 + c0;
#pragma unroll
                        for (int n = 0; n < 2; ++n) *(u32x2*)(rp + 16 * n) = pk4(acc[ai][bj][m][n] * sc); }
            } else if (gcol < 2048 || (gcol >= 2464 && gcol < 2976)) {
                const int c0 = (gcol < 2048 ? gcol - 1536 : gcol - 2464 + 512) + 4 * fq;
#pragma unroll
                for (int ai = 0; ai < 2; ++ai)
#pragma unroll
                    for (int m = 0; m < 4; ++m) { bf16_t* rp = GATE + (size_t)(row0 + ai * 128 + m * 16) * 1024 + c0;
#pragma unroll
                        for (int n = 0; n < 2; ++n) *(u32x2*)(rp + 16 * n) = pk4(silu4(acc[ai][bj][m][n])); }
            } else if (gcol < 2304) {
                const int c0 = gcol - 2048 + 4 * fq;
#pragma unroll
                for (int ai = 0; ai < 2; ++ai)
#pragma unroll
                    for (int m = 0; m < 4; ++m) { bf16_t* rp = QLAT + (size_t)(row0 + ai * 128 + m * 16) * 256 + c0;
#pragma unroll
                        for (int n = 0; n < 2; ++n) *(u32x2*)(rp + 16 * n) = pk4(acc[ai][bj][m][n]); }
            } else if (gcol < 2432) {
                const int c0 = gcol - 2304 + 4 * fq;
#pragma unroll
                for (int ai = 0; ai < 2; ++ai)
#pragma unroll
                    for (int m = 0; m < 4; ++m) { bf16_t* rp = KVLAT + (size_t)(row0 + ai * 128 + m * 16) * 128 + c0;
#pragma unroll
                        for (int n = 0; n < 2; ++n) *(u32x2*)(rp + 16 * n) = pk4(acc[ai][bj][m][n]); }
            } else if (gcol < 2464) {
#pragma unroll
                for (int ai = 0; ai < 2; ++ai)
#pragma unroll
                    for (int m = 0; m < 4; ++m) { const size_t row = (size_t)(row0 + ai * 128 + m * 16);
                        const f32x4 cs = *(const f32x4*)(COS + row * 16 + 4 * fq), sn = *(const f32x4*)(SIN + row * 16 + 4 * fq);
                        const f32x4 t1 = acc[ai][bj][m][0], t2 = acc[ai][bj][m][1];
                        const f32x4 o1 = t1 * cs - t2 * sn, o2 = t2 * cs + t1 * sn;
                        bf16_t* rp = KR + row * 32 + 4 * fq; *(u32x2*)(rp) = pk4(o1); *(u32x2*)(rp + 16) = pk4(o2); if (m & 1) asm volatile("" ::: "memory"); }
            } else if (gcol == 2976) {
                if (fq < 2) {
                    const f32x4 bfv = *(const f32x4*)(BF + 4 * fq);
#pragma unroll
                    for (int ai = 0; ai < 2; ++ai)
#pragma unroll
                        for (int m = 0; m < 4; ++m) { const size_t row = (size_t)(row0 + ai * 128 + m * 16); const f32x4 v = acc[ai][bj][m][0] + bfv;
                            *(f32x4*)(LOGF + row * 8 + 4 * fq) = (f32x4){logsig_f(v[0]), logsig_f(v[1]), logsig_f(v[2]), logsig_f(v[3])}; }
                }
            }
        }
    }
};
struct EpiQ {
    static constexpr bool PERM = false, AFTER_DRAIN = false;
    unsigned char* ws;
    __device__ __forceinline__ void operator()(const f32x4 (&acc)[2][2][4][2], const Unit& u, int wr, int wc, int fr, int fq) const {
        const int row0 = u.pm * 256 + wr * 64 + fr;
        const float* SSQ = (const float*)(ws + WS_SSQQ); const float* COS = (const float*)(ws + WS_COS); const float* SIN = (const float*)(ws + WS_SIN); bf16_t* QM = (bf16_t*)(ws + WS_QM);
        float rs[2][4];
#pragma unroll
        for (int ai = 0; ai < 2; ++ai)
#pragma unroll
            for (int m = 0; m < 4; ++m) { const f32x4 s = *(const f32x4*)(SSQ + (size_t)(row0 + ai * 128 + m * 16) * 4); rs[ai][m] = rsqrtf(((s[0] + s[1]) + (s[2] + s[3])) * (1.f / 256.f) + EPS_) * C2M; }
#pragma unroll
        for (int bj = 0; bj < 2; ++bj) {
            const int gcol = u.pn * 256 + bj * 128 + wc * 32; const bool rope = ((gcol >> 5) % 3) == 2;
#pragma unroll
            for (int ai = 0; ai < 2; ++ai)
#pragma unroll
                for (int m = 0; m < 4; ++m) { const size_t row = (size_t)(row0 + ai * 128 + m * 16);
                    f32x4 v0 = acc[ai][bj][m][0] * rs[ai][m], v1 = acc[ai][bj][m][1] * rs[ai][m];
                    if (rope) { const f32x4 cs = *(const f32x4*)(COS + row * 16 + 4 * fq), sn = *(const f32x4*)(SIN + row * 16 + 4 * fq);
                        const f32x4 o1 = v0 * cs - v1 * sn, o2 = v1 * cs + v0 * sn; v0 = o1; v1 = o2; }
                    bf16_t* rp = QM + row * 768 + gcol + 4 * fq; *(u32x2*)(rp) = pk4(v0); *(u32x2*)(rp + 16) = pk4(v1); if (m & 1) asm volatile("" ::: "memory"); }
        }
    }
};
struct EpiKV {
    static constexpr bool PERM = false, AFTER_DRAIN = false;
    unsigned char* ws;
    __device__ __forceinline__ void operator()(const f32x4 (&acc)[2][2][4][2], const Unit& u, int wr, int wc, int fr, int fq) const {
        const int row0 = u.pm * 256 + wr * 64 + fr;
        const float* SSQ = (const float*)(ws + WS_SSQK); bf16_t* KM = (bf16_t*)(ws + WS_KM);
        float rs[2][4];
#pragma unroll
        for (int ai = 0; ai < 2; ++ai)
#pragma unroll
            for (int m = 0; m < 4; ++m) { const f32x4 s = *(const f32x4*)(SSQ + (size_t)(row0 + ai * 128 + m * 16) * 4); rs[ai][m] = rsqrtf(((s[0] + s[1]) + (s[2] + s[3])) * (1.f / 128.f) + EPS_); }
#pragma unroll
        for (int bj = 0; bj < 2; ++bj) {
            const int gcol = u.pn * 256 + bj * 128 + wc * 32; const int head = gcol >> 7, within = gcol & 127;
            bf16_t* base = KM + (within < 64 ? (size_t)0 : (size_t)((WS_VM - WS_KM) / 2)); const int c0 = head * 64 + (within & 63) + 4 * fq;
#pragma unroll
            for (int ai = 0; ai < 2; ++ai)
#pragma unroll
                for (int m = 0; m < 4; ++m) { bf16_t* rp = base + (size_t)(row0 + ai * 128 + m * 16) * 512 + c0;
#pragma unroll
                    for (int n = 0; n < 2; ++n) *(u32x2*)(rp + 16 * n) = pk4(acc[ai][bj][m][n] * rs[ai][m]); }
        }
    }
};
struct EpiOut {
    static constexpr bool PERM = false, AFTER_DRAIN = false;
    const float* XIN; float* XOUT; const float* MODG;
    __device__ __forceinline__ void operator()(const f32x4 (&acc)[2][2][4][2], const Unit& u, int wr, int wc, int fr, int fq) const {
        const int row0 = u.pm * 256 + wr * 64 + fr; const int b = (u.pm * 256) >> 12;
#pragma unroll
        for (int bj = 0; bj < 2; ++bj)
#pragma unroll
            for (int n = 0; n < 2; ++n) { const int col = u.pn * 256 + bj * 128 + wc * 32 + 16 * n + 4 * fq; const f32x4 g4 = *(const f32x4*)(MODG + (size_t)b * 3072 + col);
#pragma unroll
                for (int ai = 0; ai < 2; ++ai)
#pragma unroll
                    for (int m = 0; m < 4; ++m) { const size_t off = (size_t)(row0 + ai * 128 + m * 16) * 1024 + col; const f32x4 xi = *(const f32x4*)(XIN + off); *(f32x4*)(XOUT + off) = xi + g4 * acc[ai][bj][m][n]; } asm volatile("" ::: "memory"); }
    }
};

__device__ __forceinline__ int crow(int r, int hi) { return (r & 3) + 8 * (r >> 2) + 4 * hi; }
__device__ __forceinline__ bf16x8 vtr2(const LAS unsigned char* p) {
    const v4i16_t lo = __builtin_amdgcn_ds_read_tr16_b64_v4i16((LAS v4i16_t*)p), hi = __builtin_amdgcn_ds_read_tr16_b64_v4i16((LAS v4i16_t*)(p + 512));
    return (bf16x8){lo[0], lo[1], lo[2], lo[3], hi[0], hi[1], hi[2], hi[3]};
}
constexpr int AT_KBUF = 13312, AT_OFF_V = 2 * AT_KBUF, AT_OFF_CK = AT_OFF_V + 2 * 8192, AT_OFF_WS = AT_OFF_CK + 512;

template <bool MLA>
__device__ __forceinline__ void attn_unit(LAS unsigned char* lds, int b, int h, int qb, unsigned char* ws, int wave_s) {
    constexpr int DQK = MLA ? 96 : 64, NDS = DQK / 16, KROW = MLA ? 208 : 144, QP = MLA ? 768 : 512;
    const bf16_t* Q = (const bf16_t*)(ws + (MLA ? WS_QM : WS_QF)); const bf16_t* K = (const bf16_t*)(ws + (MLA ? WS_KM : WS_KF)); const bf16_t* V = (const bf16_t*)(ws + (MLA ? WS_VM : WS_VF));
    const bf16_t* KRp = (const bf16_t*)(ws + WS_KR); const float* CUM = (const float*)(ws + WS_CUM); const bf16_t* GATE = (const bf16_t*)(ws + WS_GATE); bf16_t* Y = (bf16_t*)(ws + WS_H);
    const int tid = otid(wave_s), lane = tid & 63, r32 = lane & 31, hi = lane >> 5; const int wid = __builtin_amdgcn_readfirstlane(tid >> 6);
    const int par = (wid >> 2) & 1;
    const int q0 = qb * 256, qw0 = q0 + wid * 32; const size_t rowbase = (size_t)b * SEQ;
    const int NT = q0 / 64 + 4;
    bf16x8 qr[NDS];
    { const bf16_t* qp = Q + (rowbase + qw0 + r32) * QP + h * DQK + hi * 8;
#pragma unroll
      for (int ds = 0; ds < NDS; ++ds) qr[ds] = *(const bf16x8*)(qp + ds * 16); }
    const int krow = tid >> 3, kch = tid & 7;
    const bf16_t* kgu = K + rowbase * 512 + h * 64; const unsigned koff = (unsigned)(krow * 512 + kch * 8); const int kdst = krow * KROW + kch * 16;
    const bf16_t* krgu = KRp + rowbase * 32; const unsigned kroff = (unsigned)((tid >> 2) * 32 + (tid & 3) * 8); const int krdst = (tid >> 2) * KROW + 128 + (tid & 3) * 16;
    const int vdh = tid >> 8, vrow = (tid >> 2) & 63, vc4 = tid & 3;
    const bf16_t* vgu = V + rowbase * 512 + h * 64; const unsigned voff = (unsigned)(vrow * 512 + vdh * 32 + vc4 * 8); const int vdst = AT_OFF_V + vdh * 4096 + vrow * 64 + vc4 * 16;
    const float* ckgu = CUM + (size_t)(b * 8 + h) * SEQ; const unsigned ckoff = (unsigned)(tid & 63);
    u32x4 kreg, krreg = (u32x4){0u, 0u, 0u, 0u}, vreg; float ckreg = 0.f;
#define AT_LOADK(t) do { kreg = *(const u32x4*)(kgu + (size_t)(t) * 64 * 512 + koff); \
        if (MLA) { if (tid < 256) krreg = *(const u32x4*)(krgu + (size_t)(t) * 64 * 32 + kroff); } else { if (tid < 64) ckreg = -ckgu[(size_t)(t) * 64 + ckoff]; } } while (0)
#define AT_STOREK(bf) do { *(LAS u32x4*)(lds + (bf) * AT_KBUF + kdst) = kreg; \
        if (MLA) { if (tid < 256) *(LAS u32x4*)(lds + (bf) * AT_KBUF + krdst) = krreg; } else { if (tid < 64) *(LAS float*)(lds + AT_OFF_CK + (bf) * 256 + tid * 4) = ckreg; } } while (0)
#define AT_LOADV(t) do { vreg = *(const u32x4*)(vgu + (size_t)(t) * 64 * 512 + voff); } while (0)
#define AT_STOREV(bf) do { *(LAS u32x4*)(lds + (bf) * 8192 + vdst) = vreg; } while (0)
    float mhat = -1e30f, lsum = 0.f; f32x16 o0 = {}, o1 = {};
    const int vb = AT_OFF_V + ((lane >> 4) & 1) * 32 + (lane & 3) * 8 + (4 * hi + ((lane & 15) >> 2)) * 64;
#define AT_QK(P0, P1, t_, MASKOK) do { const int bf_ = (t_) & 1; \
        if (!MLA) { _Pragma("unroll") for (int g = 0; g < 4; ++g) { const f32x4 c0 = *(const LAS f32x4*)(lds + AT_OFF_CK + bf_ * 256 + (8 * g + 4 * hi) * 4), c1 = *(const LAS f32x4*)(lds + AT_OFF_CK + bf_ * 256 + (32 + 8 * g + 4 * hi) * 4); \
                _Pragma("unroll") for (int e = 0; e < 4; ++e) { P0[4 * g + e] = c0[e]; P1[4 * g + e] = c1[e]; } } } \
        else { P0 = (f32x16){}; P1 = (f32x16){}; } \
        const LAS unsigned char* kb_ = lds + bf_ * AT_KBUF + r32 * KROW + hi * 16; \
        _Pragma("unroll") for (int ds = 0; ds < NDS; ++ds) { \
            const bf16x8 kf0 = *(const LAS bf16x8*)(kb_ + ds * 32), kf1 = *(const LAS bf16x8*)(kb_ + 32 * KROW + ds * 32); \
            P0 = __builtin_amdgcn_mfma_f32_32x32x16_bf16(kf0, qr[ds], P0, 0, 0, 0); \
            P1 = __builtin_amdgcn_mfma_f32_32x32x16_bf16(kf1, qr[ds], P1, 0, 0, 0); } \
        if (MASKOK && !MLA && (t_) * 64 + 63 > qw0) { const int q_ = qw0 + r32; \
            _Pragma("unroll") for (int r = 0; r < 16; ++r) { const int kv = (t_) * 64 + crow(r, hi); if (kv > q_) P0[r] = -INFINITY; if (kv + 32 > q_) P1[r] = -INFINITY; } } } while (0)
#define AT_SMPV(P0, P1, t_) do { const int bf_ = (t_) & 1; \
        float ra = fmaxf(fmaxf(P0[0], P0[1]), P1[0]), rb = fmaxf(fmaxf(P0[2], P0[3]), P1[1]); ra = fmaxf(fmaxf(ra, P1[2]), P1[3]); \
        _Pragma("unroll") for (int r = 4; r < 16; r += 4) { ra = fmaxf(fmaxf(ra, P0[r]), P0[r + 1]); rb = fmaxf(fmaxf(rb, P0[r + 2]), P0[r + 3]); ra = fmaxf(fmaxf(ra, P1[r]), P1[r + 1]); rb = fmaxf(fmaxf(rb, P1[r + 2]), P1[r + 3]); } \
        float rm = fmaxf(ra, rb); { auto rr = __builtin_amdgcn_permlane32_swap(__float_as_uint(rm), __float_as_uint(rm), false, false); rm = fmaxf(__uint_as_float(rr[0]), __uint_as_float(rr[1])); } \
        if (__any(rm > mhat + 16.f)) { \
            const float mnew = fmaxf(mhat, rm), alpha = __builtin_amdgcn_exp2f(mhat - mnew); \
            lsum *= alpha; mhat = mnew; \
            _Pragma("unroll") for (int r = 0; r < 16; ++r) { o0[r] *= alpha; o1[r] *= alpha; } } \
        float sacc = 0.f; \
        _Pragma("unroll") for (int r = 0; r < 16; ++r) { P0[r] = __builtin_amdgcn_exp2f(P0[r] - mhat); P1[r] = __builtin_amdgcn_exp2f(P1[r] - mhat); sacc += P0[r] + P1[r]; } \
        lsum += sacc; \
        u32x4 pw[4]; \
        _Pragma("unroll") for (int s = 0; s < 2; ++s) { \
            pw[s]     = (u32x4){cvtpk_s(P0[8 * s], P0[8 * s + 1]), cvtpk_s(P0[8 * s + 2], P0[8 * s + 3]), cvtpk_s(P0[8 * s + 4], P0[8 * s + 5]), cvtpk_s(P0[8 * s + 6], P0[8 * s + 7])}; \
            pw[2 + s] = (u32x4){cvtpk_s(P1[8 * s], P1[8 * s + 1]), cvtpk_s(P1[8 * s + 2], P1[8 * s + 3]), cvtpk_s(P1[8 * s + 4], P1[8 * s + 5]), cvtpk_s(P1[8 * s + 6], P1[8 * s + 7])}; } \
        const LAS unsigned char* vp_ = lds + vb + bf_ * 8192; \
        _Pragma("unroll") for (int s = 0; s < 4; ++s) { \
            const bf16x8 pa = __builtin_bit_cast(bf16x8, pw[s]); \
            const bf16x8 v0 = vtr2(vp_ + s * 1024), v1 = vtr2(vp_ + 4096 + s * 1024); \
            o0 = __builtin_amdgcn_mfma_f32_32x32x16_bf16(v0, pa, o0, 0, 0, 0); \
            o1 = __builtin_amdgcn_mfma_f32_32x32x16_bf16(v1, pa, o1, 0, 0, 0); } } while (0)
#define AT_STEP(PAR, C0, C1, N0, N1, t_) do { \
        if ((t_) + 2 < NT) AT_LOADK((t_) + 2); if ((t_) + 1 < NT) AT_LOADV((t_) + 1); \
        const bool actN_ = ((t_) + 1 < NT) && (((t_) + 1) * 64 <= qw0), actC_ = ((t_) * 64 <= qw0); \
        __builtin_amdgcn_sched_barrier(0); \
        if (PAR == 0) { if (actN_) AT_QK(N0, N1, (t_) + 1, true); if (actC_) AT_SMPV(C0, C1, t_); } \
        else          { if (actC_) AT_SMPV(C0, C1, t_); if (actN_) AT_QK(N0, N1, (t_) + 1, true); } \
        __builtin_amdgcn_sched_barrier(0); \
        if ((t_) + 2 < NT) AT_STOREK((t_) & 1); if ((t_) + 1 < NT) AT_STOREV(((t_) + 1) & 1); \
        __syncthreads(); } while (0)
#define AT_STEADY(PAR, C0, C1, N0, N1, t_) do { \
        AT_LOADK((t_) + 2); AT_LOADV((t_) + 1); \
        __builtin_amdgcn_sched_barrier(0); \
        if (PAR == 0) { AT_QK(N0, N1, (t_) + 1, false); AT_SMPV(C0, C1, t_); \
            _Pragma("unroll") for (int i_ = 0; i_ < 2 * NDS; ++i_) { __builtin_amdgcn_sched_group_barrier(0x008, 1, 0); __builtin_amdgcn_sched_group_barrier(0x002, 12, 0); } } \
        else          { AT_SMPV(C0, C1, t_); AT_QK(N0, N1, (t_) + 1, false); } \
        __builtin_amdgcn_sched_barrier(0); \
        AT_STOREK((t_) & 1); AT_STOREV(((t_) + 1) & 1); \
        __syncthreads(); } while (0)
    f32x16 sa0, sa1, sb0, sb1;
    __syncthreads();
    AT_LOADK(0); AT_LOADV(0); AT_STOREK(0); AT_STOREV(0); AT_LOADK(1); AT_STOREK(1);
    __syncthreads();
    AT_QK(sa0, sa1, 0, true);
    __syncthreads();
    int t = 0;
    if (par == 0) {
        for (; t + 6 < NT; t += 2) { AT_STEADY(0, sa0, sa1, sb0, sb1, t); AT_STEADY(0, sb0, sb1, sa0, sa1, t + 1); }
        for (; t < NT; t += 2) { AT_STEP(0, sa0, sa1, sb0, sb1, t); AT_STEP(0, sb0, sb1, sa0, sa1, t + 1); }
    } else {
        for (; t + 6 < NT; t += 2) { AT_STEADY(1, sa0, sa1, sb0, sb1, t); AT_STEADY(1, sb0, sb1, sa0, sa1, t + 1); }
        for (; t < NT; t += 2) { AT_STEP(1, sa0, sa1, sb0, sb1, t); AT_STEP(1, sb0, sb1, sa0, sa1, t + 1); }
    }
#undef AT_LOADK
#undef AT_STOREK
#undef AT_LOADV
#undef AT_STOREV
#undef AT_QK
#undef AT_SMPV
#undef AT_STEP
#undef AT_STEADY
    float lt; { auto rr = __builtin_amdgcn_permlane32_swap(__float_as_uint(lsum), __float_as_uint(lsum), false, false); lt = __uint_as_float(rr[0]) + __uint_as_float(rr[1]); }
    const float rl = 1.f / lt;
    const size_t ob = (rowbase + qw0 + r32) * 1024 + (MLA ? 512 : 0) + h * 64 + 4 * hi;
#pragma unroll
    for (int g = 0; g < 4; ++g) {
        const u32x2 ga = *(const u32x2*)(GATE + ob + 8 * g), gb = *(const u32x2*)(GATE + ob + 32 + 8 * g);
        f32x4 a = (f32x4){o0[4 * g], o0[4 * g + 1], o0[4 * g + 2], o0[4 * g + 3]} * rl, c = (f32x4){o1[4 * g], o1[4 * g + 1], o1[4 * g + 2], o1[4 * g + 3]} * rl;
        a = a * (f32x4){__builtin_bit_cast(float, ga.x << 16), __builtin_bit_cast(float, ga.x & 0xffff0000u), __builtin_bit_cast(float, ga.y << 16), __builtin_bit_cast(float, ga.y & 0xffff0000u)};
        c = c * (f32x4){__builtin_bit_cast(float, gb.x << 16), __builtin_bit_cast(float, gb.x & 0xffff0000u), __builtin_bit_cast(float, gb.y << 16), __builtin_bit_cast(float, gb.y & 0xffff0000u)};
        *(u32x2*)(Y + ob + 8 * g) = pk4(a); *(u32x2*)(Y + ob + 32 + 8 * g) = pk4(c);
    }
}

template <int MODE>
__device__ __forceinline__ void transpose_item(const float* __restrict__ W, int K, int Nsrc, int Ndst, bf16_t* __restrict__ WT, const float* __restrict__ kscale, LAS float* scr, int item, int lane) {
    const int nblk = Ndst / 32, kb = item / nblk, nb = item % nblk, k0 = 64 * kb, n0 = 32 * nb;
    const int nd = n0 + (lane & 31); int ns = nd; bool valid = true;
    if (MODE == 1) { if (nd < 1536) ns = nd; else if (nd < 2976) ns = nd + 8; else if (nd < 2984) ns = nd - 1440; else { ns = 0; valid = false; } }
#pragma unroll 8
    for (int i = 0; i < 32; ++i) { const int kk = 2 * i + (lane >> 5); float v = valid ? W[(size_t)(k0 + kk) * Nsrc + ns] : 0.f; if (kscale) v *= kscale[k0 + kk]; scr[kk * 33 + (lane & 31)] = v; }
    LDS_WAIT();
    const int c = lane & 7;
#pragma unroll
    for (int j = 0; j < 4; ++j) { const int n = (lane >> 3) + 8 * j; const LAS float* s = scr + (8 * c) * 33 + n;
        u32x4 o; o.x = pk2(s[0 * 33], s[1 * 33]); o.y = pk2(s[2 * 33], s[3 * 33]); o.z = pk2(s[4 * 33], s[5 * 33]); o.w = pk2(s[6 * 33], s[7 * 33]);
        *(u32x4*)(WT + (size_t)(n0 + n) * K + k0 + 8 * c) = o; }
    LDS_WAIT();
}

struct Args { const void* in[14]; float* out; unsigned char* ws; };

__global__ void __launch_bounds__(512) mk_fwd(Args args) {
    extern __shared__ __attribute__((aligned(16))) unsigned char smem[];
    LAS unsigned char* lds = (LAS unsigned char*)smem;
    cg::grid_group grid = cg::this_grid();
    const int wave_s = __builtin_amdgcn_readfirstlane((int)threadIdx.x >> 6);
    const int G = gridDim.x, bx = blockIdx.x, NGW = G * 8;
    unsigned char* ws = args.ws; float* X = args.out;
    float* MOD = (float*)(ws + WS_MOD);
    unsigned* bar = (unsigned*)ws;
    volatile LAS unsigned* bst = (volatile LAS unsigned*)(lds + 131072);
    { const int t0 = otid(wave_s); if (t0 < 2) bst[t0] = 0u; __syncthreads(); if (t0 == 0) (void)xb_add(&bar[XB_XCNT(xb_xcc_id())], 1u); }
#define GRID_BAR() xcd_barrier(bar, bst, otid(wave_s))

    {
        const int tid = otid(wave_s), lane = tid & 63; const int wave = __builtin_amdgcn_readfirstlane(tid >> 6); const int gw = bx * 8 + wave;
        const float* c_in = (const float*)args.in[1]; const int* pos_in = (const int*)args.in[2];
        const float* w_ada = (const float*)args.in[4]; const float* b_ada = (const float*)args.in[5];
        const float* w_in = (const float*)args.in[6]; const float* q_norm_g = (const float*)args.in[8];
        const float* w_uq = (const float*)args.in[9]; const float* kv_norm_g = (const float*)args.in[10]; const float* w_ukv = (const float*)args.in[11];
        const float* w_out = (const float*)args.in[12];
        bf16_t* WIN = (bf16_t*)(ws + WS_WIN); bf16_t* WOUT = (bf16_t*)(ws + WS_WOUT); bf16_t* WUQ = (bf16_t*)(ws + WS_WUQ); bf16_t* WUKV = (bf16_t*)(ws + WS_WUKV);
        float* COS = (float*)(ws + WS_COS); float* SIN = (float*)(ws + WS_SIN);
        for (int unit = bx; unit < DEPTH * 48; unit += G) {
            LAS float* cact = (LAS float*)lds; LAS float* red = (LAS float*)(lds + 32768);
            const int l = unit / 48, n = (unit % 48) * 64 + lane;
            for (int i = tid; i < NB * DM; i += 512) cact[i] = silu_f(c_in[i]);
            __syncthreads();
            float a[8];
#pragma unroll
            for (int b = 0; b < 8; ++b) a[b] = 0.f;
            const float* wp = w_ada + ((size_t)l * DM + 128 * wave) * 3072 + n;
#pragma unroll 4
            for (int kk = 0; kk < 128; ++kk) { const float wv = wp[(size_t)kk * 3072];
#pragma unroll
                for (int b = 0; b < 8; ++b) a[b] += cact[b * DM + 128 * wave + kk] * wv; }
#pragma unroll
            for (int b = 0; b < 8; ++b) red[(wave * 8 + b) * 64 + lane] = a[b];
            __syncthreads();
            { float s = b_ada[l * 3072 + n];
#pragma unroll
              for (int w2 = 0; w2 < 8; ++w2) s += red[(w2 * 8 + wave) * 64 + lane];
              MOD[(size_t)(l * 8 + wave) * 3072 + n] = s; }
            __syncthreads();
        }
        { LAS float* scr = (LAS float*)(lds + 49152) + wave * (64 * 33);
          constexpr int I_IN = 16 * 96, I_OUT = 16 * 32, I_UQ = 4 * 24, I_UKV = 2 * 32, I_L = I_IN + I_OUT + I_UQ + I_UKV;
          for (int it = gw; it < DEPTH * I_L; it += NGW) {
              const int l = it / I_L; int r = it % I_L;
              if (r < I_IN) { transpose_item<1>(w_in + (size_t)l * DM * NIN, DM, NIN, NINP, WIN + (size_t)l * NINP * DM, nullptr, scr, r, lane); continue; } r -= I_IN;
              if (r < I_OUT) { transpose_item<0>(w_out + (size_t)l * DM * DM, DM, DM, DM, WOUT + (size_t)l * DM * DM, nullptr, scr, r, lane); continue; } r -= I_OUT;
              if (r < I_UQ) { transpose_item<0>(w_uq + (size_t)l * 256 * 768, 256, 768, 768, WUQ + (size_t)l * 768 * 256, q_norm_g + l * 256, scr, r, lane); continue; } r -= I_UQ;
              transpose_item<0>(w_ukv + (size_t)l * 128 * 1024, 128, 1024, 1024, WUKV + (size_t)l * 1024 * 128, kv_norm_g + l * 128, scr, r, lane);
          } }
        for (int idx = bx * 512 + tid; idx < MTOK * 16; idx += G * 512) {
            const int tok = idx >> 4, i = idx & 15;
            const float inv = 1.0f / powf(10000.0f, (float)(2 * i) * (1.0f / 32.0f));
            const float ang = (float)pos_in[tok] * inv; float sn, cs; sincosf(ang, &sn, &cs);
            COS[idx] = cs; SIN[idx] = sn;
        }
    }

    grid.sync();
    for (int l = 0; l <= DEPTH; ++l) {
        if (l > 0) GRID_BAR();
        {
            const int tid = otid(wave_s), lane = tid & 63; const int wave = __builtin_amdgcn_readfirstlane(tid >> 6); const int gw = bx * 8 + wave;
            const bool fin = (l == DEPTH);
            const float* xs = (l == 0) ? (const float*)args.in[0] : X; const float* gsrc = fin ? (const float*)args.in[13] : (const float*)args.in[3] + l * DM;
            bf16_t* H = (bf16_t*)(ws + WS_H);
            for (int r0 = gw * 16; r0 < MTOK; r0 += NGW * 16) {
                const int b = r0 >> 12;
                f32x4 gs[4], sh[4];
#pragma unroll
                for (int j = 0; j < 4; ++j) { const int col = 4 * lane + 256 * j; const f32x4 g = *(const f32x4*)(gsrc + col);
                    if (fin) { gs[j] = g; sh[j] = (f32x4){0.f, 0.f, 0.f, 0.f}; }
                    else { const f32x4 sc = *(const f32x4*)(MOD + (size_t)(l * 8 + b) * 3072 + 1024 + col); gs[j] = g * (sc + 1.0f); sh[j] = *(const f32x4*)(MOD + (size_t)(l * 8 + b) * 3072 + col); } }
                for (int rr = 0; rr < 16; ++rr) {
                    const size_t row = (size_t)(r0 + rr);
                    f32x4 v[4]; float ss = 0.f;
#pragma unroll
                    for (int j = 0; j < 4; ++j) { v[j] = *(const f32x4*)(xs + row * DM + 4 * lane + 256 * j); ss += (v[j][0] * v[j][0] + v[j][1] * v[j][1]) + (v[j][2] * v[j][2] + v[j][3] * v[j][3]); }
                    const float rstd = rsqrtf(wave_sum(ss, lane) * (1.f / DM) + EPS_);
                    if (fin) {
#pragma unroll
                        for (int j = 0; j < 4; ++j) *(f32x4*)(X + row * DM + 4 * lane + 256 * j) = v[j] * rstd * gs[j];
                    } else {
#pragma unroll
                        for (int j = 0; j < 4; ++j) *(u32x2*)(H + row * DM + 4 * lane + 256 * j) = pk4(v[j] * rstd * gs[j] + sh[j]);
                    }
                }
            }
        }
        if (l == DEPTH) break;
        GRID_BAR();
        {
            pg8::Gemm g{(const bf16_t*)(ws + WS_H), (const bf16_t*)(ws + WS_WIN) + (size_t)l * NINP * DM, MTOK, NINP, DM}; pg8::StaticOrder S; S.init(MTOK, NINP, G, bx);
            EpiIn E{ws, (const float*)args.in[7] + l * 8};
            pg8::gemm_phase<EpiIn, pg8::StaticOrder, true, true>(lds, g, S, E, wave_s);
        }
        GRID_BAR();
        {
            const int tid = otid(wave_s), lane = tid & 63; const int wave = __builtin_amdgcn_readfirstlane(tid >> 6);
            const float* LOGF = (const float*)(ws + WS_LOGF); float* CUM = (float*)(ws + WS_CUM);
            for (int u = bx; u < 64; u += G) {
                LAS float* wsum = (LAS float*)lds;
                const float* lf = LOGF + (size_t)(u >> 3) * SEQ * 8 + (u & 7);
                float v[8]; float s = 0.f;
#pragma unroll
                for (int i = 0; i < 8; ++i) { s += lf[(size_t)(8 * tid + i) * 8]; v[i] = s; }
                float incl = s;
#pragma unroll
                for (int off = 1; off < 64; off <<= 1) { const float t = shup(incl, off, lane); if (lane >= off) incl += t; }
                if (lane == 63) wsum[wave] = incl;
                __syncthreads();
                float base = 0.f;
                for (int w2 = 0; w2 < wave; ++w2) base += wsum[w2];
                const float excl = base + incl - s;
#pragma unroll
                for (int i = 0; i < 8; ++i) CUM[(size_t)u * SEQ + 8 * tid + i] = (excl + v[i]) * LOG2E;
                __syncthreads();
            }
        }
        { pg8::Gemm g{(const bf16_t*)(ws + WS_QLAT), (const bf16_t*)(ws + WS_WUQ) + (size_t)l * 768 * 256, MTOK, 768, 256}; pg8::StaticOrder S; S.init(MTOK, 768, G, bx);
          EpiQ E{ws};
          pg8::gemm_phase<EpiQ, pg8::StaticOrder, true, true>(lds, g, S, E, wave_s); }
        __syncthreads();
        { pg8::Gemm g{(const bf16_t*)(ws + WS_KVLAT), (const bf16_t*)(ws + WS_WUKV) + (size_t)l * 1024 * 128, MTOK, 1024, 128}; pg8::StaticOrder S; S.init(MTOK, 1024, G, bx);
          EpiKV E{ws};
          pg8::gemm_phase<EpiKV, pg8::StaticOrder, true, true>(lds, g, S, E, wave_s); }
        GRID_BAR();
        {
            const int vcu = (G % 8 == 0) ? (bx % 8) * (G / 8) + bx / 8 : bx;
            for (int u = vcu; u < 2048; u += G) {
                const int i = u & 255, j = u >> 8; const int bh = i >> 2, s = i & 3, jj = j & 3;
                const int qb = (jj == 0) ? 15 - s : (jj == 1) ? 8 + s : (jj == 2) ? 7 - s : s;
                if (j < 4) attn_unit<true>(lds, bh >> 3, bh & 7, qb, ws, wave_s);
                else attn_unit<false>(lds, bh >> 3, bh & 7, qb, ws, wave_s);
            }
        }
        GRID_BAR();
        {
            pg8::Gemm g{(const bf16_t*)(ws + WS_H), (const bf16_t*)(ws + WS_WOUT) + (size_t)l * DM * DM, MTOK, DM, DM}; pg8::StaticOrder S; S.init(MTOK, DM, G, bx);
            EpiOut E{l == 0 ? (const float*)args.in[0] : X, X, MOD + (size_t)l * 8 * 3072 + 2048};
            pg8::gemm_phase<EpiOut, pg8::StaticOrder, true, true>(lds, g, S, E, wave_s);
        }
    }
}

extern "C" void kernel_launch(void* const* d_in, const int* in_sizes, int n_in, void* d_out, int out_size, void* d_ws, size_t ws_size, hipStream_t stream) {
    static int grid = 0;
    if (grid == 0) {
        if (n_in != 14 || out_size != MTOK * DM || ws_size < WS_END) { fprintf(stderr, "kernel_launch: unexpected shapes (n_in %d, out %d, ws %zu)\n", n_in, out_size, ws_size); grid = -1; return; }
        int dev = 0, cus = 0, per_cu = 0;
        (void)hipGetDevice(&dev); (void)hipDeviceGetAttribute(&cus, hipDeviceAttributeMultiprocessorCount, dev);
        (void)hipFuncSetAttribute((const void*)mk_fwd, hipFuncAttributeMaxDynamicSharedMemorySize, LDS_BYTES);
        if (hipOccupancyMaxActiveBlocksPerMultiprocessor(&per_cu, (const void*)mk_fwd, 512, LDS_BYTES) != hipSuccess || per_cu < 1) per_cu = 1;
        (void)hipGetLastError();
        grid = cus * per_cu;
    }
    if (grid < 0) return;
    (void)hipMemsetAsync(d_ws, 0, 16384, stream);
    Args a{};
    for (int i = 0; i < 14; ++i) a.in[i] = d_in[i];
    a.out = (float*)d_out; a.ws = (unsigned char*)d_ws;
    void* kargs[] = {&a};
    hipError_t e = hipLaunchCooperativeKernel((const void*)mk_fwd, dim3(grid), dim3(512), kargs, LDS_BYTES, stream);
    if (e != hipSuccess) fprintf(stderr, "cooperative launch failed: %s (grid %d)\n", hipGetErrorString(e), grid);
}
```

```cpp
#include <hip/hip_runtime.h>
#include <hip/hip_cooperative_groups.h>
#include <cstdio>
#include <cstdint>
#include <cmath>
namespace cg = cooperative_groups;
__device__ __forceinline__ int otid(int wave_s) { int l; asm volatile("v_mbcnt_lo_u32_b32 %0, -1, 0\n\tv_mbcnt_hi_u32_b32 %0, -1, %0" : "=v"(l)); int w = wave_s; asm volatile("" : "+s"(w)); return (w << 6) | l; }
namespace pg8 {
#define PG8_LAS __attribute__((address_space(3)))
typedef unsigned short bf16_t;
typedef short bf16x8 __attribute__((ext_vector_type(8)));
typedef float f32x4 __attribute__((ext_vector_type(4)));
typedef unsigned u32x4 __attribute__((ext_vector_type(4)));
constexpr int BM = 256, BK = 64, HALF = 128, HTB = HALF * BK * 2  , STAGE_BYTES = 8 * HTB, NXCD = 8, WGM = 8;

__host__ __device__ __forceinline__ int lds_byte(int r, int c) { const int st = (r >> 4) * 2 + (c >> 5), rr = r & 15, cc = c & 31, ob = rr * 64 + cc * 2; return st * 1024 + (ob ^ (((ob >> 9) & 1) << 5)); }
__host__ __device__ __forceinline__ void stage_rc(int b, int& R, int& C) { const int st = b / 1024, sb = b % 1024, swz = sb ^ (((sb >> 9) & 1) << 5); R = (st >> 1) * 16 + swz / 64; C = (st & 1) * 32 + (swz % 64) / 2; }
__host__ __device__ __forceinline__ int perm32(int rho) { const int n = rho >> 4, i = rho & 15; return 8 * (i >> 2) + 4 * n + (i & 3); }

struct Unit { int pm, pn; };
struct Gemm { const bf16_t* A; const bf16_t* Bt; int M, N, K; };

struct StaticOrder {
    int nM, nN, nwg, G, c;
    __host__ __device__ void init(int M, int N, int G_, int c_) { nM = M / BM; nN = N / BM; nwg = nM * nN; G = G_; c = c_; }
    __host__ __device__ bool next(int i, Unit& u) const {
        const long L = (long)i * G + c; if (L >= nwg) return false;
        int wgid = (int)L; { const int q = nwg / NXCD, r = nwg % NXCD, xcd = wgid % NXCD, off = wgid / NXCD; wgid = (xcd < r ? xcd * (q + 1) : r * (q + 1) + (xcd - r) * q) + off; }
        const int nig = WGM * nN, gid = wgid / nig, fm = gid * WGM, gsz = (nM - fm) < WGM ? (nM - fm) : WGM;
        u.pm = fm + ((wgid % nig) % gsz); u.pn = (wgid % nig) / gsz; return true;
    }
    __device__ __forceinline__ void a_ready(const Unit&) const {}
    __device__ __forceinline__ void done(const Unit&) const {}
};

__device__ __forceinline__ unsigned cvt_pk_bf16(float lo, float hi) { unsigned r; asm volatile("v_cvt_pk_bf16_f32 %0, %1, %2" : "=v"(r) : "v"(lo), "v"(hi)); return r; }
template <class Epi, class Sched, bool ALIGN_EPI = false, bool SP2 = false>
__device__ __forceinline__ void gemm_phase(PG8_LAS unsigned char* lds, const Gemm g, const Sched& S, const Epi& E, int wave_s) {
    const int tid = otid(wave_s), wid = __builtin_amdgcn_readfirstlane(tid >> 6), lane = tid & 63, wr = wid >> 2, wc = wid & 3, fr = lane & 15, fq = lane >> 4;
    const int K = g.K, nt = K / BK;
    unsigned voffA[2], voffB[2];
#pragma unroll
    for (int i = 0; i < 2; ++i) { int R, C; stage_rc(tid * 16 + i * 8192, R, C); const int Rb = Epi::PERM ? ((R & ~31) + perm32(R & 31)) : R;
        voffA[i] = (unsigned)(R * K + C) * 2u; voffB[i] = (unsigned)(Rb * K + C) * 2u; }
    const size_t kstep = (size_t)(BK * 2);
    const size_t hstep = (size_t)HALF * K * 2;
    const size_t tstep = 2 * hstep;
    const unsigned ldsw = (unsigned)wid * 1024u;
    const int aoff = lds_byte(wr * 64 + fr, fq * 8), boff = lds_byte(wc * 32 + fr, fq * 8);
#define PG8_SA(b, h) (((b) * 2 + (h)) * HTB)
#define PG8_SB(b, h) ((4 + (b) * 2 + (h)) * HTB)
#define PG8_STAGE(bufoff, gbase, voff) do { _Pragma("unroll") for (int _i = 0; _i < 2; ++_i) \
        __builtin_amdgcn_global_load_lds((const unsigned*)((const char*)(gbase) + (voff)[_i]), (PG8_LAS unsigned*)(lds + (bufoff) + ldsw + _i * 8192), 16, 0, 0); } while (0)
#define PG8_LDA(dst, b, h) do { _Pragma("unroll") for (int m = 0; m < 4; ++m) _Pragma("unroll") for (int k = 0; k < 2; ++k) dst[m][k] = *(const PG8_LAS bf16x8*)(lds + PG8_SA(b, h) + aoff + m * 2048 + k * 1024); } while (0)
#define PG8_LDB(dst, b, h) do { _Pragma("unroll") for (int n = 0; n < 2; ++n) _Pragma("unroll") for (int k = 0; k < 2; ++k) dst[n][k] = *(const PG8_LAS bf16x8*)(lds + PG8_SB(b, h) + boff + n * 2048 + k * 1024); } while (0)
#define PG8_MMA(ai, bj, At, Bt) do { __builtin_amdgcn_s_setprio(1); _Pragma("unroll") for (int m = 0; m < 4; ++m) _Pragma("unroll") for (int n = 0; n < 2; ++n) _Pragma("unroll") for (int k = 0; k < 2; ++k) \
        acc[ai][bj][m][n] = __builtin_amdgcn_mfma_f32_16x16x32_bf16(Bt[n][k], At[m][k], acc[ai][bj][m][n], 0, 0, 0); __builtin_amdgcn_s_setprio(0); } while (0)
#define PG8_WAIT_V(n) asm volatile("s_waitcnt vmcnt(" #n ")" ::: "memory")
#define PG8_WAIT_L(n) asm volatile("s_waitcnt lgkmcnt(" #n ")" ::: "memory")
#define PG8_BAR __builtin_amdgcn_s_barrier()
#define PG8_SCHED __builtin_amdgcn_sched_barrier(0)
    Unit cur, nxt; int ui = 0;
    if (!S.next(0, cur)) return;
    f32x4 acc[2][2][4][2];
#pragma unroll
    for (int a = 0; a < 2; ++a)
#pragma unroll
        for (int b = 0; b < 2; ++b)
#pragma unroll
            for (int m = 0; m < 4; ++m)
#pragma unroll
                for (int n = 0; n < 2; ++n) acc[a][b][m][n] = (f32x4){0.f, 0.f, 0.f, 0.f};
    bf16x8 At[4][2], B0[2][2], B1[2][2];
    const char* cA = (const char*)g.A + (size_t)cur.pm * tstep; const char* cB = (const char*)g.Bt + (size_t)cur.pn * tstep;
    S.a_ready(cur);
    if constexpr (SP2) {
        PG8_STAGE(PG8_SB(0, 0), cB, voffB); PG8_STAGE(PG8_SB(0, 1), cB + hstep, voffB); PG8_STAGE(PG8_SA(0, 0), cA, voffA); PG8_STAGE(PG8_SA(0, 1), cA + hstep, voffA);
        if (wr == 1) PG8_BAR;
        PG8_WAIT_V(2); PG8_BAR;
        PG8_STAGE(PG8_SB(1, 0), cB + kstep, voffB); PG8_STAGE(PG8_SA(1, 0), cA + kstep, voffA); PG8_STAGE(PG8_SB(1, 1), cB + hstep + kstep, voffB);
        PG8_WAIT_V(6); PG8_BAR;
    } else {
        PG8_STAGE(PG8_SB(0, 0), cB, voffB); PG8_STAGE(PG8_SA(0, 0), cA, voffA); PG8_STAGE(PG8_SB(0, 1), cB + hstep, voffB); PG8_STAGE(PG8_SA(0, 1), cA + hstep, voffA);
        if (wr == 1) PG8_BAR;
        PG8_WAIT_V(4); PG8_BAR;
        PG8_STAGE(PG8_SB(1, 0), cB + kstep, voffB); PG8_STAGE(PG8_SA(1, 0), cA + kstep, voffA); PG8_STAGE(PG8_SB(1, 1), cB + hstep + kstep, voffB);
        PG8_WAIT_V(6); PG8_BAR;
    }
    for (;;) {
        const bool has_next = S.next(ui + 1, nxt);
        const char* nA = has_next ? (const char*)g.A + (size_t)nxt.pm * tstep : cA; const char* nB = has_next ? (const char*)g.Bt + (size_t)nxt.pn * tstep : cB;
        for (int t = 0; t < nt; t += 2) {
            const bool last = (t == nt - 2);
            const char* a1 = cA + (size_t)(t + 1) * kstep;
            const char* a2 = last ? nA : cA + (size_t)(t + 2) * kstep; const char* b2 = last ? nB : cB + (size_t)(t + 2) * kstep;
            const char* a3 = a2 + kstep; const char* b3 = b2 + kstep;
            if (last && has_next) S.a_ready(nxt);
            if constexpr (SP2) {
            PG8_LDB(B0, 0, 0); PG8_LDB(B1, 0, 1); PG8_SCHED; PG8_LDA(At, 0, 0); PG8_STAGE(PG8_SA(1, 1), a1 + hstep, voffA);
            PG8_WAIT_V(8); PG8_WAIT_L(0); PG8_BAR; PG8_MMA(0, 0, At, B0); PG8_MMA(0, 1, At, B1); PG8_BAR; PG8_SCHED;
            PG8_LDA(At, 0, 1); PG8_STAGE(PG8_SB(0, 0), b2, voffB); PG8_STAGE(PG8_SB(0, 1), b2 + hstep, voffB); PG8_STAGE(PG8_SA(0, 0), a2, voffA);
            PG8_WAIT_V(8); PG8_WAIT_L(0); PG8_BAR; PG8_MMA(1, 0, At, B0); PG8_MMA(1, 1, At, B1); PG8_BAR; PG8_SCHED;
            PG8_LDB(B0, 1, 0); PG8_LDB(B1, 1, 1); PG8_SCHED; PG8_LDA(At, 1, 0); PG8_STAGE(PG8_SA(0, 1), a2 + hstep, voffA);
            PG8_WAIT_V(8); PG8_WAIT_L(0); PG8_BAR; PG8_MMA(0, 0, At, B0); PG8_MMA(0, 1, At, B1); PG8_BAR; PG8_SCHED;
            PG8_LDA(At, 1, 1); PG8_STAGE(PG8_SB(1, 0), b3, voffB); PG8_STAGE(PG8_SB(1, 1), b3 + hstep, voffB); PG8_STAGE(PG8_SA(1, 0), a3, voffA);
            PG8_WAIT_V(8); PG8_WAIT_L(0); PG8_BAR; PG8_MMA(1, 0, At, B0); PG8_MMA(1, 1, At, B1); PG8_BAR; PG8_SCHED;
            } else {
            PG8_LDB(B0, 0, 0); PG8_SCHED; PG8_LDA(At, 0, 0); PG8_STAGE(PG8_SA(1, 1), a1 + hstep, voffA);
            PG8_WAIT_L(8); PG8_BAR; PG8_WAIT_L(0); PG8_MMA(0, 0, At, B0); PG8_BAR; PG8_SCHED;
            PG8_LDB(B1, 0, 1); PG8_STAGE(PG8_SB(0, 0), b2, voffB);
            PG8_BAR; PG8_WAIT_L(0); PG8_MMA(0, 1, At, B1); PG8_BAR;
            PG8_LDA(At, 0, 1); PG8_STAGE(PG8_SA(0, 0), a2, voffA);
            PG8_BAR; PG8_WAIT_L(0); PG8_MMA(1, 0, At, B0); PG8_BAR; PG8_SCHED;
            PG8_STAGE(PG8_SB(0, 1), b2 + hstep, voffB);
            PG8_WAIT_V(6); PG8_BAR; PG8_MMA(1, 1, At, B1); PG8_BAR;
            PG8_LDB(B0, 1, 0); PG8_SCHED; PG8_LDA(At, 1, 0); PG8_STAGE(PG8_SA(0, 1), a2 + hstep, voffA);
            PG8_WAIT_L(8); PG8_BAR; PG8_WAIT_L(0); PG8_MMA(0, 0, At, B0); PG8_BAR; PG8_SCHED;
            PG8_LDB(B1, 1, 1); PG8_STAGE(PG8_SB(1, 0), b3, voffB);
            PG8_BAR; PG8_WAIT_L(0); PG8_MMA(0, 1, At, B1); PG8_BAR;
            PG8_LDA(At, 1, 1); PG8_STAGE(PG8_SA(1, 0), a3, voffA);
            PG8_BAR; PG8_WAIT_L(0); PG8_MMA(1, 0, At, B0); PG8_BAR; PG8_SCHED;
            PG8_STAGE(PG8_SB(1, 1), b3 + hstep, voffB);
            PG8_WAIT_V(6); PG8_BAR; PG8_MMA(1, 1, At, B1); PG8_BAR;
            }
        }
        if constexpr (ALIGN_EPI) { if (wr == 0) PG8_BAR; }
        if constexpr (!Epi::AFTER_DRAIN) { int fr2 = fr, fq2 = fq; asm volatile("" : "+v"(fr2), "+v"(fq2)); E(acc, cur, wr, wc, fr2, fq2); S.done(cur); }
        if (!has_next) break;
#pragma unroll
        for (int a = 0; a < 2; ++a)
#pragma unroll
            for (int b = 0; b < 2; ++b)
#pragma unroll
                for (int m = 0; m < 4; ++m)
#pragma unroll
                    for (int n = 0; n < 2; ++n) acc[a][b][m][n] = (f32x4){0.f, 0.f, 0.f, 0.f};
        cur = nxt; cA = nA; cB = nB; ++ui;
        if constexpr (ALIGN_EPI) { if (wr == 1) PG8_BAR; }
    }
    PG8_WAIT_V(0);
    if constexpr (!ALIGN_EPI) { if (wr == 0) PG8_BAR; }
    PG8_BAR;
    if constexpr (Epi::AFTER_DRAIN) { E.fused(acc, cur, wr, wc, fr, fq, lds, wid, lane); S.done(cur); }
#undef PG8_SA
#undef PG8_SB
#undef PG8_STAGE
#undef PG8_LDA
#undef PG8_LDB
#undef PG8_MMA
#undef PG8_WAIT_V
#undef PG8_WAIT_L
#undef PG8_BAR
#undef PG8_SCHED
}
}

#define LAS __attribute__((address_space(3)))
typedef unsigned short bf16_t;
typedef short bf16x8 __attribute__((ext_vector_type(8)));
typedef float f32x4 __attribute__((ext_vector_type(4)));
typedef float f32x16 __attribute__((ext_vector_type(16)));
typedef unsigned u32x4 __attribute__((ext_vector_type(4)));
typedef unsigned u32x2 __attribute__((ext_vector_type(2)));
typedef short v4i16_t __attribute__((ext_vector_type(4)));

constexpr int NB = 8, SEQ = 4096, DM = 1024, DEPTH = 4, MTOK = NB * SEQ, NIN = 2984, NINP = 3072;
constexpr float EPS_ = 1e-6f, LOG2E = 1.4426950408889634f;
constexpr float C2F = 0.125f * LOG2E;
constexpr float C2M = 0.10206207261596575f * LOG2E;
constexpr int LDS_BYTES = 132096;

constexpr size_t MiB = 1u << 20;
constexpr size_t WS_WIN = 2 * MiB, WS_WOUT = 26 * MiB, WS_WUQ = 34 * MiB, WS_WUKV = 36 * MiB, WS_MOD = 37 * MiB, WS_COS = 38 * MiB, WS_SIN = 40 * MiB,
                 WS_LOGF = 42 * MiB, WS_CUM = 43 * MiB, WS_SSQQ = 44 * MiB, WS_SSQK = 45 * MiB, WS_H = 48 * MiB, WS_QF = 112 * MiB, WS_KF = 144 * MiB,
                 WS_VF = 176 * MiB, WS_GATE = 208 * MiB, WS_QLAT = 272 * MiB, WS_KVLAT = 288 * MiB, WS_KR = 296 * MiB, WS_QM = 298 * MiB, WS_KM = 346 * MiB,
                 WS_VM = 378 * MiB, WS_END = 410 * MiB;

__device__ __forceinline__ unsigned f2bf(float f) { unsigned u = __builtin_bit_cast(unsigned, f); return (u + 0x7fffu + ((u >> 16) & 1u)) >> 16; }
typedef float f32x2_t __attribute__((ext_vector_type(2))); typedef __bf16 bf16x2_t __attribute__((ext_vector_type(2)));
__device__ __forceinline__ unsigned cvtpk_s(float lo, float hi) { f32x2_t v = {lo, hi}; bf16x2_t b = __builtin_convertvector(v, bf16x2_t); return __builtin_bit_cast(unsigned, b); }
__device__ __forceinline__ unsigned pk2(float lo, float hi) { return cvtpk_s(lo, hi); }
__device__ __forceinline__ float bf2f(bf16_t v) { return __builtin_bit_cast(float, (unsigned)v << 16); }
__device__ __forceinline__ u32x2 pk4(f32x4 v) { u32x2 w; w.x = pk2(v[0], v[1]); w.y = pk2(v[2], v[3]); return w; }
__device__ __forceinline__ float silu_f(float v) { return v * __builtin_amdgcn_rcpf(1.f + __builtin_amdgcn_exp2f(-1.4426950408889634f * v)); }
__device__ __forceinline__ f32x4 silu4(f32x4 v) { return (f32x4){silu_f(v[0]), silu_f(v[1]), silu_f(v[2]), silu_f(v[3])}; }
__device__ __forceinline__ float logsig_f(float x) { return fminf(x, 0.f) - log1pf(expf(-fabsf(x))); }
__device__ __forceinline__ float shx(float v, int mask, int lane) { return __builtin_bit_cast(float, __builtin_amdgcn_ds_bpermute((lane ^ mask) << 2, __builtin_bit_cast(int, v))); }
__device__ __forceinline__ float shup(float v, int off, int lane) { return __builtin_bit_cast(float, __builtin_amdgcn_ds_bpermute(((lane - off) & 63) << 2, __builtin_bit_cast(int, v))); }
__device__ __forceinline__ float wave_sum(float v, int lane) {
#pragma unroll
    for (int o = 1; o < 64; o <<= 1) v += shx(v, o, lane);
    return v;
}
#define LDS_WAIT() asm volatile("s_waitcnt lgkmcnt(0)" ::: "memory")


#define XB_TMO      128
#define XB_XCNT(j)  (256  + 64 * (j))
#define XB_XSUB(j)  (1280 + 64 * (j))
#define XB_XGEN(j)  (2304 + 64 * (j))
#define XB_TOP      3328
#define XB_TOPGEN   3392
#define XCD_BAR_WORDS 3456
#define XB_SPIN_CAP (1u << 18)
__device__ __forceinline__ unsigned xb_ld(unsigned* p)              { return __hip_atomic_load(p, __ATOMIC_RELAXED, __HIP_MEMORY_SCOPE_AGENT); }
__device__ __forceinline__ unsigned xb_add(unsigned* p, unsigned v) { return __hip_atomic_fetch_add(p, v, __ATOMIC_RELAXED, __HIP_MEMORY_SCOPE_AGENT); }
__device__ __forceinline__ unsigned xb_xcc_id() { return (unsigned)__builtin_amdgcn_s_getreg((3 << 11) | 20) & 0xFu; }
#define XB_SPIN(cond, bar) do { unsigned _sp = 0; while (cond) { __builtin_amdgcn_s_sleep(1); \
    if ((++_sp & 255u) == 0u) { if (xb_ld(&(bar)[XB_TMO])) break; if (_sp > XB_SPIN_CAP) { atomicAdd(&(bar)[XB_TMO], 1u); break; } } } } while (0)
__device__ __forceinline__ void xcd_barrier_complete(unsigned* bar, unsigned x, unsigned& nloc, unsigned& nx) {
    const unsigned G = gridDim.x * gridDim.y * gridDim.z;
    unsigned sum, cnt, mine, sp = 0u;
    for (;;) {
        sum = 0u; cnt = 0u; mine = 0u;
#pragma unroll
        for (unsigned j = 0; j < 16; ++j) { const unsigned c = xb_ld(&bar[XB_XCNT(j)]); sum += c; cnt += (c > 0u) ? 1u : 0u; mine = (j == x) ? c : mine; }
        if (sum == G) break;
        __builtin_amdgcn_s_sleep(1);
        if ((++sp & 255u) == 0u) { if (xb_ld(&bar[XB_TMO])) break; if (sp > XB_SPIN_CAP) { atomicAdd(&bar[XB_TMO], 1u); break; } }
    }
    nloc = mine > 0u ? mine : 1u; nx = cnt > 0u ? cnt : 1u;
}
__device__ __forceinline__ void xcd_barrier(unsigned* bar, volatile LAS unsigned* st, int tid) {
    asm volatile("s_waitcnt vmcnt(0)" ::: "memory");
    __syncthreads();
    if (tid == 0) {
        const unsigned x = xb_xcc_id();
        __builtin_amdgcn_s_waitcnt(0);
        unsigned nloc = st[0], nx = st[1];
        if (nloc == 0u) { xcd_barrier_complete(bar, x, nloc, nx); st[0] = nloc; st[1] = nx; }
        const unsigned old = xb_add(&bar[XB_XSUB(x)], 1u);
        const unsigned gen = old / nloc;
        if (old + 1u == (gen + 1u) * nloc) {
            __builtin_amdgcn_fence(__ATOMIC_RELEASE, "agent");
            asm volatile("s_waitcnt vmcnt(0)" ::: "memory");
            const unsigned og = xb_add(&bar[XB_TOP], 1u);
            const unsigned tg = og / nx;
            if (og + 1u == (tg + 1u) * nx) xb_add(&bar[XB_TOPGEN], 1u);
            else XB_SPIN(xb_ld(&bar[XB_TOPGEN]) == tg, bar);
            __builtin_amdgcn_fence(__ATOMIC_ACQUIRE, "agent");
            xb_add(&bar[XB_XGEN(x)], 1u);
            asm volatile("s_waitcnt vmcnt(0)" ::: "memory");
        } else {
            XB_SPIN(xb_ld(&bar[XB_XGEN(x)]) == gen, bar);
            __builtin_amdgcn_fence(__ATOMIC_ACQUIRE, "agent");
            asm volatile("s_waitcnt vmcnt(0)" ::: "memory");
        }
    }
    __syncthreads();
}

using pg8::Unit;
struct EpiIn {
    static constexpr bool PERM = false, AFTER_DRAIN = false;
    unsigned char* ws; const float* BF;
    __device__ __forceinline__ void operator()(const f32x4 (&acc)[2][2][4][2], const Unit& u, int wr, int wc, int fr, int fq) const {
        const int row0 = u.pm * 256 + wr * 64 + fr;
        bf16_t* QF = (bf16_t*)(ws + WS_QF); bf16_t* GATE = (bf16_t*)(ws + WS_GATE); bf16_t* QLAT = (bf16_t*)(ws + WS_QLAT); bf16_t* KVLAT = (bf16_t*)(ws + WS_KVLAT); bf16_t* KR = (bf16_t*)(ws + WS_KR);
        float* LOGF = (float*)(ws + WS_LOGF); float* SSQQ = (float*)(ws + WS_SSQQ); float* SSQK = (float*)(ws + WS_SSQK); const float* COS = (const float*)(ws + WS_COS); const float* SIN = (const float*)(ws + WS_SIN);
        if (u.pn == 8) {
#pragma unroll
            for (int ai = 0; ai < 2; ++ai)
#pragma unroll
                for (int m = 0; m < 4; ++m) {
                    float s = 0.f;
#pragma unroll
                    for (int bj = 0; bj < 2; ++bj)
#pragma unroll
                        for (int n = 0; n < 2; ++n) { const f32x4 x = acc[ai][bj][m][n]; s += (x[0] * x[0] + x[1] * x[1]) + (x[2] * x[2] + x[3] * x[3]); }
                    s += shx(s, 16, fq * 16 + fr); s += shx(s, 32, fq * 16 + fr);
                    if (fq == 0) SSQQ[(size_t)(row0 + ai * 128 + m * 16) * 4 + wc] = s;
                }
        } else if (u.pn == 9) {
#pragma unroll
            for (int ai = 0; ai < 2; ++ai)
#pragma unroll
                for (int m = 0; m < 4; ++m) {
                    float s = 0.f;
#pragma unroll
                    for (int n = 0; n < 2; ++n) { const f32x4 x = acc[ai][0][m][n]; s += (x[0] * x[0] + x[1] * x[1]) + (x[2] * x[2] + x[3] * x[3]); }
                    s += shx(s, 16, fq * 16 + fr); s += shx(s, 32, fq * 16 + fr);
                    if (fq == 0) SSQK[(size_t)(row0 + ai * 128 + m * 16) * 4 + wc] = s;
                }
        }
#pragma unroll
        for (int bj = 0; bj < 2; ++bj) {
            const int gcol = u.pn * 256 + bj * 128 + wc * 32;
            if (gcol < 1536) {
                const int seg = gcol >> 9; bf16_t* base = QF + (size_t)seg * ((WS_KF - WS_QF) / 2); const float sc = seg == 0 ? C2F : 1.f; const int c0 = (gcol & 511) + 4 * fq;
#pragma unroll
                for (int ai = 0; ai < 2; ++ai)
#pragma unroll
                    for (int m = 0; m < 4; ++m) { bf16_t* rp = base + (size_t)(row0 + ai * 128 + m * 16) * 512 + c0;
#pragma unroll
                        for (int n = 0; n < 2; ++n) *(u32x2*)(rp + 16 * n) = pk4(acc[ai][bj][m][n] * sc); }
            } else if (gcol < 2048 || (gcol >= 2464 && gcol < 2976)) {
                const int c0 = (gcol < 2048 ? gcol - 1536 : gcol - 2464 + 512) + 4 * fq;
#pragma unroll
                for (int ai = 0; ai < 2; ++ai)
#pragma unroll
                    for (int m = 0; m < 4; ++m) { bf16_t* rp = GATE + (size_t)(row0 + ai * 128 + m * 16) * 1024 + c0;
#pragma unroll
                        for (int n = 0; n < 2; ++n) *(u32x2*)(rp + 16 * n) = pk4(silu4(acc[ai][bj][m][n])); }
            } else if (gcol < 2304) {
                const int c0 = gcol - 2048 + 4 * fq;
#pragma unroll
                for (int ai = 0; ai < 2; ++ai)
#pragma unroll
                    for (int m = 0; m < 4; ++m) { bf16_t* rp = QLAT + (size_t)(row0 + ai * 128 + m * 16) * 256 + c0;
#pragma unroll
                        for (int n = 0; n < 2; ++n) *(u32x2*)(rp + 16 * n) = pk4(acc[ai][bj][m][n]); }
            } else if (gcol < 2432) {
                const int c0 = gcol - 2304 + 4 * fq;
#pragma unroll
                for (int ai = 0; ai < 2; ++ai)
#pragma unroll
                    for (int m = 0; m < 4; ++m) { bf16_t* rp = KVLAT + (size_t)(row0 + ai * 128 + m * 16) * 128 + c0;
#pragma unroll
                        for (int n = 0; n < 2; ++n) *(u32x2*)(rp + 16 * n) = pk4(acc[ai][bj][m][n]); }
            } else if (gcol < 2464) {
#pragma unroll
                for (int ai = 0; ai < 2; ++ai)
#pragma unroll
                    for (int m = 0; m < 4; ++m) { const size_t row = (size_t)(row0 + ai * 128 + m * 16);
                        const f32x4 cs = *(const f32x4*)(COS + row * 16 + 4 * fq), sn = *(const f32x4*)(SIN + row * 16 + 4 * fq);
                        const f32x4 t1 = acc[ai][bj][m][0], t2 = acc[ai][bj][m][1];
                        const f32x4 o1 = t1 * cs - t2 * sn, o2 = t2 * cs + t1 * sn;
                        bf16_t* rp = KR + row * 32 + 4 * fq; *(u32x2*)(rp) = pk4(o1); *(u32x2*)(rp + 16) = pk4(o2); if (m & 1) asm volatile("" ::: "memory"); }
            } else if (gcol == 2976) {
                if (fq < 2) {
                    const f32x4 bfv = *(const f32x4*)(BF + 4 * fq);
#pragma unroll
                    for (int ai = 0; ai < 2; ++ai)
#pragma unroll
                        for (int m = 0; m < 4; ++m) { const size_t row = (size_t)(row0 + ai * 128 + m * 16); const f32x4 v = acc[ai][bj][m][0] + bfv;
                            *(f32x4*)(LOGF + row * 8 + 4 * fq) = (f32x4){logsig_f(v[0]), logsig_f(v[1]), logsig_f(v[2]), logsig_f(v[3])}; }
                }
            }
        }
    }
};
struct EpiQ {
    static constexpr bool PERM = false, AFTER_DRAIN = false;
    unsigned char* ws;
    __device__ __forceinline__ void operator()(const f32x4 (&acc)[2][2][4][2], const Unit& u, int wr, int wc, int fr, int fq) const {
        const int row0 = u.pm * 256 + wr * 64 + fr;
        const float* SSQ = (const float*)(ws + WS_SSQQ); const float* COS = (const float*)(ws + WS_COS); const float* SIN = (const float*)(ws + WS_SIN); bf16_t* QM = (bf16_t*)(ws + WS_QM);
        float rs[2][4];
#pragma unroll
        for (int ai = 0; ai < 2; ++ai)
#pragma unroll
            for (int m = 0; m < 4; ++m) { const f32x4 s = *(const f32x4*)(SSQ + (size_t)(row0 + ai * 128 + m * 16) * 4); rs[ai][m] = rsqrtf(((s[0] + s[1]) + (s[2] + s[3])) * (1.f / 256.f) + EPS_) * C2M; }
#pragma unroll
        for (int bj = 0; bj < 2; ++bj) {
            const int gcol = u.pn * 256 + bj * 128 + wc * 32; const bool rope = ((gcol >> 5) % 3) == 2;
#pragma unroll
            for (int ai = 0; ai < 2; ++ai)
#pragma unroll
                for (int m = 0; m < 4; ++m) { const size_t row = (size_t)(row0 + ai * 128 + m * 16);
                    f32x4 v0 = acc[ai][bj][m][0] * rs[ai][m], v1 = acc[ai][bj][m][1] * rs[ai][m];
                    if (rope) { const f32x4 cs = *(const f32x4*)(COS + row * 16 + 4 * fq), sn = *(const f32x4*)(SIN + row * 16 + 4 * fq);
                        const f32x4 o1 = v0 * cs - v1 * sn, o2 = v1 * cs + v0 * sn; v0 = o1; v1 = o2; }
                    bf16_t* rp = QM + row * 768 + gcol + 4 * fq; *(u32x2*)(rp) = pk4(v0); *(u32x2*)(rp + 16) = pk4(v1); if (m & 1) asm volatile("" ::: "memory"); }
        }
    }
};
struct EpiKV {
    static constexpr bool PERM = false, AFTER_DRAIN = false;
    unsigned char* ws;
    __device__ __forceinline__ void operator()(const f32x4 (&acc)[2][2][4][2], const Unit& u, int wr, int wc, int fr, int fq) const {
        const int row0 = u.pm * 256 + wr * 64 + fr;
        const float* SSQ = (const float*)(ws + WS_SSQK); bf16_t* KM = (bf16_t*)(ws + WS_KM);
        float rs[2][4];
#pragma unroll
        for (int ai = 0; ai < 2; ++ai)
#pragma unroll
            for (int m = 0; m < 4; ++m) { const f32x4 s = *(const f32x4*)(SSQ + (size_t)(row0 + ai * 128 + m * 16) * 4); rs[ai][m] = rsqrtf(((s[0] + s[1]) + (s[2] + s[3])) * (1.f / 128.f) + EPS_); }
#pragma unroll
        for (int bj = 0; bj < 2; ++bj) {
            const int gcol = u.pn * 256 + bj * 128 + wc * 32; const int head = gcol >> 7, within = gcol & 127;
            bf16_t* base = KM + (within < 64 ? (size_t)0 : (size_t)((WS_VM - WS_KM) / 2)); const int c0 = head * 64 + (within & 63) + 4 * fq;
#pragma unroll
            for (int ai = 0; ai < 2; ++ai)
#pragma unroll
                for (int m = 0; m < 4; ++m) { bf16_t* rp = base + (size_t)(row0 + ai * 128 + m * 16) * 512 + c0;
#pragma unroll
                    for (int n = 0; n < 2; ++n) *(u32x2*)(rp + 16 * n) = pk4(acc[ai][bj][m][n] * rs[ai][m]); }
        }
    }
};
struct EpiOut {
    static constexpr bool PERM = false, AFTER_DRAIN = false;
    const float* XIN; float* XOUT; const float* MODG;
    __device__ __forceinline__ void operator()(const f32x4 (&acc)[2][2][4][2], const Unit& u, int wr, int wc, int fr, int fq) const {
        const int row0 = u.pm * 256 + wr * 64 + fr; const int b = (u.pm * 256) >> 12;
#pragma unroll
        for (int bj = 0; bj < 2; ++bj)
#pragma unroll
            for (int n = 0; n < 2; ++n) { const int col = u.pn * 256 + bj * 128 + wc * 32 + 16 * n + 4 * fq; const f32x4 g4 = *(const f32x4*)(MODG + (size_t)b * 3072 + col);
#pragma unroll
                for (int ai = 0; ai < 2; ++ai)
#pragma unroll
                    for (int m = 0; m < 4; ++m) { const size_t off = (size_t)(row0 + ai * 128 + m * 16) * 1024 + col; const f32x4 xi = *(const f32x4*)(XIN + off); *(f32x4*)(XOUT + off) = xi + g4 * acc[ai][bj][m][n]; } asm volatile("" ::: "memory"); }
    }
};

__device__ __forceinline__ int crow(int r, int hi) { return (r & 3) + 8 * (r >> 2) + 4 * hi; }
__device__ __forceinline__ bf16x8 vtr2(const LAS unsigned char* p) {
    const v4i16_t lo = __builtin_amdgcn_ds_read_tr16_b64_v4i16((LAS v4i16_t*)p), hi = __builtin_amdgcn_ds_read_tr16_b64_v4i16((LAS v4i16_t*)(p + 512));
    return (bf16x8){lo[0], lo[1], lo[2], lo[3], hi[0], hi[1], hi[2], hi[3]};
}
constexpr int AT_KBUF = 13312, AT_OFF_V = 2 * AT_KBUF, AT_OFF_CK = AT_OFF_V + 2 * 8192, AT_OFF_WS = AT_OFF_CK + 512;

template <bool MLA>
__device__ __forceinline__ void attn_unit(LAS unsigned char* lds, int b, int h, int qb, unsigned char* ws, int wave_s) {
    constexpr int DQK = MLA ? 96 : 64, NDS = DQK / 16, KROW = MLA ? 208 : 144, QP = MLA ? 768 : 512;
    const bf16_t* Q = (const bf16_t*)(ws + (MLA ? WS_QM : WS_QF)); const bf16_t* K = (const bf16_t*)(ws + (MLA ? WS_KM : WS_KF)); const bf16_t* V = (const bf16_t*)(ws + (MLA ? WS_VM : WS_VF));
    const bf16_t* KRp = (const bf16_t*)(ws + WS_KR); const float* CUM = (const float*)(ws + WS_CUM); const bf16_t* GATE = (const bf16_t*)(ws + WS_GATE); bf16_t* Y = (bf16_t*)(ws + WS_H);
    const int tid = otid(wave_s), lane = tid & 63, r32 = lane & 31, hi = lane >> 5; const int wid = __builtin_amdgcn_readfirstlane(tid >> 6);
    const int par = (wid >> 2) & 1;
    const int q0 = qb * 256, qw0 = q0 + wid * 32; const size_t rowbase = (size_t)b * SEQ;
    const int NT = q0 / 64 + 4;
    bf16x8 qr[NDS];
    { const bf16_t* qp = Q + (rowbase + qw0 + r32) * QP + h * DQK + hi * 8;
#pragma unroll
      for (int ds = 0; ds < NDS; ++ds) qr[ds] = *(const bf16x8*)(qp + ds * 16); }
    const int krow = tid >> 3, kch = tid & 7;
    const bf16_t* kgu = K + rowbase * 512 + h * 64; const unsigned koff = (unsigned)(krow * 512 + kch * 8); const int kdst = krow * KROW + kch * 16;
    const bf16_t* krgu = KRp + rowbase * 32; const unsigned kroff = (unsigned)((tid >> 2) * 32 + (tid & 3) * 8); const int krdst = (tid >> 2) * KROW + 128 + (tid & 3) * 16;
    const int vdh = tid >> 8, vrow = (tid >> 2) & 63, vc4 = tid & 3;
    const bf16_t* vgu = V + rowbase * 512 + h * 64; const unsigned voff = (unsigned)(vrow * 512 + vdh * 32 + vc4 * 8); const int vdst = AT_OFF_V + vdh * 4096 + vrow * 64 + vc4 * 16;
    const float* ckgu = CUM + (size_t)(b * 8 + h) * SEQ; const unsigned ckoff = (unsigned)(tid & 63);
    u32x4 kreg, krreg = (u32x4){0u, 0u, 0u, 0u}, vreg; float ckreg = 0.f;
#define AT_LOADK(t) do { kreg = *(const u32x4*)(kgu + (size_t)(t) * 64 * 512 + koff); \
        if (MLA) { if (tid < 256) krreg = *(const u32x4*)(krgu + (size_t)(t) * 64 * 32 + kroff); } else { if (tid < 64) ckreg = -ckgu[(size_t)(t) * 64 + ckoff]; } } while (0)
#define AT_STOREK(bf) do { *(LAS u32x4*)(lds + (bf) * AT_KBUF + kdst) = kreg; \
        if (MLA) { if (tid < 256) *(LAS u32x4*)(lds + (bf) * AT_KBUF + krdst) = krreg; } else { if (tid < 64) *(LAS float*)(lds + AT_OFF_CK + (bf) * 256 + tid * 4) = ckreg; } } while (0)
#define AT_LOADV(t) do { vreg = *(const u32x4*)(vgu + (size_t)(t) * 64 * 512 + voff); } while (0)
#define AT_STOREV(bf) do { *(LAS u32x4*)(lds + (bf) * 8192 + vdst) = vreg; } while (0)
    float mhat = -1e30f, lsum = 0.f; f32x16 o0 = {}, o1 = {};
    const int vb = AT_OFF_V + ((lane >> 4) & 1) * 32 + (lane & 3) * 8 + (4 * hi + ((lane & 15) >> 2)) * 64;
#define AT_QK(P0, P1, t_, MASKOK) do { const int bf_ = (t_) & 1; \
        if (!MLA) { _Pragma("unroll") for (int g = 0; g < 4; ++g) { const f32x4 c0 = *(const LAS f32x4*)(lds + AT_OFF_CK + bf_ * 256 + (8 * g + 4 * hi) * 4), c1 = *(const LAS f32x4*)(lds + AT_OFF_CK + bf_ * 256 + (32 + 8 * g + 4 * hi) * 4); \
                _Pragma("unroll") for (int e = 0; e < 4; ++e) { P0[4 * g + e] = c0[e]; P1[4 * g + e] = c1[e]; } } } \
        else { P0 = (f32x16){}; P1 = (f32x16){}; } \
        const LAS unsigned char* kb_ = lds + bf_ * AT_KBUF + r32 * KROW + hi * 16; \
        _Pragma("unroll") for (int ds = 0; ds < NDS; ++ds) { \
            const bf16x8 kf0 = *(const LAS bf16x8*)(kb_ + ds * 32), kf1 = *(const LAS bf16x8*)(kb_ + 32 * KROW + ds * 32); \
            P0 = __builtin_amdgcn_mfma_f32_32x32x16_bf16(kf0, qr[ds], P0, 0, 0, 0); \
            P1 = __builtin_amdgcn_mfma_f32_32x32x16_bf16(kf1, qr[ds], P1, 0, 0, 0); } \
        if (MASKOK && !MLA && (t_) * 64 + 63 > qw0) { const int q_ = qw0 + r32; \
            _Pragma("unroll") for (int r = 0; r < 16; ++r) { const int kv = (t_) * 64 + crow(r, hi); if (kv > q_) P0[r] = -INFINITY; if (kv + 32 > q_) P1[r] = -INFINITY; } } } while (0)
#define AT_SMPV(P0, P1, t_) do { const int bf_ = (t_) & 1; \
        float ra = fmaxf(fmaxf(P0[0], P0[1]), P1[0]), rb = fmaxf(fmaxf(P0[2], P0[3]), P1[1]); ra = fmaxf(fmaxf(ra, P1[2]), P1[3]); \
        _Pragma("unroll") for (int r = 4; r < 16; r += 4) { ra = fmaxf(fmaxf(ra, P0[r]), P0[r + 1]); rb = fmaxf(fmaxf(rb, P0[r + 2]), P0[r + 3]); ra = fmaxf(fmaxf(ra, P1[r]), P1[r + 1]); rb = fmaxf(fmaxf(rb, P1[r + 2]), P1[r + 3]); } \
        float rm = fmaxf(ra, rb); { auto rr = __builtin_amdgcn_permlane32_swap(__float_as_uint(rm), __float_as_uint(rm), false, false); rm = fmaxf(__uint_as_float(rr[0]), __uint_as_float(rr[1])); } \
        if (__any(rm > mhat + 16.f)) { \
            const float mnew = fmaxf(mhat, rm), alpha = __builtin_amdgcn_exp2f(mhat - mnew); \
            lsum *= alpha; mhat = mnew; \
            _Pragma("unroll") for (int r = 0; r < 16; ++r) { o0[r] *= alpha; o1[r] *= alpha; } } \
        float sacc = 0.f; \
        _Pragma("unroll") for (int r = 0; r < 16; ++r) { P0[r] = __builtin_amdgcn_exp2f(P0[r] - mhat); P1[r] = __builtin_amdgcn_exp2f(P1[r] - mhat); sacc += P0[r] + P1[r]; } \
        lsum += sacc; \
        u32x4 pw[4]; \
        _Pragma("unroll") for (int s = 0; s < 2; ++s) { \
            pw[s]     = (u32x4){cvtpk_s(P0[8 * s], P0[8 * s + 1]), cvtpk_s(P0[8 * s + 2], P0[8 * s + 3]), cvtpk_s(P0[8 * s + 4], P0[8 * s + 5]), cvtpk_s(P0[8 * s + 6], P0[8 * s + 7])}; \
            pw[2 + s] = (u32x4){cvtpk_s(P1[8 * s], P1[8 * s + 1]), cvtpk_s(P1[8 * s + 2], P1[8 * s + 3]), cvtpk_s(P1[8 * s + 4], P1[8 * s + 5]), cvtpk_s(P1[8 * s + 6], P1[8 * s + 7])}; } \
        const LAS unsigned char* vp_ = lds + vb + bf_ * 8192; \
        _Pragma("unroll") for (int s = 0; s < 4; ++s) { \
            const bf16x8 pa = __builtin_bit_cast(bf16x8, pw[s]); \
            const bf16x8 v0 = vtr2(vp_ + s * 1024), v1 = vtr2(vp_ + 4096 + s * 1024); \
            o0 = __builtin_amdgcn_mfma_f32_32x32x16_bf16(v0, pa, o0, 0, 0, 0); \
            o1 = __builtin_amdgcn_mfma_f32_32x32x16_bf16(v1, pa, o1, 0, 0, 0); } } while (0)
#define AT_STEP(PAR, C0, C1, N0, N1, t_) do { \
        if ((t_) + 2 < NT) AT_LOADK((t_) + 2); if ((t_) + 1 < NT) AT_LOADV((t_) + 1); \
        const bool actN_ = ((t_) + 1 < NT) && (((t_) + 1) * 64 <= qw0), actC_ = ((t_) * 64 <= qw0); \
        __builtin_amdgcn_sched_barrier(0); \
        if (PAR == 0) { if (actN_) AT_QK(N0, N1, (t_) + 1, true); if (actC_) AT_SMPV(C0, C1, t_); } \
        else          { if (actC_) AT_SMPV(C0, C1, t_); if (actN_) AT_QK(N0, N1, (t_) + 1, true); } \
        __builtin_amdgcn_sched_barrier(0); \
        if ((t_) + 2 < NT) AT_STOREK((t_) & 1); if ((t_) + 1 < NT) AT_STOREV(((t_) + 1) & 1); \
        __syncthreads(); } while (0)
#define AT_STEADY(PAR, C0, C1, N0, N1, t_) do { \
        AT_LOADK((t_) + 2); AT_LOADV((t_) + 1); \
        __builtin_amdgcn_sched_barrier(0); \
        if (PAR == 0) { AT_QK(N0, N1, (t_) + 1, false); AT_SMPV(C0, C1, t_); \
            _Pragma("unroll") for (int i_ = 0; i_ < 2 * NDS; ++i_) { __builtin_amdgcn_sched_group_barrier(0x008, 1, 0); __builtin_amdgcn_sched_group_barrier(0x002, 12, 0); } } \
        else          { AT_SMPV(C0, C1, t_); AT_QK(N0, N1, (t_) + 1, false); \
            _Pragma("unroll") for (int i_ = 0; i_ < 2 * NDS; ++i_) { __builtin_amdgcn_sched_group_barrier(0x002, 12, 0); __builtin_amdgcn_sched_group_barrier(0x008, 1, 0); } } \
        __builtin_amdgcn_sched_barrier(0); \
        AT_STOREK((t_) & 1); AT_STOREV(((t_) + 1) & 1); \
        __syncthreads(); } while (0)
    f32x16 sa0, sa1, sb0, sb1;
    __syncthreads();
    AT_LOADK(0); AT_LOADV(0); AT_STOREK(0); AT_STOREV(0); AT_LOADK(1); AT_STOREK(1);
    __syncthreads();
    AT_QK(sa0, sa1, 0, true);
    __syncthreads();
    int t = 0;
    if (par == 0) {
        for (; t + 6 < NT; t += 2) { AT_STEADY(0, sa0, sa1, sb0, sb1, t); AT_STEADY(0, sb0, sb1, sa0, sa1, t + 1); }
        for (; t < NT; t += 2) { AT_STEP(0, sa0, sa1, sb0, sb1, t); AT_STEP(0, sb0, sb1, sa0, sa1, t + 1); }
    } else {
        for (; t + 6 < NT; t += 2) { AT_STEADY(1, sa0, sa1, sb0, sb1, t); AT_STEADY(1, sb0, sb1, sa0, sa1, t + 1); }
        for (; t < NT; t += 2) { AT_STEP(1, sa0, sa1, sb0, sb1, t); AT_STEP(1, sb0, sb1, sa0, sa1, t + 1); }
    }
#undef AT_LOADK
#undef AT_STOREK
#undef AT_LOADV
#undef AT_STOREV
#undef AT_QK
#undef AT_SMPV
#undef AT_STEP
#undef AT_STEADY
    float lt; { auto rr = __builtin_amdgcn_permlane32_swap(__float_as_uint(lsum), __float_as_uint(lsum), false, false); lt = __uint_as_float(rr[0]) + __uint_as_float(rr[1]); }
    const float rl = __builtin_amdgcn_rcpf(lt);
    const size_t ob = (rowbase + qw0 + r32) * 1024 + (MLA ? 512 : 0) + h * 64 + 4 * hi;
#pragma unroll
    for (int g = 0; g < 4; ++g) {
        const u32x2 ga = *(const u32x2*)(GATE + ob + 8 * g), gb = *(const u32x2*)(GATE + ob + 32 + 8 * g);
        f32x4 a = (f32x4){o0[4 * g], o0[4 * g + 1], o0[4 * g + 2], o0[4 * g + 3]} * rl, c = (f32x4){o1[4 * g], o1[4 * g + 1], o1[4 * g + 2], o1[4 * g + 3]} * rl;
        a = a * (f32x4){__builtin_bit_cast(float, ga.x << 16), __builtin_bit_cast(float, ga.x & 0xffff0000u), __builtin_bit_cast(float, ga.y << 16), __builtin_bit_cast(float, ga.y & 0xffff0000u)};
        c = c * (f32x4){__builtin_bit_cast(float, gb.x << 16), __builtin_bit_cast(float, gb.x & 0xffff0000u), __builtin_bit_cast(float, gb.y << 16), __builtin_bit_cast(float, gb.y & 0xffff0000u)};
        *(u32x2*)(Y + ob + 8 * g) = pk4(a); *(u32x2*)(Y + ob + 32 + 8 * g) = pk4(c);
    }
}

template <int MODE>
__device__ __forceinline__ void transpose_item(const float* __restrict__ W, int K, int Nsrc, int Ndst, bf16_t* __restrict__ WT, const float* __restrict__ kscale, LAS float* scr, int item, int lane) {
    const int nblk = Ndst / 32, kb = item / nblk, nb = item % nblk, k0 = 64 * kb, n0 = 32 * nb;
    const int nd = n0 + (lane & 31); int ns = nd; bool valid = true;
    if (MODE == 1) { if (nd < 1536) ns = nd; else if (nd < 2976) ns = nd + 8; else if (nd < 2984) ns = nd - 1440; else { ns = 0; valid = false; } }
#pragma unroll 8
    for (int i = 0; i < 32; ++i) { const int kk = 2 * i + (lane >> 5); float v = valid ? W[(size_t)(k0 + kk) * Nsrc + ns] : 0.f; if (kscale) v *= kscale[k0 + kk]; scr[kk * 33 + (lane & 31)] = v; }
    LDS_WAIT();
    const int c = lane & 7;
#pragma unroll
    for (int j = 0; j < 4; ++j) { const int n = (lane >> 3) + 8 * j; const LAS float* s = scr + (8 * c) * 33 + n;
        u32x4 o; o.x = pk2(s[0 * 33], s[1 * 33]); o.y = pk2(s[2 * 33], s[3 * 33]); o.z = pk2(s[4 * 33], s[5 * 33]); o.w = pk2(s[6 * 33], s[7 * 33]);
        *(u32x4*)(WT + (size_t)(n0 + n) * K + k0 + 8 * c) = o; }
    LDS_WAIT();
}

struct Args { const void* in[14]; float* out; unsigned char* ws; };

__global__ void __launch_bounds__(512) mk_fwd(Args args) {
    extern __shared__ __attribute__((aligned(16))) unsigned char smem[];
    LAS unsigned char* lds = (LAS unsigned char*)smem;
    cg::grid_group grid = cg::this_grid();
    const int wave_s = __builtin_amdgcn_readfirstlane((int)threadIdx.x >> 6);
    const int G = gridDim.x, bx = blockIdx.x, NGW = G * 8;
    unsigned char* ws = args.ws; float* X = args.out;
    float* MOD = (float*)(ws + WS_MOD);
    unsigned* bar = (unsigned*)ws;
    volatile LAS unsigned* bst = (volatile LAS unsigned*)(lds + 131072);
    { const int t0 = otid(wave_s); if (t0 < 2) bst[t0] = 0u; __syncthreads(); if (t0 == 0) (void)xb_add(&bar[XB_XCNT(xb_xcc_id())], 1u); }
#define GRID_BAR() xcd_barrier(bar, bst, otid(wave_s))

    {
        const int tid = otid(wave_s), lane = tid & 63; const int wave = __builtin_amdgcn_readfirstlane(tid >> 6); const int gw = bx * 8 + wave;
        const float* c_in = (const float*)args.in[1]; const int* pos_in = (const int*)args.in[2];
        const float* w_ada = (const float*)args.in[4]; const float* b_ada = (const float*)args.in[5];
        const float* w_in = (const float*)args.in[6]; const float* q_norm_g = (const float*)args.in[8];
        const float* w_uq = (const float*)args.in[9]; const float* kv_norm_g = (const float*)args.in[10]; const float* w_ukv = (const float*)args.in[11];
        const float* w_out = (const float*)args.in[12];
        bf16_t* WIN = (bf16_t*)(ws + WS_WIN); bf16_t* WOUT = (bf16_t*)(ws + WS_WOUT); bf16_t* WUQ = (bf16_t*)(ws + WS_WUQ); bf16_t* WUKV = (bf16_t*)(ws + WS_WUKV);
        float* COS = (float*)(ws + WS_COS); float* SIN = (float*)(ws + WS_SIN);
        for (int unit = bx; unit < DEPTH * 48; unit += G) {
            LAS float* cact = (LAS float*)lds; LAS float* red = (LAS float*)(lds + 32768);
            const int l = unit / 48, n = (unit % 48) * 64 + lane;
            for (int i = tid; i < NB * DM; i += 512) cact[i] = silu_f(c_in[i]);
            __syncthreads();
            float a[8];
#pragma unroll
            for (int b = 0; b < 8; ++b) a[b] = 0.f;
            const float* wp = w_ada + ((size_t)l * DM + 128 * wave) * 3072 + n;
#pragma unroll 4
            for (int kk = 0; kk < 128; ++kk) { const float wv = wp[(size_t)kk * 3072];
#pragma unroll
                for (int b = 0; b < 8; ++b) a[b] += cact[b * DM + 128 * wave + kk] * wv; }
#pragma unroll
            for (int b = 0; b < 8; ++b) red[(wave * 8 + b) * 64 + lane] = a[b];
            __syncthreads();
            { float s = b_ada[l * 3072 + n];
#pragma unroll
              for (int w2 = 0; w2 < 8; ++w2) s += red[(w2 * 8 + wave) * 64 + lane];
              MOD[(size_t)(l * 8 + wave) * 3072 + n] = s; }
            __syncthreads();
        }
        { LAS float* scr = (LAS float*)(lds + 49152) + wave * (64 * 33);
          constexpr int I_IN = 16 * 96, I_OUT = 16 * 32, I_UQ = 4 * 24, I_UKV = 2 * 32, I_L = I_IN + I_OUT + I_UQ + I_UKV;
          for (int it = gw; it < DEPTH * I_L; it += NGW) {
              const int l = it / I_L; int r = it % I_L;
              if (r < I_IN) { transpose_item<1>(w_in + (size_t)l * DM * NIN, DM, NIN, NINP, WIN + (size_t)l * NINP * DM, nullptr, scr, r, lane); continue; } r -= I_IN;
              if (r < I_OUT) { transpose_item<0>(w_out + (size_t)l * DM * DM, DM, DM, DM, WOUT + (size_t)l * DM * DM, nullptr, scr, r, lane); continue; } r -= I_OUT;
              if (r < I_UQ) { transpose_item<0>(w_uq + (size_t)l * 256 * 768, 256, 768, 768, WUQ + (size_t)l * 768 * 256, q_norm_g + l * 256, scr, r, lane); continue; } r -= I_UQ;
              transpose_item<0>(w_ukv + (size_t)l * 128 * 1024, 128, 1024, 1024, WUKV + (size_t)l * 1024 * 128, kv_norm_g + l * 128, scr, r, lane);
          } }
        for (int idx = bx * 512 + tid; idx < MTOK * 16; idx += G * 512) {
            const int tok = idx >> 4, i = idx & 15;
            const float inv = 1.0f / powf(10000.0f, (float)(2 * i) * (1.0f / 32.0f));
            const float ang = (float)pos_in[tok] * inv; float sn, cs; sincosf(ang, &sn, &cs);
            COS[idx] = cs; SIN[idx] = sn;
        }
    }

    grid.sync();
    for (int l = 0; l <= DEPTH; ++l) {
        if (l > 0) GRID_BAR();
        {
            const int tid = otid(wave_s), lane = tid & 63; const int wave = __builtin_amdgcn_readfirstlane(tid >> 6); const int gw = bx * 8 + wave;
            const bool fin = (l == DEPTH);
            const float* xs = (l == 0) ? (const float*)args.in[0] : X; const float* gsrc = fin ? (const float*)args.in[13] : (const float*)args.in[3] + l * DM;
            bf16_t* H = (bf16_t*)(ws + WS_H);
            for (int r0 = gw * 16; r0 < MTOK; r0 += NGW * 16) {
                const int b = r0 >> 12;
                f32x4 gs[4], sh[4];
#pragma unroll
                for (int j = 0; j < 4; ++j) { const int col = 4 * lane + 256 * j; const f32x4 g = *(const f32x4*)(gsrc + col);
                    if (fin) { gs[j] = g; sh[j] = (f32x4){0.f, 0.f, 0.f, 0.f}; }
                    else { const f32x4 sc = *(const f32x4*)(MOD + (size_t)(l * 8 + b) * 3072 + 1024 + col); gs[j] = g * (sc + 1.0f); sh[j] = *(const f32x4*)(MOD + (size_t)(l * 8 + b) * 3072 + col); } }
                for (int rr = 0; rr < 16; ++rr) {
                    const size_t row = (size_t)(r0 + rr);
                    f32x4 v[4]; float ss = 0.f;
#pragma unroll
                    for (int j = 0; j < 4; ++j) { v[j] = *(const f32x4*)(xs + row * DM + 4 * lane + 256 * j); ss += (v[j][0] * v[j][0] + v[j][1] * v[j][1]) + (v[j][2] * v[j][2] + v[j][3] * v[j][3]); }
                    const float rstd = rsqrtf(wave_sum(ss, lane) * (1.f / DM) + EPS_);
                    if (fin) {
#pragma unroll
                        for (int j = 0; j < 4; ++j) *(f32x4*)(X + row * DM + 4 * lane + 256 * j) = v[j] * rstd * gs[j];
                    } else {
#pragma unroll
                        for (int j = 0; j < 4; ++j) *(u32x2*)(H + row * DM + 4 * lane + 256 * j) = pk4(v[j] * rstd * gs[j] + sh[j]);
                    }
                }
            }
        }
        if (l == DEPTH) break;
        GRID_BAR();
        {
            pg8::Gemm g{(const bf16_t*)(ws + WS_H), (const bf16_t*)(ws + WS_WIN) + (size_t)l * NINP * DM, MTOK, NINP, DM}; pg8::StaticOrder S; S.init(MTOK, NINP, G, bx);
            EpiIn E{ws, (const float*)args.in[7] + l * 8};
            pg8::gemm_phase<EpiIn, pg8::StaticOrder, true, true>(lds, g, S, E, wave_s);
        }
        GRID_BAR();
        {
            const int tid = otid(wave_s), lane = tid & 63; const int wave = __builtin_amdgcn_readfirstlane(tid >> 6);
            const float* LOGF = (const float*)(ws + WS_LOGF); float* CUM = (float*)(ws + WS_CUM);
            for (int u = bx; u < 64; u += G) {
                LAS float* wsum = (LAS float*)lds;
                const float* lf = LOGF + (size_t)(u >> 3) * SEQ * 8 + (u & 7);
                float v[8]; float s = 0.f;
#pragma unroll
                for (int i = 0; i < 8; ++i) { s += lf[(size_t)(8 * tid + i) * 8]; v[i] = s; }
                float incl = s;
#pragma unroll
                for (int off = 1; off < 64; off <<= 1) { const float t = shup(incl, off, lane); if (lane >= off) incl += t; }
                if (lane == 63) wsum[wave] = incl;
                __syncthreads();
                float base = 0.f;
                for (int w2 = 0; w2 < wave; ++w2) base += wsum[w2];
                const float excl = base + incl - s;
#pragma unroll
                for (int i = 0; i < 8; ++i) CUM[(size_t)u * SEQ + 8 * tid + i] = (excl + v[i]) * LOG2E;
                __syncthreads();
            }
        }
        { pg8::Gemm g{(const bf16_t*)(ws + WS_QLAT), (const bf16_t*)(ws + WS_WUQ) + (size_t)l * 768 * 256, MTOK, 768, 256}; pg8::StaticOrder S; S.init(MTOK, 768, G, bx);
          EpiQ E{ws};
          pg8::gemm_phase<EpiQ, pg8::StaticOrder, true, true>(lds, g, S, E, wave_s); }
        __syncthreads();
        { pg8::Gemm g{(const bf16_t*)(ws + WS_KVLAT), (const bf16_t*)(ws + WS_WUKV) + (size_t)l * 1024 * 128, MTOK, 1024, 128}; pg8::StaticOrder S; S.init(MTOK, 1024, G, bx);
          EpiKV E{ws};
          pg8::gemm_phase<EpiKV, pg8::StaticOrder, true, true>(lds, g, S, E, wave_s); }
        GRID_BAR();
        {
            const int vcu = (G % 8 == 0) ? (bx % 8) * (G / 8) + bx / 8 : bx;
            for (int u = vcu; u < 2048; u += G) {
                const int i = u & 255, j = u >> 8; const int bh = i >> 2, s = i & 3, jj = j & 3;
                const int qb = (jj == 0) ? 15 - s : (jj == 1) ? 8 + s : (jj == 2) ? 7 - s : s;
                if (j < 4) attn_unit<true>(lds, bh >> 3, bh & 7, qb, ws, wave_s);
                else attn_unit<false>(lds, bh >> 3, bh & 7, qb, ws, wave_s);
            }
        }
        GRID_BAR();
        {
            pg8::Gemm g{(const bf16_t*)(ws + WS_H), (const bf16_t*)(ws + WS_WOUT) + (size_t)l * DM * DM, MTOK, DM, DM}; pg8::StaticOrder S; S.init(MTOK, DM, G, bx);
            EpiOut E{l == 0 ? (const float*)args.in[0] : X, X, MOD + (size_t)l * 8 * 3072 + 2048};
            pg8::gemm_phase<EpiOut, pg8::StaticOrder, true, true>(lds, g, S, E, wave_s);
        }
    }
}

extern "C" void kernel_launch(void* const* d_in, const int* in_sizes, int n_in, void* d_out, int out_size, void* d_ws, size_t ws_size, hipStream_t stream) {
    static int grid = 0;
    if (grid == 0) {
        if (n_in != 14 || out_size != MTOK * DM || ws_size < WS_END) { fprintf(stderr, "kernel_launch: unexpected shapes (n_in %d, out %d, ws %zu)\n", n_in, out_size, ws_size); grid = -1; return; }
        int dev = 0, cus = 0, per_cu = 0;
        (void)hipGetDevice(&dev); (void)hipDeviceGetAttribute(&cus, hipDeviceAttributeMultiprocessorCount, dev);
        (void)hipFuncSetAttribute((const void*)mk_fwd, hipFuncAttributeMaxDynamicSharedMemorySize, LDS_BYTES);
        if (hipOccupancyMaxActiveBlocksPerMultiprocessor(&per_cu, (const void*)mk_fwd, 512, LDS_BYTES) != hipSuccess || per_cu < 1) per_cu = 1;
        (void)hipGetLastError();
        grid = cus * per_cu;
    }
    if (grid < 0) return;
    (void)hipMemsetAsync(d_ws, 0, 16384, stream);
    Args a{};
    for (int i = 0; i < 14; ++i) a.in[i] = d_in[i];
    a.out = (float*)d_out; a.ws = (unsigned char*)d_ws;
    void* kargs[] = {&a};
    hipError_t e = hipLaunchCooperativeKernel((const void*)mk_fwd, dim3(grid), dim3(512), kargs, LDS_BYTES, stream);
    if (e != hipSuccess) fprintf(stderr, "cooperative launch failed: %s (grid %d)\n", hipGetErrorString(e), grid);
}
```

```cpp
#include <hip/hip_runtime.h>
#include <hip/hip_cooperative_groups.h>
#include <cstdio>
#include <cstdint>
#include <cmath>
namespace cg = cooperative_groups;
__device__ __forceinline__ int otid(int wave_s) { int l; asm volatile("v_mbcnt_lo_u32_b32 %0, -1, 0\n\tv_mbcnt_hi_u32_b32 %0, -1, %0" : "=v"(l)); int w = wave_s; asm volatile("" : "+s"(w)); return (w << 6) | l; }
namespace pg8 {
#define PG8_LAS __attribute__((address_space(3)))
typedef unsigned short bf16_t;
typedef short bf16x8 __attribute__((ext_vector_type(8)));
typedef float f32x4 __attribute__((ext_vector_type(4)));
typedef unsigned u32x4 __attribute__((ext_vector_type(4)));
constexpr int BM = 256, BK = 64, HALF = 128, HTB = HALF * BK * 2  , STAGE_BYTES = 8 * HTB, NXCD = 8, WGM = 8;

__host__ __device__ __forceinline__ int lds_byte(int r, int c) { const int st = (r >> 4) * 2 + (c >> 5), rr = r & 15, cc = c & 31, ob = rr * 64 + cc * 2; return st * 1024 + (ob ^ (((ob >> 9) & 1) << 5)); }
__host__ __device__ __forceinline__ void stage_rc(int b, int& R, int& C) { const int st = b / 1024, sb = b % 1024, swz = sb ^ (((sb >> 9) & 1) << 5); R = (st >> 1) * 16 + swz / 64; C = (st & 1) * 32 + (swz % 64) / 2; }
__host__ __device__ __forceinline__ int perm32(int rho) { const int n = rho >> 4, i = rho & 15; return 8 * (i >> 2) + 4 * n + (i & 3); }

struct Unit { int pm, pn; };
struct Gemm { const bf16_t* A; const bf16_t* Bt; int M, N, K; };

struct StaticOrder {
    int nM, nN, nwg, G, c;
    __host__ __device__ void init(int M, int N, int G_, int c_) { nM = M / BM; nN = N / BM; nwg = nM * nN; G = G_; c = c_; }
    __host__ __device__ bool next(int i, Unit& u) const {
        const long L = (long)i * G + c; if (L >= nwg) return false;
        int wgid = (int)L; { const int q = nwg / NXCD, r = nwg % NXCD, xcd = wgid % NXCD, off = wgid / NXCD; wgid = (xcd < r ? xcd * (q + 1) : r * (q + 1) + (xcd - r) * q) + off; }
        const int nig = WGM * nN, gid = wgid / nig, fm = gid * WGM, gsz = (nM - fm) < WGM ? (nM - fm) : WGM;
        u.pm = fm + ((wgid % nig) % gsz); u.pn = (wgid % nig) / gsz; return true;
    }
    __device__ __forceinline__ void a_ready(const Unit&) const {}
    __device__ __forceinline__ void done(const Unit&) const {}
};

__device__ __forceinline__ unsigned cvt_pk_bf16(float lo, float hi) { unsigned r; asm volatile("v_cvt_pk_bf16_f32 %0, %1, %2" : "=v"(r) : "v"(lo), "v"(hi)); return r; }
template <class Epi, class Sched, bool ALIGN_EPI = false, bool SP2 = false>
__device__ __forceinline__ void gemm_phase(PG8_LAS unsigned char* lds, const Gemm g, const Sched& S, const Epi& E, int wave_s) {
    const int tid = otid(wave_s), wid = __builtin_amdgcn_readfirstlane(tid >> 6), lane = tid & 63, wr = wid >> 2, wc = wid & 3, fr = lane & 15, fq = lane >> 4;
    const int K = g.K, nt = K / BK;
    unsigned voffA[2], voffB[2];
#pragma unroll
    for (int i = 0; i < 2; ++i) { int R, C; stage_rc(tid * 16 + i * 8192, R, C); const int Rb = Epi::PERM ? ((R & ~31) + perm32(R & 31)) : R;
        voffA[i] = (unsigned)(R * K + C) * 2u; voffB[i] = (unsigned)(Rb * K + C) * 2u; }
    const size_t kstep = (size_t)(BK * 2);
    const size_t hstep = (size_t)HALF * K * 2;
    const size_t tstep = 2 * hstep;
    const unsigned ldsw = (unsigned)wid * 1024u;
    const int aoff = lds_byte(wr * 64 + fr, fq * 8), boff = lds_byte(wc * 32 + fr, fq * 8);
#define PG8_SA(b, h) (((b) * 2 + (h)) * HTB)
#define PG8_SB(b, h) ((4 + (b) * 2 + (h)) * HTB)
#define PG8_STAGE(bufoff, gbase, voff) do { _Pragma("unroll") for (int _i = 0; _i < 2; ++_i) \
        __builtin_amdgcn_global_load_lds((const unsigned*)((const char*)(gbase) + (voff)[_i]), (PG8_LAS unsigned*)(lds + (bufoff) + ldsw + _i * 8192), 16, 0, 0); } while (0)
#define PG8_LDA(dst, b, h) do { _Pragma("unroll") for (int m = 0; m < 4; ++m) _Pragma("unroll") for (int k = 0; k < 2; ++k) dst[m][k] = *(const PG8_LAS bf16x8*)(lds + PG8_SA(b, h) + aoff + m * 2048 + k * 1024); } while (0)
#define PG8_LDB(dst, b, h) do { _Pragma("unroll") for (int n = 0; n < 2; ++n) _Pragma("unroll") for (int k = 0; k < 2; ++k) dst[n][k] = *(const PG8_LAS bf16x8*)(lds + PG8_SB(b, h) + boff + n * 2048 + k * 1024); } while (0)
#define PG8_MMA(ai, bj, At, Bt) do { __builtin_amdgcn_s_setprio(1); _Pragma("unroll") for (int m = 0; m < 4; ++m) _Pragma("unroll") for (int n = 0; n < 2; ++n) _Pragma("unroll") for (int k = 0; k < 2; ++k) \
        acc[ai][bj][m][n] = __builtin_amdgcn_mfma_f32_16x16x32_bf16(Bt[n][k], At[m][k], acc[ai][bj][m][n], 0, 0, 0); __builtin_amdgcn_s_setprio(0); } while (0)
#define PG8_WAIT_V(n) asm volatile("s_waitcnt vmcnt(" #n ")" ::: "memory")
#define PG8_WAIT_L(n) asm volatile("s_waitcnt lgkmcnt(" #n ")" ::: "memory")
#define PG8_BAR __builtin_amdgcn_s_barrier()
#define PG8_SCHED __builtin_amdgcn_sched_barrier(0)
    Unit cur, nxt; int ui = 0;
    if (!S.next(0, cur)) return;
    f32x4 acc[2][2][4][2];
#pragma unroll
    for (int a = 0; a < 2; ++a)
#pragma unroll
        for (int b = 0; b < 2; ++b)
#pragma unroll
            for (int m = 0; m < 4; ++m)
#pragma unroll
                for (int n = 0; n < 2; ++n) acc[a][b][m][n] = (f32x4){0.f, 0.f, 0.f, 0.f};
    bf16x8 At[4][2], B0[2][2], B1[2][2];
    const char* cA = (const char*)g.A + (size_t)cur.pm * tstep; const char* cB = (const char*)g.Bt + (size_t)cur.pn * tstep;
    S.a_ready(cur);
    if constexpr (SP2) {
        PG8_STAGE(PG8_SB(0, 0), cB, voffB); PG8_STAGE(PG8_SB(0, 1), cB + hstep, voffB); PG8_STAGE(PG8_SA(0, 0), cA, voffA); PG8_STAGE(PG8_SA(0, 1), cA + hstep, voffA);
        if (wr == 1) PG8_BAR;
        PG8_WAIT_V(2); PG8_BAR;
        PG8_STAGE(PG8_SB(1, 0), cB + kstep, voffB); PG8_STAGE(PG8_SA(1, 0), cA + kstep, voffA); PG8_STAGE(PG8_SB(1, 1), cB + hstep + kstep, voffB);
        PG8_WAIT_V(6); PG8_BAR;
    } else {
        PG8_STAGE(PG8_SB(0, 0), cB, voffB); PG8_STAGE(PG8_SA(0, 0), cA, voffA); PG8_STAGE(PG8_SB(0, 1), cB + hstep, voffB); PG8_STAGE(PG8_SA(0, 1), cA + hstep, voffA);
        if (wr == 1) PG8_BAR;
        PG8_WAIT_V(4); PG8_BAR;
        PG8_STAGE(PG8_SB(1, 0), cB + kstep, voffB); PG8_STAGE(PG8_SA(1, 0), cA + kstep, voffA); PG8_STAGE(PG8_SB(1, 1), cB + hstep + kstep, voffB);
        PG8_WAIT_V(6); PG8_BAR;
    }
    for (;;) {
        const bool has_next = S.next(ui + 1, nxt);
        const char* nA = has_next ? (const char*)g.A + (size_t)nxt.pm * tstep : cA; const char* nB = has_next ? (const char*)g.Bt + (size_t)nxt.pn * tstep : cB;
        for (int t = 0; t < nt; t += 2) {
            const bool last = (t == nt - 2);
            const char* a1 = cA + (size_t)(t + 1) * kstep;
            const char* a2 = last ? nA : cA + (size_t)(t + 2) * kstep; const char* b2 = last ? nB : cB + (size_t)(t + 2) * kstep;
            const char* a3 = a2 + kstep; const char* b3 = b2 + kstep;
            if (last && has_next) S.a_ready(nxt);
            if constexpr (SP2) {
            PG8_LDB(B0, 0, 0); PG8_LDB(B1, 0, 1); PG8_SCHED; PG8_LDA(At, 0, 0); PG8_STAGE(PG8_SA(1, 1), a1 + hstep, voffA);
            PG8_WAIT_V(8); PG8_WAIT_L(0); PG8_BAR; PG8_MMA(0, 0, At, B0); PG8_MMA(0, 1, At, B1); PG8_BAR; PG8_SCHED;
            PG8_LDA(At, 0, 1); PG8_STAGE(PG8_SB(0, 0), b2, voffB); PG8_STAGE(PG8_SB(0, 1), b2 + hstep, voffB); PG8_STAGE(PG8_SA(0, 0), a2, voffA);
            PG8_WAIT_V(8); PG8_WAIT_L(0); PG8_BAR; PG8_MMA(1, 0, At, B0); PG8_MMA(1, 1, At, B1); PG8_BAR; PG8_SCHED;
            PG8_LDB(B0, 1, 0); PG8_LDB(B1, 1, 1); PG8_SCHED; PG8_LDA(At, 1, 0); PG8_STAGE(PG8_SA(0, 1), a2 + hstep, voffA);
            PG8_WAIT_V(8); PG8_WAIT_L(0); PG8_BAR; PG8_MMA(0, 0, At, B0); PG8_MMA(0, 1, At, B1); PG8_BAR; PG8_SCHED;
            PG8_LDA(At, 1, 1); PG8_STAGE(PG8_SB(1, 0), b3, voffB); PG8_STAGE(PG8_SB(1, 1), b3 + hstep, voffB); PG8_STAGE(PG8_SA(1, 0), a3, voffA);
            PG8_WAIT_V(8); PG8_WAIT_L(0); PG8_BAR; PG8_MMA(1, 0, At, B0); PG8_MMA(1, 1, At, B1); PG8_BAR; PG8_SCHED;
            } else {
            PG8_LDB(B0, 0, 0); PG8_SCHED; PG8_LDA(At, 0, 0); PG8_STAGE(PG8_SA(1, 1), a1 + hstep, voffA);
            PG8_WAIT_L(8); PG8_BAR; PG8_WAIT_L(0); PG8_MMA(0, 0, At, B0); PG8_BAR; PG8_SCHED;
            PG8_LDB(B1, 0, 1); PG8_STAGE(PG8_SB(0, 0), b2, voffB);
            PG8_BAR; PG8_WAIT_L(0); PG8_MMA(0, 1, At, B1); PG8_BAR;
            PG8_LDA(At, 0, 1); PG8_STAGE(PG8_SA(0, 0), a2, voffA);
            PG8_BAR; PG8_WAIT_L(0); PG8_MMA(1, 0, At, B0); PG8_BAR; PG8_SCHED;
            PG8_STAGE(PG8_SB(0, 1), b2 + hstep, voffB);
            PG8_WAIT_V(6); PG8_BAR; PG8_MMA(1, 1, At, B1); PG8_BAR;
            PG8_LDB(B0, 1, 0); PG8_SCHED; PG8_LDA(At, 1, 0); PG8_STAGE(PG8_SA(0, 1), a2 + hstep, voffA);
            PG8_WAIT_L(8); PG8_BAR; PG8_WAIT_L(0); PG8_MMA(0, 0, At, B0); PG8_BAR; PG8_SCHED;
            PG8_LDB(B1, 1, 1); PG8_STAGE(PG8_SB(1, 0), b3, voffB);
            PG8_BAR; PG8_WAIT_L(0); PG8_MMA(0, 1, At, B1); PG8_BAR;
            PG8_LDA(At, 1, 1); PG8_STAGE(PG8_SA(1, 0), a3, voffA);
            PG8_BAR; PG8_WAIT_L(0); PG8_MMA(1, 0, At, B0); PG8_BAR; PG8_SCHED;
            PG8_STAGE(PG8_SB(1, 1), b3 + hstep, voffB);
            PG8_WAIT_V(6); PG8_BAR; PG8_MMA(1, 1, At, B1); PG8_BAR;
            }
        }
        if constexpr (ALIGN_EPI) { if (wr == 0) PG8_BAR; }
        if constexpr (!Epi::AFTER_DRAIN) { int fr2 = fr, fq2 = fq; asm volatile("" : "+v"(fr2), "+v"(fq2)); E(acc, cur, wr, wc, fr2, fq2); S.done(cur); }
        if (!has_next) break;
#pragma unroll
        for (int a = 0; a < 2; ++a)
#pragma unroll
            for (int b = 0; b < 2; ++b)
#pragma unroll
                for (int m = 0; m < 4; ++m)
#pragma unroll
                    for (int n = 0; n < 2; ++n) acc[a][b][m][n] = (f32x4){0.f, 0.f, 0.f, 0.f};
        cur = nxt; cA = nA; cB = nB; ++ui;
        if constexpr (ALIGN_EPI) { if (wr == 1) PG8_BAR; }
    }
    PG8_WAIT_V(0);
    if constexpr (!ALIGN_EPI) { if (wr == 0) PG8_BAR; }
    PG8_BAR;
    if constexpr (Epi::AFTER_DRAIN) { E.fused(acc, cur, wr, wc, fr, fq, lds, wid, lane); S.done(cur); }
#undef PG8_SA
#undef PG8_SB
#undef PG8_STAGE
#undef PG8_LDA
#undef PG8_LDB
#undef PG8_MMA
#undef PG8_WAIT_V
#undef PG8_WAIT_L
#undef PG8_BAR
#undef PG8_SCHED
}
}

#define LAS __attribute__((address_space(3)))
typedef unsigned short bf16_t;
typedef short bf16x8 __attribute__((ext_vector_type(8)));
typedef float f32x4 __attribute__((ext_vector_type(4)));
typedef float f32x16 __attribute__((ext_vector_type(16)));
typedef unsigned u32x4 __attribute__((ext_vector_type(4)));
typedef unsigned u32x2 __attribute__((ext_vector_type(2)));
typedef short v4i16_t __attribute__((ext_vector_type(4)));

constexpr int NB = 8, SEQ = 4096, DM = 1024, DEPTH = 4, MTOK = NB * SEQ, NIN = 2984, NINP = 3072;
constexpr float EPS_ = 1e-6f, LOG2E = 1.4426950408889634f;
constexpr float C2F = 0.125f * LOG2E;
constexpr float C2M = 0.10206207261596575f * LOG2E;
constexpr int LDS_BYTES = 132096;

constexpr size_t MiB = 1u << 20;
constexpr size_t WS_WIN = 2 * MiB, WS_WOUT = 26 * MiB, WS_WUQ = 34 * MiB, WS_WUKV = 36 * MiB, WS_MOD = 37 * MiB, WS_COS = 38 * MiB, WS_SIN = 40 * MiB,
                 WS_LOGF = 42 * MiB, WS_CUM = 43 * MiB, WS_SSQQ = 44 * MiB, WS_SSQK = 45 * MiB, WS_H = 48 * MiB, WS_QF = 112 * MiB, WS_KF = 144 * MiB,
                 WS_VF = 176 * MiB, WS_GATE = 208 * MiB, WS_QLAT = 272 * MiB, WS_KVLAT = 288 * MiB, WS_KR = 296 * MiB, WS_QM = 298 * MiB, WS_KM = 346 * MiB,
                 WS_VM = 378 * MiB, WS_END = 410 * MiB;

__device__ __forceinline__ unsigned f2bf(float f) { unsigned u = __builtin_bit_cast(unsigned, f); return (u + 0x7fffu + ((u >> 16) & 1u)) >> 16; }
typedef float f32x2_t __attribute__((ext_vector_type(2))); typedef __bf16 bf16x2_t __attribute__((ext_vector_type(2)));
__device__ __forceinline__ unsigned cvtpk_s(float lo, float hi) { f32x2_t v = {lo, hi}; bf16x2_t b = __builtin_convertvector(v, bf16x2_t); return __builtin_bit_cast(unsigned, b); }
__device__ __forceinline__ unsigned pk2(float lo, float hi) { return cvtpk_s(lo, hi); }
__device__ __forceinline__ float bf2f(bf16_t v) { return __builtin_bit_cast(float, (unsigned)v << 16); }
__device__ __forceinline__ u32x2 pk4(f32x4 v) { u32x2 w; w.x = pk2(v[0], v[1]); w.y = pk2(v[2], v[3]); return w; }
__device__ __forceinline__ float silu_f(float v) { return v * __builtin_amdgcn_rcpf(1.f + __builtin_amdgcn_exp2f(-1.4426950408889634f * v)); }
__device__ __forceinline__ f32x4 silu4(f32x4 v) { return (f32x4){silu_f(v[0]), silu_f(v[1]), silu_f(v[2]), silu_f(v[3])}; }
__device__ __forceinline__ float logsig_f(float x) { return fminf(x, 0.f) - log1pf(expf(-fabsf(x))); }
__device__ __forceinline__ float shx(float v, int mask, int lane) { return __builtin_bit_cast(float, __builtin_amdgcn_ds_bpermute((lane ^ mask) << 2, __builtin_bit_cast(int, v))); }
__device__ __forceinline__ float shup(float v, int off, int lane) { return __builtin_bit_cast(float, __builtin_amdgcn_ds_bpermute(((lane - off) & 63) << 2, __builtin_bit_cast(int, v))); }
__device__ __forceinline__ float wave_sum(float v, int lane) {
#pragma unroll
    for (int o = 1; o < 64; o <<= 1) v += shx(v, o, lane);
    return v;
}
#define LDS_WAIT() asm volatile("s_waitcnt lgkmcnt(0)" ::: "memory")


#define XB_TMO      128
#define XB_XCNT(j)  (256  + 64 * (j))
#define XB_XSUB(j)  (1280 + 64 * (j))
#define XB_XGEN(j)  (2304 + 64 * (j))
#define XB_TOP      3328
#define XB_TOPGEN   3392
#define XCD_BAR_WORDS 3456
#define XB_SPIN_CAP (1u << 18)
__device__ __forceinline__ unsigned xb_ld(unsigned* p)              { return __hip_atomic_load(p, __ATOMIC_RELAXED, __HIP_MEMORY_SCOPE_AGENT); }
__device__ __forceinline__ unsigned xb_add(unsigned* p, unsigned v) { return __hip_atomic_fetch_add(p, v, __ATOMIC_RELAXED, __HIP_MEMORY_SCOPE_AGENT); }
__device__ __forceinline__ unsigned xb_xcc_id() { return (unsigned)__builtin_amdgcn_s_getreg((3 << 11) | 20) & 0xFu; }
#define XB_SPIN(cond, bar) do { unsigned _sp = 0; while (cond) { __builtin_amdgcn_s_sleep(1); \
    if ((++_sp & 255u) == 0u) { if (xb_ld(&(bar)[XB_TMO])) break; if (_sp > XB_SPIN_CAP) { atomicAdd(&(bar)[XB_TMO], 1u); break; } } } } while (0)
__device__ __forceinline__ void xcd_barrier_complete(unsigned* bar, unsigned x, unsigned& nloc, unsigned& nx) {
    const unsigned G = gridDim.x * gridDim.y * gridDim.z;
    unsigned sum, cnt, mine, sp = 0u;
    for (;;) {
        sum = 0u; cnt = 0u; mine = 0u;
#pragma unroll
        for (unsigned j = 0; j < 16; ++j) { const unsigned c = xb_ld(&bar[XB_XCNT(j)]); sum += c; cnt += (c > 0u) ? 1u : 0u; mine = (j == x) ? c : mine; }
        if (sum == G) break;
        __builtin_amdgcn_s_sleep(1);
        if ((++sp & 255u) == 0u) { if (xb_ld(&bar[XB_TMO])) break; if (sp > XB_SPIN_CAP) { atomicAdd(&bar[XB_TMO], 1u); break; } }
    }
    nloc = mine > 0u ? mine : 1u; nx = cnt > 0u ? cnt : 1u;
}
__device__ __forceinline__ void xcd_barrier(unsigned* bar, volatile LAS unsigned* st, int tid) {
    asm volatile("s_waitcnt vmcnt(0)" ::: "memory");
    __syncthreads();
    if (tid == 0) {
        const unsigned x = xb_xcc_id();
        __builtin_amdgcn_s_waitcnt(0);
        unsigned nloc = st[0], nx = st[1];
        if (nloc == 0u) { xcd_barrier_complete(bar, x, nloc, nx); st[0] = nloc; st[1] = nx; }
        const unsigned old = xb_add(&bar[XB_XSUB(x)], 1u);
        const unsigned gen = old / nloc;
        if (old + 1u == (gen + 1u) * nloc) {
            __builtin_amdgcn_fence(__ATOMIC_RELEASE, "agent");
            asm volatile("s_waitcnt vmcnt(0)" ::: "memory");
            const unsigned og = xb_add(&bar[XB_TOP], 1u);
            const unsigned tg = og / nx;
            if (og + 1u == (tg + 1u) * nx) xb_add(&bar[XB_TOPGEN], 1u);
            else XB_SPIN(xb_ld(&bar[XB_TOPGEN]) == tg, bar);
            __builtin_amdgcn_fence(__ATOMIC_ACQUIRE, "agent");
            xb_add(&bar[XB_XGEN(x)], 1u);
            asm volatile("s_waitcnt vmcnt(0)" ::: "memory");
        } else {
            XB_SPIN(xb_ld(&bar[XB_XGEN(x)]) == gen, bar);
            __builtin_amdgcn_fence(__ATOMIC_ACQUIRE, "agent");
            asm volatile("s_waitcnt vmcnt(0)" ::: "memory");
        }
    }
    __syncthreads();
}

using pg8::Unit;
struct EpiIn {
    static constexpr bool PERM = false, AFTER_DRAIN = false;
    unsigned char* ws; const float* BF;
    __device__ __forceinline__ void operator()(const f32x4 (&acc)[2][2][4][2], const Unit& u, int wr, int wc, int fr, int fq) const {
        const int row0 = u.pm * 256 + wr * 64 + fr;
        bf16_t* QF = (bf16_t*)(ws + WS_QF); bf16_t* GATE = (bf16_t*)(ws + WS_GATE); bf16_t* QLAT = (bf16_t*)(ws + WS_QLAT); bf16_t* KVLAT = (bf16_t*)(ws + WS_KVLAT); bf16_t* KR = (bf16_t*)(ws + WS_KR);
        float* LOGF = (float*)(ws + WS_LOGF); float* SSQQ = (float*)(ws + WS_SSQQ); float* SSQK = (float*)(ws + WS_SSQK); const float* COS = (const float*)(ws + WS_COS); const float* SIN = (const float*)(ws + WS_SIN);
        if (u.pn == 8) {
#pragma unroll
            for (int ai = 0; ai < 2; ++ai)
#pragma unroll
                for (int m = 0; m < 4; ++m) {
                    float s = 0.f;
#pragma unroll
                    for (int bj = 0; bj < 2; ++bj)
#pragma unroll
                        for (int n = 0; n < 2; ++n) { const f32x4 x = acc[ai][bj][m][n]; s += (x[0] * x[0] + x[1] * x[1]) + (x[2] * x[2] + x[3] * x[3]); }
                    s += shx(s, 16, fq * 16 + fr); s += shx(s, 32, fq * 16 + fr);
                    if (fq == 0) SSQQ[(size_t)(row0 + ai * 128 + m * 16) * 4 + wc] = s;
                }
        } else if (u.pn == 9) {
#pragma unroll
            for (int ai = 0; ai < 2; ++ai)
#pragma unroll
                for (int m = 0; m < 4; ++m) {
                    float s = 0.f;
#pragma unroll
                    for (int n = 0; n < 2; ++n) { const f32x4 x = acc[ai][0][m][n]; s += (x[0] * x[0] + x[1] * x[1]) + (x[2] * x[2] + x[3] * x[3]); }
                    s += shx(s, 16, fq * 16 + fr); s += shx(s, 32, fq * 16 + fr);
                    if (fq == 0) SSQK[(size_t)(row0 + ai * 128 + m * 16) * 4 + wc] = s;
                }
        }
#pragma unroll
        for (int bj = 0; bj < 2; ++bj) {
            const int gcol = u.pn * 256 + bj * 128 + wc * 32;
            if (gcol < 1536) {
                const int seg = gcol >> 9; bf16_t* base = QF + (size_t)seg * ((WS_KF - WS_QF) / 2); const float sc = seg == 0 ? C2F : 1.f; const int c0 = (gcol & 511) + 4 * fq;
#pragma unroll
                for (int ai = 0; ai < 2; ++ai)
#pragma unroll
                    for (int m = 0; m < 4; ++m) { bf16_t* rp = base + (size_t)(row0 + ai * 128 + m * 16) * 512 + c0;
#pragma unroll
                        for (int n = 0; n < 2; ++n) *(u32x2*)(rp + 16 * n) = pk4(acc[ai][bj][m][n] * sc); }
            } else if (gcol < 2048 || (gcol >= 2464 && gcol < 2976)) {
                const int c0 = (gcol < 2048 ? gcol - 1536 : gcol - 2464 + 512) + 4 * fq;
#pragma unroll
                for (int ai = 0; ai < 2; ++ai)
#pragma unroll
                    for (int m = 0; m < 4; ++m) { bf16_t* rp = GATE + (size_t)(row0 + ai * 128 + m * 16) * 1024 + c0;
#pragma unroll
                        for (int n = 0; n < 2; ++n) *(u32x2*)(rp + 16 * n) = pk4(silu4(acc[ai][bj][m][n])); }
            } else if (gcol < 2304) {
                const int c0 = gcol - 2048 + 4 * fq;
#pragma unroll
                for (int ai = 0; ai < 2; ++ai)
#pragma unroll
                    for (int m = 0; m < 4; ++m) { bf16_t* rp = QLAT + (size_t)(row0 + ai * 128 + m * 16) * 256 + c0;
#pragma unroll
                        for (int n = 0; n < 2; ++n) *(u32x2*)(rp + 16 * n) = pk4(acc[ai][bj][m][n]); }
            } else if (gcol < 2432) {
                const int c0 = gcol - 2304 + 4 * fq;
#pragma unroll
                for (int ai = 0; ai < 2; ++ai)
#pragma unroll
                    for (int m = 0; m < 4; ++m) { bf16_t* rp = KVLAT + (size_t)(row0 + ai * 128 + m * 16) * 128 + c0;
#pragma unroll
                        for (int n = 0; n < 2; ++n) *(u32x2*)(rp + 16 * n) = pk4(acc[ai][bj][m][n]); }
            } else if (gcol < 2464) {
#pragma unroll
                for (int ai = 0; ai < 2; ++ai)
#pragma unroll
                    for (int m = 0; m < 4; ++m) { const size_t row = (size_t)(row0 + ai * 128 + m * 16);
                        const f32x4 cs = *(const f32x4*)(COS + row * 16 + 4 * fq), sn = *(const f32x4*)(SIN + row * 16 + 4 * fq);
                        const f32x4 t1 = acc[ai][bj][m][0], t2 = acc[ai][bj][m][1];
                        const f32x4 o1 = t1 * cs - t2 * sn, o2 = t2 * cs + t1 * sn;
                        bf16_t* rp = KR + row * 32 + 4 * fq; *(u32x2*)(rp) = pk4(o1); *(u32x2*)(rp + 16) = pk4(o2); if (m & 1) asm volatile("" ::: "memory"); }
            } else if (gcol == 2976) {
                if (fq < 2) {
                    const f32x4 bfv = *(const f32x4*)(BF + 4 * fq);
#pragma unroll
                    for (int ai = 0; ai < 2; ++ai)
#pragma unroll
                        for (int m = 0; m < 4; ++m) { const size_t row = (size_t)(row0 + ai * 128 + m * 16); const f32x4 v = acc[ai][bj][m][0] + bfv;
                            *(f32x4*)(LOGF + row * 8 + 4 * fq) = (f32x4){logsig_f(v[0]), logsig_f(v[1]), logsig_f(v[2]), logsig_f(v[3])}; }
                }
            }
        }
    }
};
struct EpiQ {
    static constexpr bool PERM = false, AFTER_DRAIN = false;
    unsigned char* ws;
    __device__ __forceinline__ void operator()(const f32x4 (&acc)[2][2][4][2], const Unit& u, int wr, int wc, int fr, int fq) const {
        const int row0 = u.pm * 256 + wr * 64 + fr;
        const float* SSQ = (const float*)(ws + WS_SSQQ); const float* COS = (const float*)(ws + WS_COS); const float* SIN = (const float*)(ws + WS_SIN); bf16_t* QM = (bf16_t*)(ws + WS_QM);
        float rs[2][4];
#pragma unroll
        for (int ai = 0; ai < 2; ++ai)
#pragma unroll
            for (int m = 0; m < 4; ++m) { const f32x4 s = *(const f32x4*)(SSQ + (size_t)(row0 + ai * 128 + m * 16) * 4); rs[ai][m] = rsqrtf(((s[0] + s[1]) + (s[2] + s[3])) * (1.f / 256.f) + EPS_) * C2M; }
#pragma unroll
        for (int bj = 0; bj < 2; ++bj) {
            const int gcol = u.pn * 256 + bj * 128 + wc * 32; const bool rope = ((gcol >> 5) % 3) == 2;
#pragma unroll
            for (int ai = 0; ai < 2; ++ai)
#pragma unroll
                for (int m = 0; m < 4; ++m) { const size_t row = (size_t)(row0 + ai * 128 + m * 16);
                    f32x4 v0 = acc[ai][bj][m][0] * rs[ai][m], v1 = acc[ai][bj][m][1] * rs[ai][m];
                    if (rope) { const f32x4 cs = *(const f32x4*)(COS + row * 16 + 4 * fq), sn = *(const f32x4*)(SIN + row * 16 + 4 * fq);
                        const f32x4 o1 = v0 * cs - v1 * sn, o2 = v1 * cs + v0 * sn; v0 = o1; v1 = o2; }
                    bf16_t* rp = QM + row * 768 + gcol + 4 * fq; *(u32x2*)(rp) = pk4(v0); *(u32x2*)(rp + 16) = pk4(v1); if (m & 1) asm volatile("" ::: "memory"); }
        }
    }
};
struct EpiKV {
    static constexpr bool PERM = false, AFTER_DRAIN = false;
    unsigned char* ws;
    __device__ __forceinline__ void operator()(const f32x4 (&acc)[2][2][4][2], const Unit& u, int wr, int wc, int fr, int fq) const {
        const int row0 = u.pm * 256 + wr * 64 + fr;
        const float* SSQ = (const float*)(ws + WS_SSQK); bf16_t* KM = (bf16_t*)(ws + WS_KM);
        float rs[2][4];
#pragma unroll
        for (int ai = 0; ai < 2; ++ai)
#pragma unroll
            for (int m = 0; m < 4; ++m) { const f32x4 s = *(const f32x4*)(SSQ + (size_t)(row0 + ai * 128 + m * 16) * 4); rs[ai][m] = rsqrtf(((s[0] + s[1]) + (s[2] + s[3])) * (1.f / 128.f) + EPS_); }
#pragma unroll
        for (int bj = 0; bj < 2; ++bj) {
            const int gcol = u.pn * 256 + bj * 128 + wc * 32; const int head = gcol >> 7, within = gcol & 127;
            bf16_t* base = KM + (within < 64 ? (size_t)0 : (size_t)((WS_VM - WS_KM) / 2)); const int c0 = head * 64 + (within & 63) + 4 * fq;
#pragma unroll
            for (int ai = 0; ai < 2; ++ai)
#pragma unroll
                for (int m = 0; m < 4; ++m) { bf16_t* rp = base + (size_t)(row0 + ai * 128 + m * 16) * 512 + c0;
#pragma unroll
                    for (int n = 0; n < 2; ++n) *(u32x2*)(rp + 16 * n) = pk4(acc[ai][bj][m][n] * rs[ai][m]); }
        }
    }
};
struct EpiOut {
    static constexpr bool PERM = false, AFTER_DRAIN = false;
    const float* XIN; float* XOUT; const float* MODG;
    __device__ __forceinline__ void operator()(const f32x4 (&acc)[2][2][4][2], const Unit& u, int wr, int wc, int fr, int fq) const {
        const int row0 = u.pm * 256 + wr * 64 + fr; const int b = (u.pm * 256) >> 12;
#pragma unroll
        for (int bj = 0; bj < 2; ++bj) {
            const int col = u.pn * 256 + bj * 128 + wc * 32 + 4 * fq;
            const f32x4 g0 = *(const f32x4*)(MODG + (size_t)b * 3072 + col), g1 = *(const f32x4*)(MODG + (size_t)b * 3072 + col + 16);
            f32x4 xi[2][4][2];
#pragma unroll
            for (int ai = 0; ai < 2; ++ai)
#pragma unroll
                for (int m = 0; m < 4; ++m) { const size_t off = (size_t)(row0 + ai * 128 + m * 16) * 1024 + col; xi[ai][m][0] = *(const f32x4*)(XIN + off); xi[ai][m][1] = *(const f32x4*)(XIN + off + 16); }
#pragma unroll
            for (int ai = 0; ai < 2; ++ai)
#pragma unroll
                for (int m = 0; m < 4; ++m) { const size_t off = (size_t)(row0 + ai * 128 + m * 16) * 1024 + col;
                    *(f32x4*)(XOUT + off) = xi[ai][m][0] + g0 * acc[ai][bj][m][0]; *(f32x4*)(XOUT + off + 16) = xi[ai][m][1] + g1 * acc[ai][bj][m][1]; }
            asm volatile("" ::: "memory");
        }
    }
};

__device__ __forceinline__ int crow(int r, int hi) { return (r & 3) + 8 * (r >> 2) + 4 * hi; }
__device__ __forceinline__ bf16x8 vtr2(const LAS unsigned char* p) {
    const v4i16_t lo = __builtin_amdgcn_ds_read_tr16_b64_v4i16((LAS v4i16_t*)p), hi = __builtin_amdgcn_ds_read_tr16_b64_v4i16((LAS v4i16_t*)(p + 512));
    return (bf16x8){lo[0], lo[1], lo[2], lo[3], hi[0], hi[1], hi[2], hi[3]};
}
constexpr int AT_KBUF = 13312, AT_OFF_V = 2 * AT_KBUF, AT_OFF_CK = AT_OFF_V + 2 * 8192, AT_OFF_WS = AT_OFF_CK + 512;

template <bool MLA>
__device__ __forceinline__ void attn_unit(LAS unsigned char* lds, int b, int h, int qb, unsigned char* ws, int wave_s) {
    constexpr int DQK = MLA ? 96 : 64, NDS = DQK / 16, KROW = MLA ? 208 : 144, QP = MLA ? 768 : 512;
    const bf16_t* Q = (const bf16_t*)(ws + (MLA ? WS_QM : WS_QF)); const bf16_t* K = (const bf16_t*)(ws + (MLA ? WS_KM : WS_KF)); const bf16_t* V = (const bf16_t*)(ws + (MLA ? WS_VM : WS_VF));
    const bf16_t* KRp = (const bf16_t*)(ws + WS_KR); const float* CUM = (const float*)(ws + WS_CUM); const bf16_t* GATE = (const bf16_t*)(ws + WS_GATE); bf16_t* Y = (bf16_t*)(ws + WS_H);
    const int tid = otid(wave_s), lane = tid & 63, r32 = lane & 31, hi = lane >> 5; const int wid = __builtin_amdgcn_readfirstlane(tid >> 6);
    const int par = 0;
    const int q0 = qb * 256, qw0 = q0 + wid * 32; const size_t rowbase = (size_t)b * SEQ;
    const int NT = q0 / 64 + 4;
    bf16x8 qr[NDS];
    { const bf16_t* qp = Q + (rowbase + qw0 + r32) * QP + h * DQK + hi * 8;
#pragma unroll
      for (int ds = 0; ds < NDS; ++ds) qr[ds] = *(const bf16x8*)(qp + ds * 16); }
    const int krow = tid >> 3, kch = tid & 7;
    const bf16_t* kgu = K + rowbase * 512 + h * 64; const unsigned koff = (unsigned)(krow * 512 + kch * 8); const int kdst = krow * KROW + kch * 16;
    const bf16_t* krgu = KRp + rowbase * 32; const unsigned kroff = (unsigned)((tid >> 2) * 32 + (tid & 3) * 8); const int krdst = (tid >> 2) * KROW + 128 + (tid & 3) * 16;
    const int vdh = tid >> 8, vrow = (tid >> 2) & 63, vc4 = tid & 3;
    const bf16_t* vgu = V + rowbase * 512 + h * 64; const unsigned voff = (unsigned)(vrow * 512 + vdh * 32 + vc4 * 8); const int vdst = AT_OFF_V + vdh * 4096 + vrow * 64 + vc4 * 16;
    const float* ckgu = CUM + (size_t)(b * 8 + h) * SEQ; const unsigned ckoff = (unsigned)(tid & 63);
    u32x4 kreg, krreg = (u32x4){0u, 0u, 0u, 0u}, vreg; float ckreg = 0.f;
#define AT_LOADK(t) do { kreg = *(const u32x4*)(kgu + (size_t)(t) * 64 * 512 + koff); \
        if (MLA) { if (tid < 256) krreg = *(const u32x4*)(krgu + (size_t)(t) * 64 * 32 + kroff); } else { if (tid < 64) ckreg = -ckgu[(size_t)(t) * 64 + ckoff]; } } while (0)
#define AT_STOREK(bf) do { *(LAS u32x4*)(lds + (bf) * AT_KBUF + kdst) = kreg; \
        if (MLA) { if (tid < 256) *(LAS u32x4*)(lds + (bf) * AT_KBUF + krdst) = krreg; } else { if (tid < 64) *(LAS float*)(lds + AT_OFF_CK + (bf) * 256 + tid * 4) = ckreg; } } while (0)
#define AT_LOADV(t) do { vreg = *(const u32x4*)(vgu + (size_t)(t) * 64 * 512 + voff); } while (0)
#define AT_STOREV(bf) do { *(LAS u32x4*)(lds + (bf) * 8192 + vdst) = vreg; } while (0)
    float mhat = -1e30f, lsum = 0.f; f32x16 o0 = {}, o1 = {};
    const int vb = AT_OFF_V + ((lane >> 4) & 1) * 32 + (lane & 3) * 8 + (4 * hi + ((lane & 15) >> 2)) * 64;
#define AT_QK(P0, P1, t_, MASKOK) do { const int bf_ = (t_) & 1; \
        if (!MLA) { _Pragma("unroll") for (int g = 0; g < 4; ++g) { const f32x4 c0 = *(const LAS f32x4*)(lds + AT_OFF_CK + bf_ * 256 + (8 * g + 4 * hi) * 4), c1 = *(const LAS f32x4*)(lds + AT_OFF_CK + bf_ * 256 + (32 + 8 * g + 4 * hi) * 4); \
                _Pragma("unroll") for (int e = 0; e < 4; ++e) { P0[4 * g + e] = c0[e]; P1[4 * g + e] = c1[e]; } } } \
        else { P0 = (f32x16){}; P1 = (f32x16){}; } \
        const LAS unsigned char* kb_ = lds + bf_ * AT_KBUF + r32 * KROW + hi * 16; \
        _Pragma("unroll") for (int ds = 0; ds < NDS; ++ds) { \
            const bf16x8 kf0 = *(const LAS bf16x8*)(kb_ + ds * 32), kf1 = *(const LAS bf16x8*)(kb_ + 32 * KROW + ds * 32); \
            P0 = __builtin_amdgcn_mfma_f32_32x32x16_bf16(kf0, qr[ds], P0, 0, 0, 0); \
            P1 = __builtin_amdgcn_mfma_f32_32x32x16_bf16(kf1, qr[ds], P1, 0, 0, 0); } \
        if (MASKOK && !MLA && (t_) * 64 + 63 > qw0) { const int q_ = qw0 + r32; \
            _Pragma("unroll") for (int r = 0; r < 16; ++r) { const int kv = (t_) * 64 + crow(r, hi); if (kv > q_) P0[r] = -INFINITY; if (kv + 32 > q_) P1[r] = -INFINITY; } } } while (0)
#define AT_QKF(P0, P1, t_, MASKOK) do { const int bf_ = (t_) & 1; \
        if (!MLA) { _Pragma("unroll") for (int g = 0; g < 4; ++g) { const f32x4 c0 = *(const LAS f32x4*)(lds + AT_OFF_CK + bf_ * 256 + (8 * g + 4 * hi) * 4), c1 = *(const LAS f32x4*)(lds + AT_OFF_CK + bf_ * 256 + (32 + 8 * g + 4 * hi) * 4); \
                _Pragma("unroll") for (int e = 0; e < 4; ++e) { P0[4 * g + e] = c0[e]; P1[4 * g + e] = c1[e]; } } } \
        else { P0 = (f32x16){}; P1 = (f32x16){}; } \
        const LAS unsigned char* kb_ = lds + bf_ * AT_KBUF + r32 * KROW + hi * 16; \
        _Pragma("unroll") for (int hb = 0; hb < 2; ++hb) { bf16x8 kf_[NDS]; \
            _Pragma("unroll") for (int d2 = 0; d2 < NDS / 2; ++d2) { const int ds = hb * (NDS / 2) + d2; kf_[2 * d2] = *(const LAS bf16x8*)(kb_ + ds * 32); kf_[2 * d2 + 1] = *(const LAS bf16x8*)(kb_ + 32 * KROW + ds * 32); } \
            __builtin_amdgcn_sched_barrier(0); \
            _Pragma("unroll") for (int d2 = 0; d2 < NDS / 2; ++d2) { const int ds = hb * (NDS / 2) + d2; \
                P0 = __builtin_amdgcn_mfma_f32_32x32x16_bf16(kf_[2 * d2], qr[ds], P0, 0, 0, 0); \
                P1 = __builtin_amdgcn_mfma_f32_32x32x16_bf16(kf_[2 * d2 + 1], qr[ds], P1, 0, 0, 0); } } \
        if (MASKOK && !MLA && (t_) * 64 + 63 > qw0) { const int q_ = qw0 + r32; \
            _Pragma("unroll") for (int r = 0; r < 16; ++r) { const int kv = (t_) * 64 + crow(r, hi); if (kv > q_) P0[r] = -INFINITY; if (kv + 32 > q_) P1[r] = -INFINITY; } } } while (0)
#define AT_SMPV(P0, P1, t_) do { const int bf_ = (t_) & 1; \
        float ra = fmaxf(fmaxf(P0[0], P0[1]), P1[0]), rb = fmaxf(fmaxf(P0[2], P0[3]), P1[1]); ra = fmaxf(fmaxf(ra, P1[2]), P1[3]); \
        _Pragma("unroll") for (int r = 4; r < 16; r += 4) { ra = fmaxf(fmaxf(ra, P0[r]), P0[r + 1]); rb = fmaxf(fmaxf(rb, P0[r + 2]), P0[r + 3]); ra = fmaxf(fmaxf(ra, P1[r]), P1[r + 1]); rb = fmaxf(fmaxf(rb, P1[r + 2]), P1[r + 3]); } \
        float rm = fmaxf(ra, rb); { auto rr = __builtin_amdgcn_permlane32_swap(__float_as_uint(rm), __float_as_uint(rm), false, false); rm = fmaxf(__uint_as_float(rr[0]), __uint_as_float(rr[1])); } \
        if (__any(rm > mhat + 16.f)) { \
            const float mnew = fmaxf(mhat, rm), alpha = __builtin_amdgcn_exp2f(mhat - mnew); \
            lsum *= alpha; mhat = mnew; \
            _Pragma("unroll") for (int r = 0; r < 16; ++r) { o0[r] *= alpha; o1[r] *= alpha; } } \
        float sacc = 0.f; \
        _Pragma("unroll") for (int r = 0; r < 16; ++r) { P0[r] = __builtin_amdgcn_exp2f(P0[r] - mhat); P1[r] = __builtin_amdgcn_exp2f(P1[r] - mhat); sacc += P0[r] + P1[r]; } \
        lsum += sacc; \
        u32x4 pw[4]; \
        _Pragma("unroll") for (int s = 0; s < 2; ++s) { \
            pw[s]     = (u32x4){cvtpk_s(P0[8 * s], P0[8 * s + 1]), cvtpk_s(P0[8 * s + 2], P0[8 * s + 3]), cvtpk_s(P0[8 * s + 4], P0[8 * s + 5]), cvtpk_s(P0[8 * s + 6], P0[8 * s + 7])}; \
            pw[2 + s] = (u32x4){cvtpk_s(P1[8 * s], P1[8 * s + 1]), cvtpk_s(P1[8 * s + 2], P1[8 * s + 3]), cvtpk_s(P1[8 * s + 4], P1[8 * s + 5]), cvtpk_s(P1[8 * s + 6], P1[8 * s + 7])}; } \
        const LAS unsigned char* vp_ = lds + vb + bf_ * 8192; \
        _Pragma("unroll") for (int s = 0; s < 4; ++s) { \
            const bf16x8 pa = __builtin_bit_cast(bf16x8, pw[s]); \
            const bf16x8 v0 = vtr2(vp_ + s * 1024), v1 = vtr2(vp_ + 4096 + s * 1024); \
            o0 = __builtin_amdgcn_mfma_f32_32x32x16_bf16(v0, pa, o0, 0, 0, 0); \
            o1 = __builtin_amdgcn_mfma_f32_32x32x16_bf16(v1, pa, o1, 0, 0, 0); } } while (0)
#define AT_STEP(PAR, C0, C1, N0, N1, t_) do { \
        if ((t_) + 2 < NT) AT_LOADK((t_) + 2); if ((t_) + 1 < NT) AT_LOADV((t_) + 1); \
        const bool actN_ = ((t_) + 1 < NT) && (((t_) + 1) * 64 <= qw0), actC_ = ((t_) * 64 <= qw0); \
        __builtin_amdgcn_sched_barrier(0); \
        if (PAR == 0) { if (actN_) AT_QK(N0, N1, (t_) + 1, true); if (actC_) AT_SMPV(C0, C1, t_); } \
        else          { if (actC_) AT_SMPV(C0, C1, t_); if (actN_) AT_QK(N0, N1, (t_) + 1, true); } \
        __builtin_amdgcn_sched_barrier(0); \
        if ((t_) + 2 < NT) AT_STOREK((t_) & 1); if ((t_) + 1 < NT) AT_STOREV(((t_) + 1) & 1); \
        __syncthreads(); } while (0)
#define AT_STEADY(PAR, C0, C1, N0, N1, t_) do { \
        AT_LOADK((t_) + 2); AT_LOADV((t_) + 1); \
        __builtin_amdgcn_sched_barrier(0); \
        if (PAR == 0) { AT_QKF(N0, N1, (t_) + 1, false); AT_SMPV(C0, C1, t_); } \
        else          { AT_SMPV(C0, C1, t_); AT_QK(N0, N1, (t_) + 1, false); \
            _Pragma("unroll") for (int i_ = 0; i_ < 2 * NDS; ++i_) { __builtin_amdgcn_sched_group_barrier(0x002, 12, 0); __builtin_amdgcn_sched_group_barrier(0x008, 1, 0); } } \
        __builtin_amdgcn_sched_barrier(0); \
        AT_STOREK((t_) & 1); AT_STOREV(((t_) + 1) & 1); \
        __syncthreads(); } while (0)
    f32x16 sa0, sa1, sb0, sb1;
    __syncthreads();
    AT_LOADK(0); AT_LOADV(0); AT_STOREK(0); AT_STOREV(0); AT_LOADK(1); AT_STOREK(1);
    __syncthreads();
    AT_QK(sa0, sa1, 0, true);
    __syncthreads();
    int t = 0;
    if (par == 0) {
        for (; t + 6 < NT; t += 2) { AT_STEADY(0, sa0, sa1, sb0, sb1, t); AT_STEADY(0, sb0, sb1, sa0, sa1, t + 1); }
        for (; t < NT; t += 2) { AT_STEP(0, sa0, sa1, sb0, sb1, t); AT_STEP(0, sb0, sb1, sa0, sa1, t + 1); }
    } else {
        for (; t + 6 < NT; t += 2) { AT_STEADY(1, sa0, sa1, sb0, sb1, t); AT_STEADY(1, sb0, sb1, sa0, sa1, t + 1); }
        for (; t < NT; t += 2) { AT_STEP(1, sa0, sa1, sb0, sb1, t); AT_STEP(1, sb0, sb1, sa0, sa1, t + 1); }
    }
#undef AT_LOADK
#undef AT_STOREK
#undef AT_LOADV
#undef AT_STOREV
#undef AT_QK
#undef AT_QKF
#undef AT_SMPV
#undef AT_STEP
#undef AT_STEADY
    float lt; { auto rr = __builtin_amdgcn_permlane32_swap(__float_as_uint(lsum), __float_as_uint(lsum), false, false); lt = __uint_as_float(rr[0]) + __uint_as_float(rr[1]); }
    const float rl = __builtin_amdgcn_rcpf(lt);
    const size_t ob = (rowbase + qw0 + r32) * 1024 + (MLA ? 512 : 0) + h * 64 + 4 * hi;
#pragma unroll
    for (int g = 0; g < 4; ++g) {
        const u32x2 ga = *(const u32x2*)(GATE + ob + 8 * g), gb = *(const u32x2*)(GATE + ob + 32 + 8 * g);
        f32x4 a = (f32x4){o0[4 * g], o0[4 * g + 1], o0[4 * g + 2], o0[4 * g + 3]} * rl, c = (f32x4){o1[4 * g], o1[4 * g + 1], o1[4 * g + 2], o1[4 * g + 3]} * rl;
        a = a * (f32x4){__builtin_bit_cast(float, ga.x << 16), __builtin_bit_cast(float, ga.x & 0xffff0000u), __builtin_bit_cast(float, ga.y << 16), __builtin_bit_cast(float, ga.y & 0xffff0000u)};
        c = c * (f32x4){__builtin_bit_cast(float, gb.x << 16), __builtin_bit_cast(float, gb.x & 0xffff0000u), __builtin_bit_cast(float, gb.y << 16), __builtin_bit_cast(float, gb.y & 0xffff0000u)};
        *(u32x2*)(Y + ob + 8 * g) = pk4(a); *(u32x2*)(Y + ob + 32 + 8 * g) = pk4(c);
    }
}

template <int MODE>
__device__ __forceinline__ void transpose_item(const float* __restrict__ W, int K, int Nsrc, int Ndst, bf16_t* __restrict__ WT, const float* __restrict__ kscale, LAS float* scr, int item, int lane) {
    const int nblk = Ndst / 32, kb = item / nblk, nb = item % nblk, k0 = 64 * kb, n0 = 32 * nb;
    const int nd = n0 + (lane & 31); int ns = nd; bool valid = true;
    if (MODE == 1) { if (nd < 1536) ns = nd; else if (nd < 2976) ns = nd + 8; else if (nd < 2984) ns = nd - 1440; else { ns = 0; valid = false; } }
#pragma unroll 32
    for (int i = 0; i < 32; ++i) { const int kk = 2 * i + (lane >> 5); float v = valid ? W[(size_t)(k0 + kk) * Nsrc + ns] : 0.f; if (kscale) v *= kscale[k0 + kk]; scr[kk * 33 + (lane & 31)] = v; }
    LDS_WAIT();
    const int c = lane & 7;
#pragma unroll
    for (int j = 0; j < 4; ++j) { const int n = (lane >> 3) + 8 * j; const LAS float* s = scr + (8 * c) * 33 + n;
        u32x4 o; o.x = pk2(s[0 * 33], s[1 * 33]); o.y = pk2(s[2 * 33], s[3 * 33]); o.z = pk2(s[4 * 33], s[5 * 33]); o.w = pk2(s[6 * 33], s[7 * 33]);
        *(u32x4*)(WT + (size_t)(n0 + n) * K + k0 + 8 * c) = o; }
    LDS_WAIT();
}

struct Args { const void* in[14]; float* out; unsigned char* ws; };

__global__ void __launch_bounds__(512) mk_fwd(Args args) {
    extern __shared__ __attribute__((aligned(16))) unsigned char smem[];
    LAS unsigned char* lds = (LAS unsigned char*)smem;
    cg::grid_group grid = cg::this_grid();
    const int wave_s = __builtin_amdgcn_readfirstlane((int)threadIdx.x >> 6);
    const int G = gridDim.x, bx = blockIdx.x, NGW = G * 8;
    unsigned char* ws = args.ws; float* X = args.out;
    float* MOD = (float*)(ws + WS_MOD);
    unsigned* bar = (unsigned*)ws;
    volatile LAS unsigned* bst = (volatile LAS unsigned*)(lds + 131072);
    { const int t0 = otid(wave_s); if (t0 < 2) bst[t0] = 0u; __syncthreads(); if (t0 == 0) (void)xb_add(&bar[XB_XCNT(xb_xcc_id())], 1u); }
#define GRID_BAR() xcd_barrier(bar, bst, otid(wave_s))

    {
        const int tid = otid(wave_s), lane = tid & 63; const int wave = __builtin_amdgcn_readfirstlane(tid >> 6); const int gw = bx * 8 + wave;
        const float* c_in = (const float*)args.in[1]; const int* pos_in = (const int*)args.in[2];
        const float* w_ada = (const float*)args.in[4]; const float* b_ada = (const float*)args.in[5];
        const float* w_in = (const float*)args.in[6]; const float* q_norm_g = (const float*)args.in[8];
        const float* w_uq = (const float*)args.in[9]; const float* kv_norm_g = (const float*)args.in[10]; const float* w_ukv = (const float*)args.in[11];
        const float* w_out = (const float*)args.in[12];
        bf16_t* WIN = (bf16_t*)(ws + WS_WIN); bf16_t* WOUT = (bf16_t*)(ws + WS_WOUT); bf16_t* WUQ = (bf16_t*)(ws + WS_WUQ); bf16_t* WUKV = (bf16_t*)(ws + WS_WUKV);
        float* COS = (float*)(ws + WS_COS); float* SIN = (float*)(ws + WS_SIN);
        for (int unit = bx; unit < DEPTH * 48; unit += G) {
            LAS float* cact = (LAS float*)lds; LAS float* red = (LAS float*)(lds + 32768);
            const int l = unit / 48, n = (unit % 48) * 64 + lane;
            for (int i = tid; i < NB * DM; i += 512) cact[i] = silu_f(c_in[i]);
            __syncthreads();
            float a[8];
#pragma unroll
            for (int b = 0; b < 8; ++b) a[b] = 0.f;
            const float* wp = w_ada + ((size_t)l * DM + 128 * wave) * 3072 + n;
#pragma unroll 16
            for (int kk = 0; kk < 128; ++kk) { const float wv = wp[(size_t)kk * 3072];
#pragma unroll
                for (int b = 0; b < 8; ++b) a[b] += cact[b * DM + 128 * wave + kk] * wv; }
#pragma unroll
            for (int b = 0; b < 8; ++b) red[(wave * 8 + b) * 64 + lane] = a[b];
            __syncthreads();
            { float s = b_ada[l * 3072 + n];
#pragma unroll
              for (int w2 = 0; w2 < 8; ++w2) s += red[(w2 * 8 + wave) * 64 + lane];
              MOD[(size_t)(l * 8 + wave) * 3072 + n] = s; }
            __syncthreads();
        }
        { LAS float* scr = (LAS float*)(lds + 49152) + wave * (64 * 33);
          constexpr int I_IN = 16 * 96, I_OUT = 16 * 32, I_UQ = 4 * 24, I_UKV = 2 * 32, I_L = I_IN + I_OUT + I_UQ + I_UKV;
          for (int it = gw; it < DEPTH * I_L; it += NGW) {
              const int l = it / I_L; int r = it % I_L;
              if (r < I_IN) { transpose_item<1>(w_in + (size_t)l * DM * NIN, DM, NIN, NINP, WIN + (size_t)l * NINP * DM, nullptr, scr, r, lane); continue; } r -= I_IN;
              if (r < I_OUT) { transpose_item<0>(w_out + (size_t)l * DM * DM, DM, DM, DM, WOUT + (size_t)l * DM * DM, nullptr, scr, r, lane); continue; } r -= I_OUT;
              if (r < I_UQ) { transpose_item<0>(w_uq + (size_t)l * 256 * 768, 256, 768, 768, WUQ + (size_t)l * 768 * 256, q_norm_g + l * 256, scr, r, lane); continue; } r -= I_UQ;
              transpose_item<0>(w_ukv + (size_t)l * 128 * 1024, 128, 1024, 1024, WUKV + (size_t)l * 1024 * 128, kv_norm_g + l * 128, scr, r, lane);
          } }
        for (int idx = bx * 512 + tid; idx < MTOK * 16; idx += G * 512) {
            const int tok = idx >> 4, i = idx & 15;
            const float inv = 1.0f / powf(10000.0f, (float)(2 * i) * (1.0f / 32.0f));
            const float ang = (float)pos_in[tok] * inv; float sn, cs; sincosf(ang, &sn, &cs);
            COS[idx] = cs; SIN[idx] = sn;
        }
    }

    grid.sync();
    for (int l = 0; l <= DEPTH; ++l) {
        if (l > 0) GRID_BAR();
        {
            const int tid = otid(wave_s), lane = tid & 63; const int wave = __builtin_amdgcn_readfirstlane(tid >> 6); const int gw = bx * 8 + wave;
            const bool fin = (l == DEPTH);
            const float* xs = (l == 0) ? (const float*)args.in[0] : X; const float* gsrc = fin ? (const float*)args.in[13] : (const float*)args.in[3] + l * DM;
            bf16_t* H = (bf16_t*)(ws + WS_H);
            for (int r0 = gw * 16; r0 < MTOK; r0 += NGW * 16) {
                const int b = r0 >> 12;
                f32x4 gs[4], sh[4];
#pragma unroll
                for (int j = 0; j < 4; ++j) { const int col = 4 * lane + 256 * j; const f32x4 g = *(const f32x4*)(gsrc + col);
                    if (fin) { gs[j] = g; sh[j] = (f32x4){0.f, 0.f, 0.f, 0.f}; }
                    else { const f32x4 sc = *(const f32x4*)(MOD + (size_t)(l * 8 + b) * 3072 + 1024 + col); gs[j] = g * (sc + 1.0f); sh[j] = *(const f32x4*)(MOD + (size_t)(l * 8 + b) * 3072 + col); } }
                for (int rr = 0; rr < 16; ++rr) {
                    const size_t row = (size_t)(r0 + rr);
                    f32x4 v[4]; float ss = 0.f;
#pragma unroll
                    for (int j = 0; j < 4; ++j) { v[j] = *(const f32x4*)(xs + row * DM + 4 * lane + 256 * j); ss += (v[j][0] * v[j][0] + v[j][1] * v[j][1]) + (v[j][2] * v[j][2] + v[j][3] * v[j][3]); }
                    const float rstd = rsqrtf(wave_sum(ss, lane) * (1.f / DM) + EPS_);
                    if (fin) {
#pragma unroll
                        for (int j = 0; j < 4; ++j) *(f32x4*)(X + row * DM + 4 * lane + 256 * j) = v[j] * rstd * gs[j];
                    } else {
#pragma unroll
                        for (int j = 0; j < 4; ++j) *(u32x2*)(H + row * DM + 4 * lane + 256 * j) = pk4(v[j] * rstd * gs[j] + sh[j]);
                    }
                }
            }
        }
        if (l == DEPTH) break;
        GRID_BAR();
        {
            pg8::Gemm g{(const bf16_t*)(ws + WS_H), (const bf16_t*)(ws + WS_WIN) + (size_t)l * NINP * DM, MTOK, NINP, DM}; pg8::StaticOrder S; S.init(MTOK, NINP, G, bx);
            EpiIn E{ws, (const float*)args.in[7] + l * 8};
            pg8::gemm_phase<EpiIn, pg8::StaticOrder, true, true>(lds, g, S, E, wave_s);
        }
        GRID_BAR();
        {
            const int tid = otid(wave_s), lane = tid & 63; const int wave = __builtin_amdgcn_readfirstlane(tid >> 6);
            const float* LOGF = (const float*)(ws + WS_LOGF); float* CUM = (float*)(ws + WS_CUM);
            for (int u = bx; u < 64; u += G) {
                LAS float* wsum = (LAS float*)lds;
                const float* lf = LOGF + (size_t)(u >> 3) * SEQ * 8 + (u & 7);
                float v[8]; float s = 0.f;
#pragma unroll
                for (int i = 0; i < 8; ++i) { s += lf[(size_t)(8 * tid + i) * 8]; v[i] = s; }
                float incl = s;
#pragma unroll
                for (int off = 1; off < 64; off <<= 1) { const float t = shup(incl, off, lane); if (lane >= off) incl += t; }
                if (lane == 63) wsum[wave] = incl;
                __syncthreads();
                float base = 0.f;
                for (int w2 = 0; w2 < wave; ++w2) base += wsum[w2];
                const float excl = base + incl - s;
#pragma unroll
                for (int i = 0; i < 8; ++i) CUM[(size_t)u * SEQ + 8 * tid + i] = (excl + v[i]) * LOG2E;
                __syncthreads();
            }
        }
        { pg8::Gemm g{(const bf16_t*)(ws + WS_QLAT), (const bf16_t*)(ws + WS_WUQ) + (size_t)l * 768 * 256, MTOK, 768, 256}; pg8::StaticOrder S; S.init(MTOK, 768, G, bx);
          EpiQ E{ws};
          pg8::gemm_phase<EpiQ, pg8::StaticOrder, true, true>(lds, g, S, E, wave_s); }
        __syncthreads();
        { pg8::Gemm g{(const bf16_t*)(ws + WS_KVLAT), (const bf16_t*)(ws + WS_WUKV) + (size_t)l * 1024 * 128, MTOK, 1024, 128}; pg8::StaticOrder S; S.init(MTOK, 1024, G, bx);
          EpiKV E{ws};
          pg8::gemm_phase<EpiKV, pg8::StaticOrder, true, true>(lds, g, S, E, wave_s); }
        GRID_BAR();
        {
            const int vcu = (G % 8 == 0) ? (bx % 8) * (G / 8) + bx / 8 : bx;
            for (int u = vcu; u < 2048; u += G) {
                const int i = u & 255, j = u >> 8; const int bh = i >> 2, s = i & 3, jj = j & 3;
                const int qb = (jj == 0) ? 15 - s : (jj == 1) ? 8 + s : (jj == 2) ? 7 - s : s;
                if (j < 4) attn_unit<true>(lds, bh >> 3, bh & 7, qb, ws, wave_s);
                else attn_unit<false>(lds, bh >> 3, bh & 7, qb, ws, wave_s);
            }
        }
        GRID_BAR();
        {
            pg8::Gemm g{(const bf16_t*)(ws + WS_H), (const bf16_t*)(ws + WS_WOUT) + (size_t)l * DM * DM, MTOK, DM, DM}; pg8::StaticOrder S; S.init(MTOK, DM, G, bx);
            EpiOut E{l == 0 ? (const float*)args.in[0] : X, X, MOD + (size_t)l * 8 * 3072 + 2048};
            pg8::gemm_phase<EpiOut, pg8::StaticOrder, true, true>(lds, g, S, E, wave_s);
        }
    }
}

extern "C" void kernel_launch(void* const* d_in, const int* in_sizes, int n_in, void* d_out, int out_size, void* d_ws, size_t ws_size, hipStream_t stream) {
    static int grid = 0;
    if (grid == 0) {
        if (n_in != 14 || out_size != MTOK * DM || ws_size < WS_END) { fprintf(stderr, "kernel_launch: unexpected shapes (n_in %d, out %d, ws %zu)\n", n_in, out_size, ws_size); grid = -1; return; }
        int dev = 0, cus = 0, per_cu = 0;
        (void)hipGetDevice(&dev); (void)hipDeviceGetAttribute(&cus, hipDeviceAttributeMultiprocessorCount, dev);
        (void)hipFuncSetAttribute((const void*)mk_fwd, hipFuncAttributeMaxDynamicSharedMemorySize, LDS_BYTES);
        if (hipOccupancyMaxActiveBlocksPerMultiprocessor(&per_cu, (const void*)mk_fwd, 512, LDS_BYTES) != hipSuccess || per_cu < 1) per_cu = 1;
        (void)hipGetLastError();
        grid = cus * per_cu;
    }
    if (grid < 0) return;
    (void)hipMemsetAsync(d_ws, 0, 16384, stream);
    Args a{};
    for (int i = 0; i < 14; ++i) a.in[i] = d_in[i];
    a.out = (float*)d_out; a.ws = (unsigned char*)d_ws;
    void* kargs[] = {&a};
    hipError_t e = hipLaunchCooperativeKernel((const void*)mk_fwd, dim3(grid), dim3(512), kargs, LDS_BYTES, stream);
    if (e != hipSuccess) fprintf(stderr, "cooperative launch failed: %s (grid %d)\n", hipGetErrorString(e), grid);
}
```

```cpp
#include <hip/hip_runtime.h>
#include <hip/hip_cooperative_groups.h>
#include <cstdio>
#include <cstdint>
#include <cmath>
namespace cg = cooperative_groups;
__device__ __forceinline__ int otid(int wave_s) { int l; asm volatile("v_mbcnt_lo_u32_b32 %0, -1, 0\n\tv_mbcnt_hi_u32_b32 %0, -1, %0" : "=v"(l)); int w = wave_s; asm volatile("" : "+s"(w)); return (w << 6) | l; }
namespace pg8 {
#define PG8_LAS __attribute__((address_space(3)))
typedef unsigned short bf16_t;
typedef short bf16x8 __attribute__((ext_vector_type(8)));
typedef float f32x4 __attribute__((ext_vector_type(4)));
typedef unsigned u32x4 __attribute__((ext_vector_type(4)));
constexpr int BM = 256, BK = 64, HALF = 128, HTB = HALF * BK * 2  , STAGE_BYTES = 8 * HTB, NXCD = 8, WGM = 8;

__host__ __device__ __forceinline__ int lds_byte(int r, int c) { const int st = (r >> 4) * 2 + (c >> 5), rr = r & 15, cc = c & 31, ob = rr * 64 + cc * 2; return st * 1024 + (ob ^ (((ob >> 9) & 1) << 5)); }
__host__ __device__ __forceinline__ void stage_rc(int b, int& R, int& C) { const int st = b / 1024, sb = b % 1024, swz = sb ^ (((sb >> 9) & 1) << 5); R = (st >> 1) * 16 + swz / 64; C = (st & 1) * 32 + (swz % 64) / 2; }
__host__ __device__ __forceinline__ int perm32(int rho) { const int n = rho >> 4, i = rho & 15; return 8 * (i >> 2) + 4 * n + (i & 3); }

struct Unit { int pm, pn; };
struct Gemm { const bf16_t* A; const bf16_t* Bt; int M, N, K; };

struct StaticOrder {
    int nM, nN, nwg, G, c;
    __host__ __device__ void init(int M, int N, int G_, int c_) { nM = M / BM; nN = N / BM; nwg = nM * nN; G = G_; c = c_; }
    __host__ __device__ bool next(int i, Unit& u) const {
        const long L = (long)i * G + c; if (L >= nwg) return false;
        int wgid = (int)L; { const int q = nwg / NXCD, r = nwg % NXCD, xcd = wgid % NXCD, off = wgid / NXCD; wgid = (xcd < r ? xcd * (q + 1) : r * (q + 1) + (xcd - r) * q) + off; }
        const int nig = WGM * nN, gid = wgid / nig, fm = gid * WGM, gsz = (nM - fm) < WGM ? (nM - fm) : WGM;
        u.pm = fm + ((wgid % nig) % gsz); u.pn = (wgid % nig) / gsz; return true;
    }
    __device__ __forceinline__ void a_ready(const Unit&) const {}
    __device__ __forceinline__ void done(const Unit&) const {}
};

__device__ __forceinline__ unsigned cvt_pk_bf16(float lo, float hi) { unsigned r; asm volatile("v_cvt_pk_bf16_f32 %0, %1, %2" : "=v"(r) : "v"(lo), "v"(hi)); return r; }
template <class Epi, class Sched, bool ALIGN_EPI = false, bool SP2 = false>
__device__ __forceinline__ void gemm_phase(PG8_LAS unsigned char* lds, const Gemm g, const Sched& S, const Epi& E, int wave_s) {
    const int tid = otid(wave_s), wid = __builtin_amdgcn_readfirstlane(tid >> 6), lane = tid & 63, wr = wid >> 2, wc = wid & 3, fr = lane & 15, fq = lane >> 4;
    const int K = g.K, nt = K / BK;
    unsigned voffA[2], voffB[2];
#pragma unroll
    for (int i = 0; i < 2; ++i) { int R, C; stage_rc(tid * 16 + i * 8192, R, C); const int Rb = Epi::PERM ? ((R & ~31) + perm32(R & 31)) : R;
        voffA[i] = (unsigned)(R * K + C) * 2u; voffB[i] = (unsigned)(Rb * K + C) * 2u; }
    const size_t kstep = (size_t)(BK * 2);
    const size_t hstep = (size_t)HALF * K * 2;
    const size_t tstep = 2 * hstep;
    const unsigned ldsw = (unsigned)wid * 1024u;
    const int aoff = lds_byte(wr * 64 + fr, fq * 8), boff = lds_byte(wc * 32 + fr, fq * 8);
#define PG8_SA(b, h) (((b) * 2 + (h)) * HTB)
#define PG8_SB(b, h) ((4 + (b) * 2 + (h)) * HTB)
#define PG8_STAGE(bufoff, gbase, voff) do { _Pragma("unroll") for (int _i = 0; _i < 2; ++_i) \
        __builtin_amdgcn_global_load_lds((const unsigned*)((const char*)(gbase) + (voff)[_i]), (PG8_LAS unsigned*)(lds + (bufoff) + ldsw + _i * 8192), 16, 0, 0); } while (0)
#define PG8_LDA(dst, b, h) do { _Pragma("unroll") for (int m = 0; m < 4; ++m) _Pragma("unroll") for (int k = 0; k < 2; ++k) dst[m][k] = *(const PG8_LAS bf16x8*)(lds + PG8_SA(b, h) + aoff + m * 2048 + k * 1024); } while (0)
#define PG8_LDB(dst, b, h) do { _Pragma("unroll") for (int n = 0; n < 2; ++n) _Pragma("unroll") for (int k = 0; k < 2; ++k) dst[n][k] = *(const PG8_LAS bf16x8*)(lds + PG8_SB(b, h) + boff + n * 2048 + k * 1024); } while (0)
#define PG8_MMA(ai, bj, At, Bt) do { __builtin_amdgcn_s_setprio(1); _Pragma("unroll") for (int m = 0; m < 4; ++m) _Pragma("unroll") for (int n = 0; n < 2; ++n) _Pragma("unroll") for (int k = 0; k < 2; ++k) \
        acc[ai][bj][m][n] = __builtin_amdgcn_mfma_f32_16x16x32_bf16(Bt[n][k], At[m][k], acc[ai][bj][m][n], 0, 0, 0); __builtin_amdgcn_s_setprio(0); } while (0)
#define PG8_WAIT_V(n) asm volatile("s_waitcnt vmcnt(" #n ")" ::: "memory")
#define PG8_WAIT_L(n) asm volatile("s_waitcnt lgkmcnt(" #n ")" ::: "memory")
#define PG8_BAR __builtin_amdgcn_s_barrier()
#define PG8_SCHED __builtin_amdgcn_sched_barrier(0)
    Unit cur, nxt; int ui = 0;
    if (!S.next(0, cur)) return;
    f32x4 acc[2][2][4][2];
#pragma unroll
    for (int a = 0; a < 2; ++a)
#pragma unroll
        for (int b = 0; b < 2; ++b)
#pragma unroll
            for (int m = 0; m < 4; ++m)
#pragma unroll
                for (int n = 0; n < 2; ++n) acc[a][b][m][n] = (f32x4){0.f, 0.f, 0.f, 0.f};
    bf16x8 At[4][2], B0[2][2], B1[2][2];
    const char* cA = (const char*)g.A + (size_t)cur.pm * tstep; const char* cB = (const char*)g.Bt + (size_t)cur.pn * tstep;
    S.a_ready(cur);
    if constexpr (SP2) {
        PG8_STAGE(PG8_SB(0, 0), cB, voffB); PG8_STAGE(PG8_SB(0, 1), cB + hstep, voffB); PG8_STAGE(PG8_SA(0, 0), cA, voffA); PG8_STAGE(PG8_SA(0, 1), cA + hstep, voffA);
        if (wr == 1) PG8_BAR;
        PG8_WAIT_V(2); PG8_BAR;
        PG8_STAGE(PG8_SB(1, 0), cB + kstep, voffB); PG8_STAGE(PG8_SA(1, 0), cA + kstep, voffA); PG8_STAGE(PG8_SB(1, 1), cB + hstep + kstep, voffB);
        PG8_WAIT_V(6); PG8_BAR;
    } else {
        PG8_STAGE(PG8_SB(0, 0), cB, voffB); PG8_STAGE(PG8_SA(0, 0), cA, voffA); PG8_STAGE(PG8_SB(0, 1), cB + hstep, voffB); PG8_STAGE(PG8_SA(0, 1), cA + hstep, voffA);
        if (wr == 1) PG8_BAR;
        PG8_WAIT_V(4); PG8_BAR;
        PG8_STAGE(PG8_SB(1, 0), cB + kstep, voffB); PG8_STAGE(PG8_SA(1, 0), cA + kstep, voffA); PG8_STAGE(PG8_SB(1, 1), cB + hstep + kstep, voffB);
        PG8_WAIT_V(6); PG8_BAR;
    }
    for (;;) {
        const bool has_next = S.next(ui + 1, nxt);
        const char* nA = has_next ? (const char*)g.A + (size_t)nxt.pm * tstep : cA; const char* nB = has_next ? (const char*)g.Bt + (size_t)nxt.pn * tstep : cB;
        for (int t = 0; t < nt; t += 2) {
            const bool last = (t == nt - 2);
            const char* a1 = cA + (size_t)(t + 1) * kstep;
            const char* a2 = last ? nA : cA + (size_t)(t + 2) * kstep; const char* b2 = last ? nB : cB + (size_t)(t + 2) * kstep;
            const char* a3 = a2 + kstep; const char* b3 = b2 + kstep;
            if (last && has_next) S.a_ready(nxt);
            if constexpr (SP2) {
            PG8_LDB(B0, 0, 0); PG8_LDB(B1, 0, 1); PG8_SCHED; PG8_LDA(At, 0, 0); PG8_STAGE(PG8_SA(1, 1), a1 + hstep, voffA);
            PG8_WAIT_V(8); PG8_WAIT_L(0); PG8_BAR; PG8_MMA(0, 0, At, B0); PG8_MMA(0, 1, At, B1); PG8_BAR; PG8_SCHED;
            PG8_LDA(At, 0, 1); PG8_STAGE(PG8_SB(0, 0), b2, voffB); PG8_STAGE(PG8_SB(0, 1), b2 + hstep, voffB); PG8_STAGE(PG8_SA(0, 0), a2, voffA);
            PG8_WAIT_V(8); PG8_WAIT_L(0); PG8_BAR; PG8_MMA(1, 0, At, B0); PG8_MMA(1, 1, At, B1); PG8_BAR; PG8_SCHED;
            PG8_LDB(B0, 1, 0); PG8_LDB(B1, 1, 1); PG8_SCHED; PG8_LDA(At, 1, 0); PG8_STAGE(PG8_SA(0, 1), a2 + hstep, voffA);
            PG8_WAIT_V(8); PG8_WAIT_L(0); PG8_BAR; PG8_MMA(0, 0, At, B0); PG8_MMA(0, 1, At, B1); PG8_BAR; PG8_SCHED;
            PG8_LDA(At, 1, 1); PG8_STAGE(PG8_SB(1, 0), b3, voffB); PG8_STAGE(PG8_SB(1, 1), b3 + hstep, voffB); PG8_STAGE(PG8_SA(1, 0), a3, voffA);
            PG8_WAIT_V(8); PG8_WAIT_L(0); PG8_BAR; PG8_MMA(1, 0, At, B0); PG8_MMA(1, 1, At, B1); PG8_BAR; PG8_SCHED;
            } else {
            PG8_LDB(B0, 0, 0); PG8_SCHED; PG8_LDA(At, 0, 0); PG8_STAGE(PG8_SA(1, 1), a1 + hstep, voffA);
            PG8_WAIT_L(8); PG8_BAR; PG8_WAIT_L(0); PG8_MMA(0, 0, At, B0); PG8_BAR; PG8_SCHED;
            PG8_LDB(B1, 0, 1); PG8_STAGE(PG8_SB(0, 0), b2, voffB);
            PG8_BAR; PG8_WAIT_L(0); PG8_MMA(0, 1, At, B1); PG8_BAR;
            PG8_LDA(At, 0, 1); PG8_STAGE(PG8_SA(0, 0), a2, voffA);
            PG8_BAR; PG8_WAIT_L(0); PG8_MMA(1, 0, At, B0); PG8_BAR; PG8_SCHED;
            PG8_STAGE(PG8_SB(0, 1), b2 + hstep, voffB);
            PG8_WAIT_V(6); PG8_BAR; PG8_MMA(1, 1, At, B1); PG8_BAR;
            PG8_LDB(B0, 1, 0); PG8_SCHED; PG8_LDA(At, 1, 0); PG8_STAGE(PG8_SA(0, 1), a2 + hstep, voffA);
            PG8_WAIT_L(8); PG8_BAR; PG8_WAIT_L(0); PG8_MMA(0, 0, At, B0); PG8_BAR; PG8_SCHED;
            PG8_LDB(B1, 1, 1); PG8_STAGE(PG8_SB(1, 0), b3, voffB);
            PG8_BAR; PG8_WAIT_L(0); PG8_MMA(0, 1, At, B1); PG8_BAR;
            PG8_LDA(At, 1, 1); PG8_STAGE(PG8_SA(1, 0), a3, voffA);
            PG8_BAR; PG8_WAIT_L(0); PG8_MMA(1, 0, At, B0); PG8_BAR; PG8_SCHED;
            PG8_STAGE(PG8_SB(1, 1), b3 + hstep, voffB);
            PG8_WAIT_V(6); PG8_BAR; PG8_MMA(1, 1, At, B1); PG8_BAR;
            }
        }
        if constexpr (ALIGN_EPI) { if (wr == 0) PG8_BAR; }
        if constexpr (!Epi::AFTER_DRAIN) { int fr2 = fr, fq2 = fq; asm volatile("" : "+v"(fr2), "+v"(fq2)); E(acc, cur, wr, wc, fr2, fq2); S.done(cur); }
        if (!has_next) break;
#pragma unroll
        for (int a = 0; a < 2; ++a)
#pragma unroll
            for (int b = 0; b < 2; ++b)
#pragma unroll
                for (int m = 0; m < 4; ++m)
#pragma unroll
                    for (int n = 0; n < 2; ++n) acc[a][b][m][n] = (f32x4){0.f, 0.f, 0.f, 0.f};
        cur = nxt; cA = nA; cB = nB; ++ui;
        if constexpr (ALIGN_EPI) { if (wr == 1) PG8_BAR; }
    }
    PG8_WAIT_V(0);
    if constexpr (!ALIGN_EPI) { if (wr == 0) PG8_BAR; }
    PG8_BAR;
    if constexpr (Epi::AFTER_DRAIN) { E.fused(acc, cur, wr, wc, fr, fq, lds, wid, lane); S.done(cur); }
#undef PG8_SA
#undef PG8_SB
#undef PG8_STAGE
#undef PG8_LDA
#undef PG8_LDB
#undef PG8_MMA
#undef PG8_WAIT_V
#undef PG8_WAIT_L
#undef PG8_BAR
#undef PG8_SCHED
}
}

#define LAS __attribute__((address_space(3)))
typedef unsigned short bf16_t;
typedef short bf16x8 __attribute__((ext_vector_type(8)));
typedef float f32x4 __attribute__((ext_vector_type(4)));
typedef float f32x16 __attribute__((ext_vector_type(16)));
typedef unsigned u32x4 __attribute__((ext_vector_type(4)));
typedef unsigned u32x2 __attribute__((ext_vector_type(2)));
typedef short v4i16_t __attribute__((ext_vector_type(4)));

constexpr int NB = 8, SEQ = 4096, DM = 1024, DEPTH = 4, MTOK = NB * SEQ, NIN = 2984, NINP = 3072;
constexpr float EPS_ = 1e-6f, LOG2E = 1.4426950408889634f;
constexpr float C2F = 0.125f * LOG2E;
constexpr float C2M = 0.10206207261596575f * LOG2E;
constexpr int LDS_BYTES = 132096;

constexpr size_t MiB = 1u << 20;
constexpr size_t WS_WIN = 2 * MiB, WS_WOUT = 26 * MiB, WS_WUQ = 34 * MiB, WS_WUKV = 36 * MiB, WS_MOD = 37 * MiB, WS_COS = 38 * MiB, WS_SIN = 40 * MiB,
                 WS_LOGF = 42 * MiB, WS_CUM = 43 * MiB, WS_SSQQ = 44 * MiB, WS_SSQK = 45 * MiB, WS_H = 48 * MiB, WS_QF = 112 * MiB, WS_KF = 144 * MiB,
                 WS_VF = 176 * MiB, WS_GATE = 208 * MiB, WS_QLAT = 272 * MiB, WS_KVLAT = 288 * MiB, WS_KR = 296 * MiB, WS_QM = 298 * MiB, WS_KM = 346 * MiB,
                 WS_VM = 378 * MiB, WS_END = 410 * MiB;
constexpr size_t WS_SB = 47 * MiB;
constexpr int CTR_WORD = 3500;

__device__ __forceinline__ unsigned f2bf(float f) { unsigned u = __builtin_bit_cast(unsigned, f); return (u + 0x7fffu + ((u >> 16) & 1u)) >> 16; }
typedef float f32x2_t __attribute__((ext_vector_type(2))); typedef __bf16 bf16x2_t __attribute__((ext_vector_type(2)));
__device__ __forceinline__ unsigned cvtpk_s(float lo, float hi) { f32x2_t v = {lo, hi}; bf16x2_t b = __builtin_convertvector(v, bf16x2_t); return __builtin_bit_cast(unsigned, b); }
__device__ __forceinline__ unsigned pk2(float lo, float hi) { return cvtpk_s(lo, hi); }
__device__ __forceinline__ float bf2f(bf16_t v) { return __builtin_bit_cast(float, (unsigned)v << 16); }
__device__ __forceinline__ u32x2 pk4(f32x4 v) { u32x2 w; w.x = pk2(v[0], v[1]); w.y = pk2(v[2], v[3]); return w; }
__device__ __forceinline__ float silu_f(float v) { return v * __builtin_amdgcn_rcpf(1.f + __builtin_amdgcn_exp2f(-1.4426950408889634f * v)); }
__device__ __forceinline__ f32x4 silu4(f32x4 v) { return (f32x4){silu_f(v[0]), silu_f(v[1]), silu_f(v[2]), silu_f(v[3])}; }
__device__ __forceinline__ float logsig_f(float x) { return fminf(x, 0.f) - log1pf(expf(-fabsf(x))); }
__device__ __forceinline__ float shx(float v, int mask, int lane) { return __builtin_bit_cast(float, __builtin_amdgcn_ds_bpermute((lane ^ mask) << 2, __builtin_bit_cast(int, v))); }
__device__ __forceinline__ float shup(float v, int off, int lane) { return __builtin_bit_cast(float, __builtin_amdgcn_ds_bpermute(((lane - off) & 63) << 2, __builtin_bit_cast(int, v))); }
__device__ __forceinline__ float wave_sum(float v, int lane) {
#pragma unroll
    for (int o = 1; o < 64; o <<= 1) v += shx(v, o, lane);
    return v;
}
#define LDS_WAIT() asm volatile("s_waitcnt lgkmcnt(0)" ::: "memory")


#define XB_TMO      128
#define XB_XCNT(j)  (256  + 64 * (j))
#define XB_XSUB(j)  (1280 + 64 * (j))
#define XB_XGEN(j)  (2304 + 64 * (j))
#define XB_TOP      3328
#define XB_TOPGEN   3392
#define XCD_BAR_WORDS 3456
#define XB_SPIN_CAP (1u << 18)
__device__ __forceinline__ unsigned xb_ld(unsigned* p)              { return __hip_atomic_load(p, __ATOMIC_RELAXED, __HIP_MEMORY_SCOPE_AGENT); }
__device__ __forceinline__ unsigned xb_add(unsigned* p, unsigned v) { return __hip_atomic_fetch_add(p, v, __ATOMIC_RELAXED, __HIP_MEMORY_SCOPE_AGENT); }
__device__ __forceinline__ unsigned xb_xcc_id() { return (unsigned)__builtin_amdgcn_s_getreg((3 << 11) | 20) & 0xFu; }
#define XB_SPIN(cond, bar) do { unsigned _sp = 0; while (cond) { __builtin_amdgcn_s_sleep(1); \
    if ((++_sp & 255u) == 0u) { if (xb_ld(&(bar)[XB_TMO])) break; if (_sp > XB_SPIN_CAP) { atomicAdd(&(bar)[XB_TMO], 1u); break; } } } } while (0)
__device__ __forceinline__ void xcd_barrier_complete(unsigned* bar, unsigned x, unsigned& nloc, unsigned& nx) {
    const unsigned G = gridDim.x * gridDim.y * gridDim.z;
    unsigned sum, cnt, mine, sp = 0u;
    for (;;) {
        sum = 0u; cnt = 0u; mine = 0u;
#pragma unroll
        for (unsigned j = 0; j < 16; ++j) { const unsigned c = xb_ld(&bar[XB_XCNT(j)]); sum += c; cnt += (c > 0u) ? 1u : 0u; mine = (j == x) ? c : mine; }
        if (sum == G) break;
        __builtin_amdgcn_s_sleep(1);
        if ((++sp & 255u) == 0u) { if (xb_ld(&bar[XB_TMO])) break; if (sp > XB_SPIN_CAP) { atomicAdd(&bar[XB_TMO], 1u); break; } }
    }
    nloc = mine > 0u ? mine : 1u; nx = cnt > 0u ? cnt : 1u;
}
__device__ __forceinline__ void xcd_barrier(unsigned* bar, volatile LAS unsigned* st, int tid) {
    asm volatile("s_waitcnt vmcnt(0)" ::: "memory");
    __syncthreads();
    if (tid == 0) {
        const unsigned x = xb_xcc_id();
        __builtin_amdgcn_s_waitcnt(0);
        unsigned nloc = st[0], nx = st[1];
        if (nloc == 0u) { xcd_barrier_complete(bar, x, nloc, nx); st[0] = nloc; st[1] = nx; }
        const unsigned old = xb_add(&bar[XB_XSUB(x)], 1u);
        const unsigned gen = old / nloc;
        if (old + 1u == (gen + 1u) * nloc) {
            __builtin_amdgcn_fence(__ATOMIC_RELEASE, "agent");
            asm volatile("s_waitcnt vmcnt(0)" ::: "memory");
            const unsigned og = xb_add(&bar[XB_TOP], 1u);
            const unsigned tg = og / nx;
            if (og + 1u == (tg + 1u) * nx) xb_add(&bar[XB_TOPGEN], 1u);
            else XB_SPIN(xb_ld(&bar[XB_TOPGEN]) == tg, bar);
            __builtin_amdgcn_fence(__ATOMIC_ACQUIRE, "agent");
            xb_add(&bar[XB_XGEN(x)], 1u);
            asm volatile("s_waitcnt vmcnt(0)" ::: "memory");
        } else {
            XB_SPIN(xb_ld(&bar[XB_XGEN(x)]) == gen, bar);
            __builtin_amdgcn_fence(__ATOMIC_ACQUIRE, "agent");
            asm volatile("s_waitcnt vmcnt(0)" ::: "memory");
        }
    }
    __syncthreads();
}

using pg8::Unit;
struct EpiIn {
    static constexpr bool PERM = false, AFTER_DRAIN = false;
    unsigned char* ws; const float* BF;
    __device__ __forceinline__ void operator()(const f32x4 (&acc)[2][2][4][2], const Unit& u, int wr, int wc, int fr, int fq) const {
        const int row0 = u.pm * 256 + wr * 64 + fr;
        bf16_t* QF = (bf16_t*)(ws + WS_QF); bf16_t* GATE = (bf16_t*)(ws + WS_GATE); bf16_t* QLAT = (bf16_t*)(ws + WS_QLAT); bf16_t* KVLAT = (bf16_t*)(ws + WS_KVLAT); bf16_t* KR = (bf16_t*)(ws + WS_KR);
        float* LOGF = (float*)(ws + WS_LOGF); float* SSQQ = (float*)(ws + WS_SSQQ); float* SSQK = (float*)(ws + WS_SSQK); const float* COS = (const float*)(ws + WS_COS); const float* SIN = (const float*)(ws + WS_SIN);
        if (u.pn == 8) {
#pragma unroll
            for (int ai = 0; ai < 2; ++ai)
#pragma unroll
                for (int m = 0; m < 4; ++m) {
                    float s = 0.f;
#pragma unroll
                    for (int bj = 0; bj < 2; ++bj)
#pragma unroll
                        for (int n = 0; n < 2; ++n) { const f32x4 x = acc[ai][bj][m][n]; s += (x[0] * x[0] + x[1] * x[1]) + (x[2] * x[2] + x[3] * x[3]); }
                    s += shx(s, 16, fq * 16 + fr); s += shx(s, 32, fq * 16 + fr);
                    if (fq == 0) SSQQ[(size_t)(row0 + ai * 128 + m * 16) * 4 + wc] = s;
                }
        } else if (u.pn == 9) {
#pragma unroll
            for (int ai = 0; ai < 2; ++ai)
#pragma unroll
                for (int m = 0; m < 4; ++m) {
                    float s = 0.f;
#pragma unroll
                    for (int n = 0; n < 2; ++n) { const f32x4 x = acc[ai][0][m][n]; s += (x[0] * x[0] + x[1] * x[1]) + (x[2] * x[2] + x[3] * x[3]); }
                    s += shx(s, 16, fq * 16 + fr); s += shx(s, 32, fq * 16 + fr);
                    if (fq == 0) SSQK[(size_t)(row0 + ai * 128 + m * 16) * 4 + wc] = s;
                }
        }
#pragma unroll
        for (int bj = 0; bj < 2; ++bj) {
            const int gcol = u.pn * 256 + bj * 128 + wc * 32;
            if (gcol < 1536) {
                const int seg = gcol >> 9; bf16_t* base = QF + (size_t)seg * ((WS_KF - WS_QF) / 2); const float sc = seg == 0 ? C2F : 1.f; const int c0 = (gcol & 511) + 4 * fq;
#pragma unroll
                for (int ai = 0; ai < 2; ++ai)
#pragma unroll
                    for (int m = 0; m < 4; ++m) { bf16_t* rp = base + (size_t)(row0 + ai * 128 + m * 16) * 512 + c0;
#pragma unroll
                        for (int n = 0; n < 2; ++n) *(u32x2*)(rp + 16 * n) = pk4(acc[ai][bj][m][n] * sc); }
            } else if (gcol < 2048 || (gcol >= 2464 && gcol < 2976)) {
                const int c0 = (gcol < 2048 ? gcol - 1536 : gcol - 2464 + 512) + 4 * fq;
#pragma unroll
                for (int ai = 0; ai < 2; ++ai)
#pragma unroll
                    for (int m = 0; m < 4; ++m) { bf16_t* rp = GATE + (size_t)(row0 + ai * 128 + m * 16) * 1024 + c0;
#pragma unroll
                        for (int n = 0; n < 2; ++n) *(u32x2*)(rp + 16 * n) = pk4(silu4(acc[ai][bj][m][n])); }
            } else if (gcol < 2304) {
                const int c0 = gcol - 2048 + 4 * fq;
#pragma unroll
                for (int ai = 0; ai < 2; ++ai)
#pragma unroll
                    for (int m = 0; m < 4; ++m) { bf16_t* rp = QLAT + (size_t)(row0 + ai * 128 + m * 16) * 256 + c0;
#pragma unroll
                        for (int n = 0; n < 2; ++n) *(u32x2*)(rp + 16 * n) = pk4(acc[ai][bj][m][n]); }
            } else if (gcol < 2432) {
                const int c0 = gcol - 2304 + 4 * fq;
#pragma unroll
                for (int ai = 0; ai < 2; ++ai)
#pragma unroll
                    for (int m = 0; m < 4; ++m) { bf16_t* rp = KVLAT + (size_t)(row0 + ai * 128 + m * 16) * 128 + c0;
#pragma unroll
                        for (int n = 0; n < 2; ++n) *(u32x2*)(rp + 16 * n) = pk4(acc[ai][bj][m][n]); }
            } else if (gcol < 2464) {
#pragma unroll
                for (int ai = 0; ai < 2; ++ai)
#pragma unroll
                    for (int m = 0; m < 4; ++m) { const size_t row = (size_t)(row0 + ai * 128 + m * 16);
                        const f32x4 cs = *(const f32x4*)(COS + row * 16 + 4 * fq), sn = *(const f32x4*)(SIN + row * 16 + 4 * fq);
                        const f32x4 t1 = acc[ai][bj][m][0], t2 = acc[ai][bj][m][1];
                        const f32x4 o1 = t1 * cs - t2 * sn, o2 = t2 * cs + t1 * sn;
                        bf16_t* rp = KR + row * 32 + 4 * fq; *(u32x2*)(rp) = pk4(o1); *(u32x2*)(rp + 16) = pk4(o2); if (m & 1) asm volatile("" ::: "memory"); }
            } else if (gcol == 2976) {
                if (fq < 2) {
                    const f32x4 bfv = *(const f32x4*)(BF + 4 * fq);
#pragma unroll
                    for (int ai = 0; ai < 2; ++ai)
#pragma unroll
                        for (int m = 0; m < 4; ++m) { const size_t row = (size_t)(row0 + ai * 128 + m * 16); const f32x4 v = acc[ai][bj][m][0] + bfv;
                            *(f32x4*)(LOGF + row * 8 + 4 * fq) = (f32x4){logsig_f(v[0]), logsig_f(v[1]), logsig_f(v[2]), logsig_f(v[3])}; }
                }
            }
        }
    }
};
struct EpiQ {
    static constexpr bool PERM = false, AFTER_DRAIN = false;
    unsigned char* ws;
    __device__ __forceinline__ void operator()(const f32x4 (&acc)[2][2][4][2], const Unit& u, int wr, int wc, int fr, int fq) const {
        const int row0 = u.pm * 256 + wr * 64 + fr;
        const float* SSQ = (const float*)(ws + WS_SSQQ); const float* COS = (const float*)(ws + WS_COS); const float* SIN = (const float*)(ws + WS_SIN); bf16_t* QM = (bf16_t*)(ws + WS_QM);
        float rs[2][4];
#pragma unroll
        for (int ai = 0; ai < 2; ++ai)
#pragma unroll
            for (int m = 0; m < 4; ++m) { const f32x4 s = *(const f32x4*)(SSQ + (size_t)(row0 + ai * 128 + m * 16) * 4); rs[ai][m] = rsqrtf(((s[0] + s[1]) + (s[2] + s[3])) * (1.f / 256.f) + EPS_) * C2M; }
#pragma unroll
        for (int bj = 0; bj < 2; ++bj) {
            const int gcol = u.pn * 256 + bj * 128 + wc * 32; const bool rope = ((gcol >> 5) % 3) == 2;
#pragma unroll
            for (int ai = 0; ai < 2; ++ai)
#pragma unroll
                for (int m = 0; m < 4; ++m) { const size_t row = (size_t)(row0 + ai * 128 + m * 16);
                    f32x4 v0 = acc[ai][bj][m][0] * rs[ai][m], v1 = acc[ai][bj][m][1] * rs[ai][m];
                    if (rope) { const f32x4 cs = *(const f32x4*)(COS + row * 16 + 4 * fq), sn = *(const f32x4*)(SIN + row * 16 + 4 * fq);
                        const f32x4 o1 = v0 * cs - v1 * sn, o2 = v1 * cs + v0 * sn; v0 = o1; v1 = o2; }
                    bf16_t* rp = QM + row * 768 + gcol + 4 * fq; *(u32x2*)(rp) = pk4(v0); *(u32x2*)(rp + 16) = pk4(v1); if (m & 1) asm volatile("" ::: "memory"); }
        }
    }
};
struct EpiKV {
    static constexpr bool PERM = false, AFTER_DRAIN = false;
    unsigned char* ws;
    __device__ __forceinline__ void operator()(const f32x4 (&acc)[2][2][4][2], const Unit& u, int wr, int wc, int fr, int fq) const {
        const int row0 = u.pm * 256 + wr * 64 + fr;
        const float* SSQ = (const float*)(ws + WS_SSQK); bf16_t* KM = (bf16_t*)(ws + WS_KM);
        float rs[2][4];
#pragma unroll
        for (int ai = 0; ai < 2; ++ai)
#pragma unroll
            for (int m = 0; m < 4; ++m) { const f32x4 s = *(const f32x4*)(SSQ + (size_t)(row0 + ai * 128 + m * 16) * 4); rs[ai][m] = rsqrtf(((s[0] + s[1]) + (s[2] + s[3])) * (1.f / 128.f) + EPS_); }
#pragma unroll
        for (int bj = 0; bj < 2; ++bj) {
            const int gcol = u.pn * 256 + bj * 128 + wc * 32; const int head = gcol >> 7, within = gcol & 127;
            bf16_t* base = KM + (within < 64 ? (size_t)0 : (size_t)((WS_VM - WS_KM) / 2)); const int c0 = head * 64 + (within & 63) + 4 * fq;
#pragma unroll
            for (int ai = 0; ai < 2; ++ai)
#pragma unroll
                for (int m = 0; m < 4; ++m) { bf16_t* rp = base + (size_t)(row0 + ai * 128 + m * 16) * 512 + c0;
#pragma unroll
                    for (int n = 0; n < 2; ++n) *(u32x2*)(rp + 16 * n) = pk4(acc[ai][bj][m][n] * rs[ai][m]); }
        }
    }
};
struct EpiOut {
    static constexpr bool PERM = false, AFTER_DRAIN = false;
    const float* XIN; float* XOUT; const float* MODG;
    __device__ __forceinline__ void operator()(const f32x4 (&acc)[2][2][4][2], const Unit& u, int wr, int wc, int fr, int fq) const {
        const int row0 = u.pm * 256 + wr * 64 + fr; const int b = (u.pm * 256) >> 12;
#pragma unroll
        for (int bj = 0; bj < 2; ++bj) {
            const int col = u.pn * 256 + bj * 128 + wc * 32 + 4 * fq;
            const f32x4 g0 = *(const f32x4*)(MODG + (size_t)b * 3072 + col), g1 = *(const f32x4*)(MODG + (size_t)b * 3072 + col + 16);
            f32x4 xi[2][4][2];
#pragma unroll
            for (int ai = 0; ai < 2; ++ai)
#pragma unroll
                for (int m = 0; m < 4; ++m) { const size_t off = (size_t)(row0 + ai * 128 + m * 16) * 1024 + col; xi[ai][m][0] = *(const f32x4*)(XIN + off); xi[ai][m][1] = *(const f32x4*)(XIN + off + 16); }
#pragma unroll
            for (int ai = 0; ai < 2; ++ai)
#pragma unroll
                for (int m = 0; m < 4; ++m) { const size_t off = (size_t)(row0 + ai * 128 + m * 16) * 1024 + col;
                    *(f32x4*)(XOUT + off) = xi[ai][m][0] + g0 * acc[ai][bj][m][0]; *(f32x4*)(XOUT + off + 16) = xi[ai][m][1] + g1 * acc[ai][bj][m][1]; }
            asm volatile("" ::: "memory");
        }
    }
};

__device__ __forceinline__ int crow(int r, int hi) { return (r & 3) + 8 * (r >> 2) + 4 * hi; }
__device__ __forceinline__ bf16x8 vtr2(const LAS unsigned char* p) {
    const v4i16_t lo = __builtin_amdgcn_ds_read_tr16_b64_v4i16((LAS v4i16_t*)p), hi = __builtin_amdgcn_ds_read_tr16_b64_v4i16((LAS v4i16_t*)(p + 512));
    return (bf16x8){lo[0], lo[1], lo[2], lo[3], hi[0], hi[1], hi[2], hi[3]};
}
constexpr int AT_KBUF = 13312, AT_OFF_V = 2 * AT_KBUF, AT_OFF_CK = AT_OFF_V + 2 * 8192, AT_OFF_WS = AT_OFF_CK + 512;

template <bool MLA>
__device__ __forceinline__ void attn_unit(LAS unsigned char* lds, int b, int h, int qb, unsigned char* ws, int wave_s) {
    constexpr int DQK = MLA ? 96 : 64, NDS = DQK / 16, KROW = MLA ? 208 : 144, QP = MLA ? 768 : 512;
    const bf16_t* Q = (const bf16_t*)(ws + (MLA ? WS_QM : WS_QF)); const bf16_t* K = (const bf16_t*)(ws + (MLA ? WS_KM : WS_KF)); const bf16_t* V = (const bf16_t*)(ws + (MLA ? WS_VM : WS_VF));
    const bf16_t* KRp = (const bf16_t*)(ws + WS_KR); const float* CUM = (const float*)(ws + WS_CUM); const bf16_t* GATE = (const bf16_t*)(ws + WS_GATE); bf16_t* Y = (bf16_t*)(ws + WS_H);
    const int tid = otid(wave_s), lane = tid & 63, r32 = lane & 31, hi = lane >> 5; const int wid = __builtin_amdgcn_readfirstlane(tid >> 6);
    const int par = 0;
    const int q0 = qb * 256, qw0 = q0 + wid * 32; const size_t rowbase = (size_t)b * SEQ;
    const int NT = q0 / 64 + 4;
    int t0 = 0;
    if (!MLA) {
        LAS int* tb = (LAS int*)(lds + AT_OFF_WS);
        if (wid == 0) {
            const unsigned* SB = (const unsigned*)(ws + WS_SB) + (size_t)(b * 8 + h) * 2;
            const float sb = sqrtf(__builtin_bit_cast(float, SB[0])) * sqrtf(__builtin_bit_cast(float, SB[1])) * 1.02f + 1.0f;
            const float* cb_ = CUM + (size_t)(b * 8 + h) * SEQ; const float c0 = cb_[q0];
            float Bd = -1e30f; if (lane < NT) Bd = 2.f * sb + c0 - cb_[64 * lane + 63];
            const unsigned long long mk = __ballot(Bd >= -160.f);
            int tmin = mk ? (int)__builtin_ctzll(mk) : 0;
            tmin &= ~1; if (tmin > NT - 4) tmin = NT - 4;
            if (lane == 0) *tb = tmin;
        }
        __syncthreads();
        t0 = __builtin_amdgcn_readfirstlane(*tb);
    }
    bf16x8 qr[NDS];
    { const bf16_t* qp = Q + (rowbase + qw0 + r32) * QP + h * DQK + hi * 8;
#pragma unroll
      for (int ds = 0; ds < NDS; ++ds) qr[ds] = *(const bf16x8*)(qp + ds * 16); }
    const int krow = tid >> 3, kch = tid & 7;
    const bf16_t* kgu = K + rowbase * 512 + h * 64; const unsigned koff = (unsigned)(krow * 512 + kch * 8); const int kdst = krow * KROW + kch * 16;
    const bf16_t* krgu = KRp + rowbase * 32; const unsigned kroff = (unsigned)((tid >> 2) * 32 + (tid & 3) * 8); const int krdst = (tid >> 2) * KROW + 128 + (tid & 3) * 16;
    const int vdh = tid >> 8, vrow = (tid >> 2) & 63, vc4 = tid & 3;
    const bf16_t* vgu = V + rowbase * 512 + h * 64; const unsigned voff = (unsigned)(vrow * 512 + vdh * 32 + vc4 * 8); const int vdst = AT_OFF_V + vdh * 4096 + vrow * 64 + vc4 * 16;
    const float* ckgu = CUM + (size_t)(b * 8 + h) * SEQ; const unsigned ckoff = (unsigned)(tid & 63);
    u32x4 kreg, krreg = (u32x4){0u, 0u, 0u, 0u}, vreg; float ckreg = 0.f;
#define AT_LOADK(t) do { kreg = *(const u32x4*)(kgu + (size_t)(t) * 64 * 512 + koff); \
        if (MLA) { if (tid < 256) krreg = *(const u32x4*)(krgu + (size_t)(t) * 64 * 32 + kroff); } else { if (tid < 64) ckreg = -ckgu[(size_t)(t) * 64 + ckoff]; } } while (0)
#define AT_STOREK(bf) do { *(LAS u32x4*)(lds + (bf) * AT_KBUF + kdst) = kreg; \
        if (MLA) { if (tid < 256) *(LAS u32x4*)(lds + (bf) * AT_KBUF + krdst) = krreg; } else { if (tid < 64) *(LAS float*)(lds + AT_OFF_CK + (bf) * 256 + tid * 4) = ckreg; } } while (0)
#define AT_LOADV(t) do { vreg = *(const u32x4*)(vgu + (size_t)(t) * 64 * 512 + voff); } while (0)
#define AT_STOREV(bf) do { *(LAS u32x4*)(lds + (bf) * 8192 + vdst) = vreg; } while (0)
    float mhat = -1e30f, lsum = 0.f; f32x16 o0 = {}, o1 = {};
    const int vb = AT_OFF_V + ((lane >> 4) & 1) * 32 + (lane & 3) * 8 + (4 * hi + ((lane & 15) >> 2)) * 64;
#define AT_QK(P0, P1, t_, MASKOK) do { const int bf_ = (t_) & 1; \
        if (!MLA) { _Pragma("unroll") for (int g = 0; g < 4; ++g) { const f32x4 c0 = *(const LAS f32x4*)(lds + AT_OFF_CK + bf_ * 256 + (8 * g + 4 * hi) * 4), c1 = *(const LAS f32x4*)(lds + AT_OFF_CK + bf_ * 256 + (32 + 8 * g + 4 * hi) * 4); \
                _Pragma("unroll") for (int e = 0; e < 4; ++e) { P0[4 * g + e] = c0[e]; P1[4 * g + e] = c1[e]; } } } \
        else { P0 = (f32x16){}; P1 = (f32x16){}; } \
        const LAS unsigned char* kb_ = lds + bf_ * AT_KBUF + r32 * KROW + hi * 16; \
        _Pragma("unroll") for (int ds = 0; ds < NDS; ++ds) { \
            const bf16x8 kf0 = *(const LAS bf16x8*)(kb_ + ds * 32), kf1 = *(const LAS bf16x8*)(kb_ + 32 * KROW + ds * 32); \
            P0 = __builtin_amdgcn_mfma_f32_32x32x16_bf16(kf0, qr[ds], P0, 0, 0, 0); \
            P1 = __builtin_amdgcn_mfma_f32_32x32x16_bf16(kf1, qr[ds], P1, 0, 0, 0); } \
        if (MASKOK && !MLA && (t_) * 64 + 63 > qw0) { const int q_ = qw0 + r32; \
            _Pragma("unroll") for (int r = 0; r < 16; ++r) { const int kv = (t_) * 64 + crow(r, hi); if (kv > q_) P0[r] = -INFINITY; if (kv + 32 > q_) P1[r] = -INFINITY; } } } while (0)
#define AT_QKF(P0, P1, t_, MASKOK) do { const int bf_ = (t_) & 1; \
        if (!MLA) { _Pragma("unroll") for (int g = 0; g < 4; ++g) { const f32x4 c0 = *(const LAS f32x4*)(lds + AT_OFF_CK + bf_ * 256 + (8 * g + 4 * hi) * 4), c1 = *(const LAS f32x4*)(lds + AT_OFF_CK + bf_ * 256 + (32 + 8 * g + 4 * hi) * 4); \
                _Pragma("unroll") for (int e = 0; e < 4; ++e) { P0[4 * g + e] = c0[e]; P1[4 * g + e] = c1[e]; } } } \
        else { P0 = (f32x16){}; P1 = (f32x16){}; } \
        const LAS unsigned char* kb_ = lds + bf_ * AT_KBUF + r32 * KROW + hi * 16; \
        _Pragma("unroll") for (int hb = 0; hb < 2; ++hb) { bf16x8 kf_[NDS]; \
            _Pragma("unroll") for (int d2 = 0; d2 < NDS / 2; ++d2) { const int ds = hb * (NDS / 2) + d2; kf_[2 * d2] = *(const LAS bf16x8*)(kb_ + ds * 32); kf_[2 * d2 + 1] = *(const LAS bf16x8*)(kb_ + 32 * KROW + ds * 32); } \
            __builtin_amdgcn_sched_barrier(0); \
            _Pragma("unroll") for (int d2 = 0; d2 < NDS / 2; ++d2) { const int ds = hb * (NDS / 2) + d2; \
                P0 = __builtin_amdgcn_mfma_f32_32x32x16_bf16(kf_[2 * d2], qr[ds], P0, 0, 0, 0); \
                P1 = __builtin_amdgcn_mfma_f32_32x32x16_bf16(kf_[2 * d2 + 1], qr[ds], P1, 0, 0, 0); } } \
        if (MASKOK && !MLA && (t_) * 64 + 63 > qw0) { const int q_ = qw0 + r32; \
            _Pragma("unroll") for (int r = 0; r < 16; ++r) { const int kv = (t_) * 64 + crow(r, hi); if (kv > q_) P0[r] = -INFINITY; if (kv + 32 > q_) P1[r] = -INFINITY; } } } while (0)
#define AT_SMPV(P0, P1, t_) do { const int bf_ = (t_) & 1; \
        float ra = fmaxf(fmaxf(P0[0], P0[1]), P1[0]), rb = fmaxf(fmaxf(P0[2], P0[3]), P1[1]); ra = fmaxf(fmaxf(ra, P1[2]), P1[3]); \
        _Pragma("unroll") for (int r = 4; r < 16; r += 4) { ra = fmaxf(fmaxf(ra, P0[r]), P0[r + 1]); rb = fmaxf(fmaxf(rb, P0[r + 2]), P0[r + 3]); ra = fmaxf(fmaxf(ra, P1[r]), P1[r + 1]); rb = fmaxf(fmaxf(rb, P1[r + 2]), P1[r + 3]); } \
        float rm = fmaxf(ra, rb); { auto rr = __builtin_amdgcn_permlane32_swap(__float_as_uint(rm), __float_as_uint(rm), false, false); rm = fmaxf(__uint_as_float(rr[0]), __uint_as_float(rr[1])); } \
        if (__any(rm > mhat + 16.f)) { \
            const float mnew = fmaxf(mhat, rm), alpha = __builtin_amdgcn_exp2f(mhat - mnew); \
            lsum *= alpha; mhat = mnew; \
            _Pragma("unroll") for (int r = 0; r < 16; ++r) { o0[r] *= alpha; o1[r] *= alpha; } } \
        float sacc = 0.f; \
        _Pragma("unroll") for (int r = 0; r < 16; ++r) { P0[r] = __builtin_amdgcn_exp2f(P0[r] - mhat); P1[r] = __builtin_amdgcn_exp2f(P1[r] - mhat); sacc += P0[r] + P1[r]; } \
        lsum += sacc; \
        u32x4 pw[4]; \
        _Pragma("unroll") for (int s = 0; s < 2; ++s) { \
            pw[s]     = (u32x4){cvtpk_s(P0[8 * s], P0[8 * s + 1]), cvtpk_s(P0[8 * s + 2], P0[8 * s + 3]), cvtpk_s(P0[8 * s + 4], P0[8 * s + 5]), cvtpk_s(P0[8 * s + 6], P0[8 * s + 7])}; \
            pw[2 + s] = (u32x4){cvtpk_s(P1[8 * s], P1[8 * s + 1]), cvtpk_s(P1[8 * s + 2], P1[8 * s + 3]), cvtpk_s(P1[8 * s + 4], P1[8 * s + 5]), cvtpk_s(P1[8 * s + 6], P1[8 * s + 7])}; } \
        const LAS unsigned char* vp_ = lds + vb + bf_ * 8192; \
        _Pragma("unroll") for (int s = 0; s < 4; ++s) { \
            const bf16x8 pa = __builtin_bit_cast(bf16x8, pw[s]); \
            const bf16x8 v0 = vtr2(vp_ + s * 1024), v1 = vtr2(vp_ + 4096 + s * 1024); \
            o0 = __builtin_amdgcn_mfma_f32_32x32x16_bf16(v0, pa, o0, 0, 0, 0); \
            o1 = __builtin_amdgcn_mfma_f32_32x32x16_bf16(v1, pa, o1, 0, 0, 0); } } while (0)
#define AT_STEP(PAR, C0, C1, N0, N1, t_) do { \
        if ((t_) + 2 < NT) AT_LOADK((t_) + 2); if ((t_) + 1 < NT) AT_LOADV((t_) + 1); \
        const bool actN_ = ((t_) + 1 < NT) && (((t_) + 1) * 64 <= qw0), actC_ = ((t_) * 64 <= qw0); \
        __builtin_amdgcn_sched_barrier(0); \
        if (PAR == 0) { if (actN_) AT_QK(N0, N1, (t_) + 1, true); if (actC_) AT_SMPV(C0, C1, t_); } \
        else          { if (actC_) AT_SMPV(C0, C1, t_); if (actN_) AT_QK(N0, N1, (t_) + 1, true); } \
        __builtin_amdgcn_sched_barrier(0); \
        if ((t_) + 2 < NT) AT_STOREK((t_) & 1); if ((t_) + 1 < NT) AT_STOREV(((t_) + 1) & 1); \
        __syncthreads(); } while (0)
#define AT_STEADY(PAR, C0, C1, N0, N1, t_) do { \
        AT_LOADK((t_) + 2); AT_LOADV((t_) + 1); \
        __builtin_amdgcn_sched_barrier(0); \
        if (PAR == 0) { AT_QKF(N0, N1, (t_) + 1, false); AT_SMPV(C0, C1, t_); } \
        else          { AT_SMPV(C0, C1, t_); AT_QK(N0, N1, (t_) + 1, false); \
            _Pragma("unroll") for (int i_ = 0; i_ < 2 * NDS; ++i_) { __builtin_amdgcn_sched_group_barrier(0x002, 12, 0); __builtin_amdgcn_sched_group_barrier(0x008, 1, 0); } } \
        __builtin_amdgcn_sched_barrier(0); \
        AT_STOREK((t_) & 1); AT_STOREV(((t_) + 1) & 1); \
        __syncthreads(); } while (0)
    f32x16 sa0, sa1, sb0, sb1;
    __syncthreads();
    AT_LOADK(t0); AT_LOADV(t0); AT_STOREK(0); AT_STOREV(0); AT_LOADK(t0 + 1); AT_STOREK(1);
    __syncthreads();
    AT_QK(sa0, sa1, t0, true);
    __syncthreads();
    int t = t0;
    if (par == 0) {
        for (; t + 6 < NT; t += 2) { AT_STEADY(0, sa0, sa1, sb0, sb1, t); AT_STEADY(0, sb0, sb1, sa0, sa1, t + 1); }
        for (; t < NT; t += 2) { AT_STEP(0, sa0, sa1, sb0, sb1, t); AT_STEP(0, sb0, sb1, sa0, sa1, t + 1); }
    } else {
        for (; t + 6 < NT; t += 2) { AT_STEADY(1, sa0, sa1, sb0, sb1, t); AT_STEADY(1, sb0, sb1, sa0, sa1, t + 1); }
        for (; t < NT; t += 2) { AT_STEP(1, sa0, sa1, sb0, sb1, t); AT_STEP(1, sb0, sb1, sa0, sa1, t + 1); }
    }
#undef AT_LOADK
#undef AT_STOREK
#undef AT_LOADV
#undef AT_STOREV
#undef AT_QK
#undef AT_QKF
#undef AT_SMPV
#undef AT_STEP
#undef AT_STEADY
    float lt; { auto rr = __builtin_amdgcn_permlane32_swap(__float_as_uint(lsum), __float_as_uint(lsum), false, false); lt = __uint_as_float(rr[0]) + __uint_as_float(rr[1]); }
    const float rl = __builtin_amdgcn_rcpf(lt);
    const size_t ob = (rowbase + qw0 + r32) * 1024 + (MLA ? 512 : 0) + h * 64 + 4 * hi;
#pragma unroll
    for (int g = 0; g < 4; ++g) {
        const u32x2 ga = *(const u32x2*)(GATE + ob + 8 * g), gb = *(const u32x2*)(GATE + ob + 32 + 8 * g);
        f32x4 a = (f32x4){o0[4 * g], o0[4 * g + 1], o0[4 * g + 2], o0[4 * g + 3]} * rl, c = (f32x4){o1[4 * g], o1[4 * g + 1], o1[4 * g + 2], o1[4 * g + 3]} * rl;
        a = a * (f32x4){__builtin_bit_cast(float, ga.x << 16), __builtin_bit_cast(float, ga.x & 0xffff0000u), __builtin_bit_cast(float, ga.y << 16), __builtin_bit_cast(float, ga.y & 0xffff0000u)};
        c = c * (f32x4){__builtin_bit_cast(float, gb.x << 16), __builtin_bit_cast(float, gb.x & 0xffff0000u), __builtin_bit_cast(float, gb.y << 16), __builtin_bit_cast(float, gb.y & 0xffff0000u)};
        *(u32x2*)(Y + ob + 8 * g) = pk4(a); *(u32x2*)(Y + ob + 32 + 8 * g) = pk4(c);
    }
}

template <int MODE>
__device__ __forceinline__ void transpose_item(const float* __restrict__ W, int K, int Nsrc, int Ndst, bf16_t* __restrict__ WT, const float* __restrict__ kscale, LAS float* scr, int item, int lane) {
    const int nblk = Ndst / 32, kb = item / nblk, nb = item % nblk, k0 = 64 * kb, n0 = 32 * nb;
    const int nd = n0 + (lane & 31); int ns = nd; bool valid = true;
    if (MODE == 1) { if (nd < 1536) ns = nd; else if (nd < 2976) ns = nd + 8; else if (nd < 2984) ns = nd - 1440; else { ns = 0; valid = false; } }
#pragma unroll 32
    for (int i = 0; i < 32; ++i) { const int kk = 2 * i + (lane >> 5); float v = valid ? W[(size_t)(k0 + kk) * Nsrc + ns] : 0.f; if (kscale) v *= kscale[k0 + kk]; scr[kk * 33 + (lane & 31)] = v; }
    LDS_WAIT();
    const int c = lane & 7;
#pragma unroll
    for (int j = 0; j < 4; ++j) { const int n = (lane >> 3) + 8 * j; const LAS float* s = scr + (8 * c) * 33 + n;
        u32x4 o; o.x = pk2(s[0 * 33], s[1 * 33]); o.y = pk2(s[2 * 33], s[3 * 33]); o.z = pk2(s[4 * 33], s[5 * 33]); o.w = pk2(s[6 * 33], s[7 * 33]);
        *(u32x4*)(WT + (size_t)(n0 + n) * K + k0 + 8 * c) = o; }
    LDS_WAIT();
}

struct Args { const void* in[14]; float* out; unsigned char* ws; };

__global__ void __launch_bounds__(512) mk_fwd(Args args) {
    extern __shared__ __attribute__((aligned(16))) unsigned char smem[];
    LAS unsigned char* lds = (LAS unsigned char*)smem;
    cg::grid_group grid = cg::this_grid();
    const int wave_s = __builtin_amdgcn_readfirstlane((int)threadIdx.x >> 6);
    const int G = gridDim.x, bx = blockIdx.x, NGW = G * 8;
    unsigned char* ws = args.ws; float* X = args.out;
    float* MOD = (float*)(ws + WS_MOD);
    unsigned* bar = (unsigned*)ws;
    volatile LAS unsigned* bst = (volatile LAS unsigned*)(lds + 131072);
    { const int t0 = otid(wave_s); if (t0 < 2) bst[t0] = 0u; __syncthreads(); if (t0 == 0) (void)xb_add(&bar[XB_XCNT(xb_xcc_id())], 1u); }
#define GRID_BAR() xcd_barrier(bar, bst, otid(wave_s))

    {
        const int tid = otid(wave_s), lane = tid & 63; const int wave = __builtin_amdgcn_readfirstlane(tid >> 6); const int gw = bx * 8 + wave;
        const float* c_in = (const float*)args.in[1]; const int* pos_in = (const int*)args.in[2];
        const float* w_ada = (const float*)args.in[4]; const float* b_ada = (const float*)args.in[5];
        const float* w_in = (const float*)args.in[6]; const float* q_norm_g = (const float*)args.in[8];
        const float* w_uq = (const float*)args.in[9]; const float* kv_norm_g = (const float*)args.in[10]; const float* w_ukv = (const float*)args.in[11];
        const float* w_out = (const float*)args.in[12];
        bf16_t* WIN = (bf16_t*)(ws + WS_WIN); bf16_t* WOUT = (bf16_t*)(ws + WS_WOUT); bf16_t* WUQ = (bf16_t*)(ws + WS_WUQ); bf16_t* WUKV = (bf16_t*)(ws + WS_WUKV);
        float* COS = (float*)(ws + WS_COS); float* SIN = (float*)(ws + WS_SIN);
        for (int unit = bx; unit < DEPTH * 48; unit += G) {
            LAS float* cact = (LAS float*)lds; LAS float* red = (LAS float*)(lds + 32768);
            const int l = unit / 48, n = (unit % 48) * 64 + lane;
            for (int i = tid; i < NB * DM; i += 512) cact[i] = silu_f(c_in[i]);
            __syncthreads();
            float a[8];
#pragma unroll
            for (int b = 0; b < 8; ++b) a[b] = 0.f;
            const float* wp = w_ada + ((size_t)l * DM + 128 * wave) * 3072 + n;
#pragma unroll 16
            for (int kk = 0; kk < 128; ++kk) { const float wv = wp[(size_t)kk * 3072];
#pragma unroll
                for (int b = 0; b < 8; ++b) a[b] += cact[b * DM + 128 * wave + kk] * wv; }
#pragma unroll
            for (int b = 0; b < 8; ++b) red[(wave * 8 + b) * 64 + lane] = a[b];
            __syncthreads();
            { float s = b_ada[l * 3072 + n];
#pragma unroll
              for (int w2 = 0; w2 < 8; ++w2) s += red[(w2 * 8 + wave) * 64 + lane];
              MOD[(size_t)(l * 8 + wave) * 3072 + n] = s; }
            __syncthreads();
        }
        { LAS float* scr = (LAS float*)(lds + 49152) + wave * (64 * 33);
          constexpr int I_IN = 16 * 96, I_OUT = 16 * 32, I_UQ = 4 * 24, I_UKV = 2 * 32, I_L = I_IN + I_OUT + I_UQ + I_UKV;
          for (int it = gw; it < DEPTH * I_L; it += NGW) {
              const int l = it / I_L; int r = it % I_L;
              if (r < I_IN) { transpose_item<1>(w_in + (size_t)l * DM * NIN, DM, NIN, NINP, WIN + (size_t)l * NINP * DM, nullptr, scr, r, lane); continue; } r -= I_IN;
              if (r < I_OUT) { transpose_item<0>(w_out + (size_t)l * DM * DM, DM, DM, DM, WOUT + (size_t)l * DM * DM, nullptr, scr, r, lane); continue; } r -= I_OUT;
              if (r < I_UQ) { transpose_item<0>(w_uq + (size_t)l * 256 * 768, 256, 768, 768, WUQ + (size_t)l * 768 * 256, q_norm_g + l * 256, scr, r, lane); continue; } r -= I_UQ;
              transpose_item<0>(w_ukv + (size_t)l * 128 * 1024, 128, 1024, 1024, WUKV + (size_t)l * 1024 * 128, kv_norm_g + l * 128, scr, r, lane);
          } }
        for (int idx = bx * 512 + tid; idx < MTOK * 16; idx += G * 512) {
            const int tok = idx >> 4, i = idx & 15;
            const float inv = 1.0f / powf(10000.0f, (float)(2 * i) * (1.0f / 32.0f));
            const float ang = (float)pos_in[tok] * inv; float sn, cs; sincosf(ang, &sn, &cs);
            COS[idx] = cs; SIN[idx] = sn;
        }
    }

    grid.sync();
    for (int l = 0; l <= DEPTH; ++l) {
        if (l > 0) GRID_BAR();
        {
            const int tid = otid(wave_s), lane = tid & 63; const int wave = __builtin_amdgcn_readfirstlane(tid >> 6); const int gw = bx * 8 + wave;
            const bool fin = (l == DEPTH);
            const float* xs = (l == 0) ? (const float*)args.in[0] : X; const float* gsrc = fin ? (const float*)args.in[13] : (const float*)args.in[3] + l * DM;
            bf16_t* H = (bf16_t*)(ws + WS_H);
            for (int r0 = gw * 16; r0 < MTOK; r0 += NGW * 16) {
                const int b = r0 >> 12;
                f32x4 gs[4], sh[4];
#pragma unroll
                for (int j = 0; j < 4; ++j) { const int col = 4 * lane + 256 * j; const f32x4 g = *(const f32x4*)(gsrc + col);
                    if (fin) { gs[j] = g; sh[j] = (f32x4){0.f, 0.f, 0.f, 0.f}; }
                    else { const f32x4 sc = *(const f32x4*)(MOD + (size_t)(l * 8 + b) * 3072 + 1024 + col); gs[j] = g * (sc + 1.0f); sh[j] = *(const f32x4*)(MOD + (size_t)(l * 8 + b) * 3072 + col); } }
                for (int rr = 0; rr < 16; ++rr) {
                    const size_t row = (size_t)(r0 + rr);
                    f32x4 v[4]; float ss = 0.f;
#pragma unroll
                    for (int j = 0; j < 4; ++j) { v[j] = *(const f32x4*)(xs + row * DM + 4 * lane + 256 * j); ss += (v[j][0] * v[j][0] + v[j][1] * v[j][1]) + (v[j][2] * v[j][2] + v[j][3] * v[j][3]); }
                    const float rstd = rsqrtf(wave_sum(ss, lane) * (1.f / DM) + EPS_);
                    if (fin) {
#pragma unroll
                        for (int j = 0; j < 4; ++j) *(f32x4*)(X + row * DM + 4 * lane + 256 * j) = v[j] * rstd * gs[j];
                    } else {
#pragma unroll
                        for (int j = 0; j < 4; ++j) *(u32x2*)(H + row * DM + 4 * lane + 256 * j) = pk4(v[j] * rstd * gs[j] + sh[j]);
                    }
                }
            }
        }
        if (l == DEPTH) break;
        GRID_BAR();
        {
            if (bx == 0) { const int t_ = otid(wave_s); if (t_ < 128) ((unsigned*)(ws + WS_SB))[t_] = 0u; }
            pg8::Gemm g{(const bf16_t*)(ws + WS_H), (const bf16_t*)(ws + WS_WIN) + (size_t)l * NINP * DM, MTOK, NINP, DM}; pg8::StaticOrder S; S.init(MTOK, NINP, G, bx);
            EpiIn E{ws, (const float*)args.in[7] + l * 8};
            pg8::gemm_phase<EpiIn, pg8::StaticOrder, true, true>(lds, g, S, E, wave_s);
        }
        GRID_BAR();
        {
            const int tid = otid(wave_s), lane = tid & 63; const int wave = __builtin_amdgcn_readfirstlane(tid >> 6);
            const float* LOGF = (const float*)(ws + WS_LOGF); float* CUM = (float*)(ws + WS_CUM);
            for (int u = bx; u < 256; u += G) {
                const int bh = u >> 2, qt = u & 3; LAS float* red = (LAS float*)lds;
                const size_t r0 = (size_t)(bh >> 3) * SEQ + qt * 1024 + 2 * tid;
                float qm = 0.f, km = 0.f;
#pragma unroll
                for (int r = 0; r < 2; ++r) {
                    const bf16_t* qp = (const bf16_t*)(ws + WS_QF) + (r0 + r) * 512 + (bh & 7) * 64; const bf16_t* kp = (const bf16_t*)(ws + WS_KF) + (r0 + r) * 512 + (bh & 7) * 64;
                    float qs = 0.f, ks = 0.f;
#pragma unroll
                    for (int c = 0; c < 8; ++c) { const u32x4 a = *(const u32x4*)(qp + 8 * c), k4 = *(const u32x4*)(kp + 8 * c);
#pragma unroll
                        for (int e = 0; e < 4; ++e) { const float a0 = __builtin_bit_cast(float, a[e] << 16), a1 = __builtin_bit_cast(float, a[e] & 0xffff0000u), b0 = __builtin_bit_cast(float, k4[e] << 16), b1 = __builtin_bit_cast(float, k4[e] & 0xffff0000u);
                            qs += a0 * a0 + a1 * a1; ks += b0 * b0 + b1 * b1; } }
                    qm = fmaxf(qm, qs); km = fmaxf(km, ks);
                }
#pragma unroll
                for (int o = 1; o < 64; o <<= 1) { qm = fmaxf(qm, shx(qm, o, lane)); km = fmaxf(km, shx(km, o, lane)); }
                if (lane == 0) { red[2 * wave] = qm; red[2 * wave + 1] = km; }
                __syncthreads();
                if (tid == 0) { float a = 0.f, c = 0.f;
                    for (int w2 = 0; w2 < 8; ++w2) { a = fmaxf(a, red[2 * w2]); c = fmaxf(c, red[2 * w2 + 1]); }
                    unsigned* SB = (unsigned*)(ws + WS_SB) + (size_t)bh * 2;
                    __hip_atomic_fetch_max(SB, __builtin_bit_cast(unsigned, a), __ATOMIC_RELAXED, __HIP_MEMORY_SCOPE_AGENT); __hip_atomic_fetch_max(SB + 1, __builtin_bit_cast(unsigned, c), __ATOMIC_RELAXED, __HIP_MEMORY_SCOPE_AGENT); }
                __syncthreads();
            }
            for (int u = bx; u < 64; u += G) {
                LAS float* wsum = (LAS float*)lds;
                const float* lf = LOGF + (size_t)(u >> 3) * SEQ * 8 + (u & 7);
                float v[8]; float s = 0.f;
#pragma unroll
                for (int i = 0; i < 8; ++i) { s += lf[(size_t)(8 * tid + i) * 8]; v[i] = s; }
                float incl = s;
#pragma unroll
                for (int off = 1; off < 64; off <<= 1) { const float t = shup(incl, off, lane); if (lane >= off) incl += t; }
                if (lane == 63) wsum[wave] = incl;
                __syncthreads();
                float base = 0.f;
                for (int w2 = 0; w2 < wave; ++w2) base += wsum[w2];
                const float excl = base + incl - s;
#pragma unroll
                for (int i = 0; i < 8; ++i) CUM[(size_t)u * SEQ + 8 * tid + i] = (excl + v[i]) * LOG2E;
                __syncthreads();
            }
        }
        { pg8::Gemm g{(const bf16_t*)(ws + WS_QLAT), (const bf16_t*)(ws + WS_WUQ) + (size_t)l * 768 * 256, MTOK, 768, 256}; pg8::StaticOrder S; S.init(MTOK, 768, G, bx);
          EpiQ E{ws};
          pg8::gemm_phase<EpiQ, pg8::StaticOrder, true, true>(lds, g, S, E, wave_s); }
        __syncthreads();
        { pg8::Gemm g{(const bf16_t*)(ws + WS_KVLAT), (const bf16_t*)(ws + WS_WUKV) + (size_t)l * 1024 * 128, MTOK, 1024, 128}; pg8::StaticOrder S; S.init(MTOK, 1024, G, bx);
          EpiKV E{ws};
          pg8::gemm_phase<EpiKV, pg8::StaticOrder, true, true>(lds, g, S, E, wave_s); }
        GRID_BAR();
        {
            unsigned* ctr = bar + CTR_WORD + 64 * l;
            LAS int* ub = (LAS int*)(lds + 131072 + 64);
            for (;;) {
                const int tq = otid(wave_s);
                __syncthreads();
                if (tq == 0) *ub = (int)__hip_atomic_fetch_add(ctr, 1u, __ATOMIC_RELAXED, __HIP_MEMORY_SCOPE_AGENT);
                __syncthreads();
                const int u = __builtin_amdgcn_readfirstlane(*ub);
                if (u >= 2048) break;
                const int r = u & 1023, qb = 15 - (r >> 6), bh = r & 63;
                if (u < 1024) attn_unit<true>(lds, bh >> 3, bh & 7, qb, ws, wave_s);
                else attn_unit<false>(lds, bh >> 3, bh & 7, qb, ws, wave_s);
            }
        }
        GRID_BAR();
        {
            pg8::Gemm g{(const bf16_t*)(ws + WS_H), (const bf16_t*)(ws + WS_WOUT) + (size_t)l * DM * DM, MTOK, DM, DM}; pg8::StaticOrder S; S.init(MTOK, DM, G, bx);
            EpiOut E{l == 0 ? (const float*)args.in[0] : X, X, MOD + (size_t)l * 8 * 3072 + 2048};
            pg8::gemm_phase<EpiOut, pg8::StaticOrder, true, true>(lds, g, S, E, wave_s);
        }
    }
}

extern "C" void kernel_launch(void* const* d_in, const int* in_sizes, int n_in, void* d_out, int out_size, void* d_ws, size_t ws_size, hipStream_t stream) {
    static int grid = 0;
    if (grid == 0) {
        if (n_in != 14 || out_size != MTOK * DM || ws_size < WS_END) { fprintf(stderr, "kernel_launch: unexpected shapes (n_in %d, out %d, ws %zu)\n", n_in, out_size, ws_size); grid = -1; return; }
        int dev = 0, cus = 0, per_cu = 0;
        (void)hipGetDevice(&dev); (void)hipDeviceGetAttribute(&cus, hipDeviceAttributeMultiprocessorCount, dev);
        (void)hipFuncSetAttribute((const void*)mk_fwd, hipFuncAttributeMaxDynamicSharedMemorySize, LDS_BYTES);
        if (hipOccupancyMaxActiveBlocksPerMultiprocessor(&per_cu, (const void*)mk_fwd, 512, LDS_BYTES) != hipSuccess || per_cu < 1) per_cu = 1;
        (void)hipGetLastError();
        grid = cus * per_cu;
    }
    if (grid < 0) return;
    (void)hipMemsetAsync(d_ws, 0, 16384, stream);
    Args a{};
    for (int i = 0; i < 14; ++i) a.in[i] = d_in[i];
    a.out = (float*)d_out; a.ws = (unsigned char*)d_ws;
    void* kargs[] = {&a};
    hipError_t e = hipLaunchCooperativeKernel((const void*)mk_fwd, dim3(grid), dim3(512), kargs, LDS_BYTES, stream);
    if (e != hipSuccess) fprintf(stderr, "cooperative launch failed: %s (grid %d)\n", hipGetErrorString(e), grid);
}
```

```cpp
#include <hip/hip_runtime.h>
#include <hip/hip_cooperative_groups.h>
#include <cstdio>
#include <cstdint>
#include <cmath>
namespace cg = cooperative_groups;
__device__ __forceinline__ int otid(int wave_s) { int l; asm volatile("v_mbcnt_lo_u32_b32 %0, -1, 0\n\tv_mbcnt_hi_u32_b32 %0, -1, %0" : "=v"(l)); int w = wave_s; asm volatile("" : "+s"(w)); return (w << 6) | l; }
namespace pg8 {
#define PG8_LAS __attribute__((address_space(3)))
typedef unsigned short bf16_t;
typedef short bf16x8 __attribute__((ext_vector_type(8)));
typedef float f32x4 __attribute__((ext_vector_type(4)));
typedef unsigned u32x4 __attribute__((ext_vector_type(4)));
constexpr int BM = 256, BK = 64, HALF = 128, HTB = HALF * BK * 2  , STAGE_BYTES = 8 * HTB, NXCD = 8, WGM = 8;

__host__ __device__ __forceinline__ int lds_byte(int r, int c) { const int st = (r >> 4) * 2 + (c >> 5), rr = r & 15, cc = c & 31, ob = rr * 64 + cc * 2; return st * 1024 + (ob ^ (((ob >> 9) & 1) << 5)); }
__host__ __device__ __forceinline__ void stage_rc(int b, int& R, int& C) { const int st = b / 1024, sb = b % 1024, swz = sb ^ (((sb >> 9) & 1) << 5); R = (st >> 1) * 16 + swz / 64; C = (st & 1) * 32 + (swz % 64) / 2; }
__host__ __device__ __forceinline__ int perm32(int rho) { const int n = rho >> 4, i = rho & 15; return 8 * (i >> 2) + 4 * n + (i & 3); }

struct Unit { int pm, pn; };
struct Gemm { const bf16_t* A; const bf16_t* Bt; int M, N, K; };

struct StaticOrder {
    int nM, nN, nwg, G, c;
    __host__ __device__ void init(int M, int N, int G_, int c_) { nM = M / BM; nN = N / BM; nwg = nM * nN; G = G_; c = c_; }
    __host__ __device__ bool next(int i, Unit& u) const {
        const long L = (long)i * G + c; if (L >= nwg) return false;
        int wgid = (int)L; { const int q = nwg / NXCD, r = nwg % NXCD, xcd = wgid % NXCD, off = wgid / NXCD; wgid = (xcd < r ? xcd * (q + 1) : r * (q + 1) + (xcd - r) * q) + off; }
        const int nig = WGM * nN, gid = wgid / nig, fm = gid * WGM, gsz = (nM - fm) < WGM ? (nM - fm) : WGM;
        u.pm = fm + ((wgid % nig) % gsz); u.pn = (wgid % nig) / gsz; return true;
    }
    __device__ __forceinline__ void a_ready(const Unit&) const {}
    __device__ __forceinline__ void done(const Unit&) const {}
};

__device__ __forceinline__ unsigned cvt_pk_bf16(float lo, float hi) { unsigned r; asm volatile("v_cvt_pk_bf16_f32 %0, %1, %2" : "=v"(r) : "v"(lo), "v"(hi)); return r; }
template <class Epi, class Sched, bool ALIGN_EPI = false, bool SP2 = false>
__device__ __forceinline__ void gemm_phase(PG8_LAS unsigned char* lds, const Gemm g, const Sched& S, const Epi& E, int wave_s) {
    const int tid = otid(wave_s), wid = __builtin_amdgcn_readfirstlane(tid >> 6), lane = tid & 63, wr = wid >> 2, wc = wid & 3, fr = lane & 15, fq = lane >> 4;
    const int K = g.K, nt = K / BK;
    unsigned voffA[2], voffB[2];
#pragma unroll
    for (int i = 0; i < 2; ++i) { int R, C; stage_rc(tid * 16 + i * 8192, R, C); const int Rb = Epi::PERM ? ((R & ~31) + perm32(R & 31)) : R;
        voffA[i] = (unsigned)(R * K + C) * 2u; voffB[i] = (unsigned)(Rb * K + C) * 2u; }
    const size_t kstep = (size_t)(BK * 2);
    const size_t hstep = (size_t)HALF * K * 2;
    const size_t tstep = 2 * hstep;
    const unsigned ldsw = (unsigned)wid * 1024u;
    const int aoff = lds_byte(wr * 64 + fr, fq * 8), boff = lds_byte(wc * 32 + fr, fq * 8);
#define PG8_SA(b, h) (((b) * 2 + (h)) * HTB)
#define PG8_SB(b, h) ((4 + (b) * 2 + (h)) * HTB)
#define PG8_STAGE(bufoff, gbase, voff) do { _Pragma("unroll") for (int _i = 0; _i < 2; ++_i) \
        __builtin_amdgcn_global_load_lds((const unsigned*)((const char*)(gbase) + (voff)[_i]), (PG8_LAS unsigned*)(lds + (bufoff) + ldsw + _i * 8192), 16, 0, 0); } while (0)
#define PG8_LDA(dst, b, h) do { _Pragma("unroll") for (int m = 0; m < 4; ++m) _Pragma("unroll") for (int k = 0; k < 2; ++k) dst[m][k] = *(const PG8_LAS bf16x8*)(lds + PG8_SA(b, h) + aoff + m * 2048 + k * 1024); } while (0)
#define PG8_LDB(dst, b, h) do { _Pragma("unroll") for (int n = 0; n < 2; ++n) _Pragma("unroll") for (int k = 0; k < 2; ++k) dst[n][k] = *(const PG8_LAS bf16x8*)(lds + PG8_SB(b, h) + boff + n * 2048 + k * 1024); } while (0)
#define PG8_MMA(ai, bj, At, Bt) do { __builtin_amdgcn_s_setprio(1); _Pragma("unroll") for (int m = 0; m < 4; ++m) _Pragma("unroll") for (int n = 0; n < 2; ++n) _Pragma("unroll") for (int k = 0; k < 2; ++k) \
        acc[ai][bj][m][n] = __builtin_amdgcn_mfma_f32_16x16x32_bf16(Bt[n][k], At[m][k], acc[ai][bj][m][n], 0, 0, 0); __builtin_amdgcn_s_setprio(0); } while (0)
#define PG8_WAIT_V(n) asm volatile("s_waitcnt vmcnt(" #n ")" ::: "memory")
#define PG8_WAIT_L(n) asm volatile("s_waitcnt lgkmcnt(" #n ")" ::: "memory")
#define PG8_BAR __builtin_amdgcn_s_barrier()
#define PG8_SCHED __builtin_amdgcn_sched_barrier(0)
    Unit cur, nxt; int ui = 0;
    if (!S.next(0, cur)) return;
    f32x4 acc[2][2][4][2];
#pragma unroll
    for (int a = 0; a < 2; ++a)
#pragma unroll
        for (int b = 0; b < 2; ++b)
#pragma unroll
            for (int m = 0; m < 4; ++m)
#pragma unroll
                for (int n = 0; n < 2; ++n) acc[a][b][m][n] = (f32x4){0.f, 0.f, 0.f, 0.f};
    bf16x8 At[4][2], B0[2][2], B1[2][2];
    const char* cA = (const char*)g.A + (size_t)cur.pm * tstep; const char* cB = (const char*)g.Bt + (size_t)cur.pn * tstep;
    S.a_ready(cur);
    if constexpr (SP2) {
        PG8_STAGE(PG8_SB(0, 0), cB, voffB); PG8_STAGE(PG8_SB(0, 1), cB + hstep, voffB); PG8_STAGE(PG8_SA(0, 0), cA, voffA); PG8_STAGE(PG8_SA(0, 1), cA + hstep, voffA);
        if (wr == 1) PG8_BAR;
        PG8_WAIT_V(2); PG8_BAR;
        PG8_STAGE(PG8_SB(1, 0), cB + kstep, voffB); PG8_STAGE(PG8_SA(1, 0), cA + kstep, voffA); PG8_STAGE(PG8_SB(1, 1), cB + hstep + kstep, voffB);
        PG8_WAIT_V(6); PG8_BAR;
    } else {
        PG8_STAGE(PG8_SB(0, 0), cB, voffB); PG8_STAGE(PG8_SA(0, 0), cA, voffA); PG8_STAGE(PG8_SB(0, 1), cB + hstep, voffB); PG8_STAGE(PG8_SA(0, 1), cA + hstep, voffA);
        if (wr == 1) PG8_BAR;
        PG8_WAIT_V(4); PG8_BAR;
        PG8_STAGE(PG8_SB(1, 0), cB + kstep, voffB); PG8_STAGE(PG8_SA(1, 0), cA + kstep, voffA); PG8_STAGE(PG8_SB(1, 1), cB + hstep + kstep, voffB);
        PG8_WAIT_V(6); PG8_BAR;
    }
    for (;;) {
        const bool has_next = S.next(ui + 1, nxt);
        const char* nA = has_next ? (const char*)g.A + (size_t)nxt.pm * tstep : cA; const char* nB = has_next ? (const char*)g.Bt + (size_t)nxt.pn * tstep : cB;
        for (int t = 0; t < nt; t += 2) {
            const bool last = (t == nt - 2);
            const char* a1 = cA + (size_t)(t + 1) * kstep;
            const char* a2 = last ? nA : cA + (size_t)(t + 2) * kstep; const char* b2 = last ? nB : cB + (size_t)(t + 2) * kstep;
            const char* a3 = a2 + kstep; const char* b3 = b2 + kstep;
            if (last && has_next) S.a_ready(nxt);
            if constexpr (SP2) {
            PG8_LDB(B0, 0, 0); PG8_LDB(B1, 0, 1); PG8_SCHED; PG8_LDA(At, 0, 0); PG8_STAGE(PG8_SA(1, 1), a1 + hstep, voffA);
            PG8_WAIT_V(8); PG8_WAIT_L(0); PG8_BAR; PG8_MMA(0, 0, At, B0); PG8_MMA(0, 1, At, B1); PG8_BAR; PG8_SCHED;
            PG8_LDA(At, 0, 1); PG8_STAGE(PG8_SB(0, 0), b2, voffB); PG8_STAGE(PG8_SB(0, 1), b2 + hstep, voffB); PG8_STAGE(PG8_SA(0, 0), a2, voffA);
            PG8_WAIT_V(8); PG8_WAIT_L(0); PG8_BAR; PG8_MMA(1, 0, At, B0); PG8_MMA(1, 1, At, B1); PG8_BAR; PG8_SCHED;
            PG8_LDB(B0, 1, 0); PG8_LDB(B1, 1, 1); PG8_SCHED; PG8_LDA(At, 1, 0); PG8_STAGE(PG8_SA(0, 1), a2 + hstep, voffA);
            PG8_WAIT_V(8); PG8_WAIT_L(0); PG8_BAR; PG8_MMA(0, 0, At, B0); PG8_MMA(0, 1, At, B1); PG8_BAR; PG8_SCHED;
            PG8_LDA(At, 1, 1); PG8_STAGE(PG8_SB(1, 0), b3, voffB); PG8_STAGE(PG8_SB(1, 1), b3 + hstep, voffB); PG8_STAGE(PG8_SA(1, 0), a3, voffA);
            PG8_WAIT_V(8); PG8_WAIT_L(0); PG8_BAR; PG8_MMA(1, 0, At, B0); PG8_MMA(1, 1, At, B1); PG8_BAR; PG8_SCHED;
            } else {
            PG8_LDB(B0, 0, 0); PG8_SCHED; PG8_LDA(At, 0, 0); PG8_STAGE(PG8_SA(1, 1), a1 + hstep, voffA);
            PG8_WAIT_L(8); PG8_BAR; PG8_WAIT_L(0); PG8_MMA(0, 0, At, B0); PG8_BAR; PG8_SCHED;
            PG8_LDB(B1, 0, 1); PG8_STAGE(PG8_SB(0, 0), b2, voffB);
            PG8_BAR; PG8_WAIT_L(0); PG8_MMA(0, 1, At, B1); PG8_BAR;
            PG8_LDA(At, 0, 1); PG8_STAGE(PG8_SA(0, 0), a2, voffA);
            PG8_BAR; PG8_WAIT_L(0); PG8_MMA(1, 0, At, B0); PG8_BAR; PG8_SCHED;
            PG8_STAGE(PG8_SB(0, 1), b2 + hstep, voffB);
            PG8_WAIT_V(6); PG8_BAR; PG8_MMA(1, 1, At, B1); PG8_BAR;
            PG8_LDB(B0, 1, 0); PG8_SCHED; PG8_LDA(At, 1, 0); PG8_STAGE(PG8_SA(0, 1), a2 + hstep, voffA);
            PG8_WAIT_L(8); PG8_BAR; PG8_WAIT_L(0); PG8_MMA(0, 0, At, B0); PG8_BAR; PG8_SCHED;
            PG8_LDB(B1, 1, 1); PG8_STAGE(PG8_SB(1, 0), b3, voffB);
            PG8_BAR; PG8_WAIT_L(0); PG8_MMA(0, 1, At, B1); PG8_BAR;
            PG8_LDA(At, 1, 1); PG8_STAGE(PG8_SA(1, 0), a3, voffA);
            PG8_BAR; PG8_WAIT_L(0); PG8_MMA(1, 0, At, B0); PG8_BAR; PG8_SCHED;
            PG8_STAGE(PG8_SB(1, 1), b3 + hstep, voffB);
            PG8_WAIT_V(6); PG8_BAR; PG8_MMA(1, 1, At, B1); PG8_BAR;
            }
        }
        if constexpr (ALIGN_EPI) { if (wr == 0) PG8_BAR; }
        if constexpr (!Epi::AFTER_DRAIN) { int fr2 = fr, fq2 = fq; asm volatile("" : "+v"(fr2), "+v"(fq2)); E(acc, cur, wr, wc, fr2, fq2); S.done(cur); }
        if (!has_next) break;
#pragma unroll
        for (int a = 0; a < 2; ++a)
#pragma unroll
            for (int b = 0; b < 2; ++b)
#pragma unroll
                for (int m = 0; m < 4; ++m)
#pragma unroll
                    for (int n = 0; n < 2; ++n) acc[a][b][m][n] = (f32x4){0.f, 0.f, 0.f, 0.f};
        cur = nxt; cA = nA; cB = nB; ++ui;
        if constexpr (ALIGN_EPI) { if (wr == 1) PG8_BAR; }
    }
    PG8_WAIT_V(0);
    if constexpr (!ALIGN_EPI) { if (wr == 0) PG8_BAR; }
    PG8_BAR;
    if constexpr (Epi::AFTER_DRAIN) { E.fused(acc, cur, wr, wc, fr, fq, lds, wid, lane); S.done(cur); }
#undef PG8_SA
#undef PG8_SB
#undef PG8_STAGE
#undef PG8_LDA
#undef PG8_LDB
#undef PG8_MMA
#undef PG8_WAIT_V
#undef PG8_WAIT_L
#undef PG8_BAR
#undef PG8_SCHED
}
}

#define LAS __attribute__((address_space(3)))
typedef unsigned short bf16_t;
typedef short bf16x8 __attribute__((ext_vector_type(8)));
typedef float f32x4 __attribute__((ext_vector_type(4)));
typedef float f32x16 __attribute__((ext_vector_type(16)));
typedef unsigned u32x4 __attribute__((ext_vector_type(4)));
typedef unsigned u32x2 __attribute__((ext_vector_type(2)));
typedef short v4i16_t __attribute__((ext_vector_type(4)));

constexpr int NB = 8, SEQ = 4096, DM = 1024, DEPTH = 4, MTOK = NB * SEQ, NIN = 2984, NINP = 3072;
constexpr float EPS_ = 1e-6f, LOG2E = 1.4426950408889634f;
constexpr float C2F = 0.125f * LOG2E;
constexpr float C2M = 0.10206207261596575f * LOG2E;
constexpr int LDS_BYTES = 132096;

constexpr size_t MiB = 1u << 20;
constexpr size_t WS_WIN = 2 * MiB, WS_WOUT = 26 * MiB, WS_WUQ = 34 * MiB, WS_WUKV = 36 * MiB, WS_MOD = 37 * MiB, WS_COS = 38 * MiB, WS_SIN = 40 * MiB,
                 WS_LOGF = 42 * MiB, WS_CUM = 43 * MiB, WS_SSQQ = 44 * MiB, WS_SSQK = 45 * MiB, WS_H = 48 * MiB, WS_QF = 112 * MiB, WS_KF = 144 * MiB,
                 WS_VF = 176 * MiB, WS_GATE = 208 * MiB, WS_QLAT = 272 * MiB, WS_KVLAT = 288 * MiB, WS_KR = 296 * MiB, WS_QM = 298 * MiB, WS_KM = 346 * MiB,
                 WS_VM = 378 * MiB, WS_END = 410 * MiB;
constexpr size_t WS_SB = 47 * MiB;
constexpr int CTR_WORD = 3500;

__device__ __forceinline__ unsigned f2bf(float f) { unsigned u = __builtin_bit_cast(unsigned, f); return (u + 0x7fffu + ((u >> 16) & 1u)) >> 16; }
typedef float f32x2_t __attribute__((ext_vector_type(2))); typedef __bf16 bf16x2_t __attribute__((ext_vector_type(2)));
__device__ __forceinline__ unsigned cvtpk_s(float lo, float hi) { f32x2_t v = {lo, hi}; bf16x2_t b = __builtin_convertvector(v, bf16x2_t); return __builtin_bit_cast(unsigned, b); }
__device__ __forceinline__ unsigned pk2(float lo, float hi) { return cvtpk_s(lo, hi); }
__device__ __forceinline__ float bf2f(bf16_t v) { return __builtin_bit_cast(float, (unsigned)v << 16); }
__device__ __forceinline__ u32x2 pk4(f32x4 v) { u32x2 w; w.x = pk2(v[0], v[1]); w.y = pk2(v[2], v[3]); return w; }
__device__ __forceinline__ float silu_f(float v) { return v * __builtin_amdgcn_rcpf(1.f + __builtin_amdgcn_exp2f(-1.4426950408889634f * v)); }
__device__ __forceinline__ f32x4 silu4(f32x4 v) { return (f32x4){silu_f(v[0]), silu_f(v[1]), silu_f(v[2]), silu_f(v[3])}; }
__device__ __forceinline__ float logsig_f(float x) { return fminf(x, 0.f) - log1pf(expf(-fabsf(x))); }
__device__ __forceinline__ float shx(float v, int mask, int lane) { return __builtin_bit_cast(float, __builtin_amdgcn_ds_bpermute((lane ^ mask) << 2, __builtin_bit_cast(int, v))); }
__device__ __forceinline__ float shup(float v, int off, int lane) { return __builtin_bit_cast(float, __builtin_amdgcn_ds_bpermute(((lane - off) & 63) << 2, __builtin_bit_cast(int, v))); }
__device__ __forceinline__ float wave_sum(float v, int lane) {
#pragma unroll
    for (int o = 1; o < 64; o <<= 1) v += shx(v, o, lane);
    return v;
}
#define LDS_WAIT() asm volatile("s_waitcnt lgkmcnt(0)" ::: "memory")


#define XB_TMO      128
#define XB_XCNT(j)  (256  + 64 * (j))
#define XB_XSUB(j)  (1280 + 64 * (j))
#define XB_XGEN(j)  (2304 + 64 * (j))
#define XB_TOP      3328
#define XB_TOPGEN   3392
#define XCD_BAR_WORDS 3456
#define XB_SPIN_CAP (1u << 18)
__device__ __forceinline__ unsigned xb_ld(unsigned* p)              { return __hip_atomic_load(p, __ATOMIC_RELAXED, __HIP_MEMORY_SCOPE_AGENT); }
__device__ __forceinline__ unsigned xb_add(unsigned* p, unsigned v) { return __hip_atomic_fetch_add(p, v, __ATOMIC_RELAXED, __HIP_MEMORY_SCOPE_AGENT); }
__device__ __forceinline__ unsigned xb_xcc_id() { return (unsigned)__builtin_amdgcn_s_getreg((3 << 11) | 20) & 0xFu; }
#define XB_SPIN(cond, bar) do { unsigned _sp = 0; while (cond) { __builtin_amdgcn_s_sleep(1); \
    if ((++_sp & 255u) == 0u) { if (xb_ld(&(bar)[XB_TMO])) break; if (_sp > XB_SPIN_CAP) { atomicAdd(&(bar)[XB_TMO], 1u); break; } } } } while (0)
__device__ __forceinline__ void xcd_barrier_complete(unsigned* bar, unsigned x, unsigned& nloc, unsigned& nx) {
    const unsigned G = gridDim.x * gridDim.y * gridDim.z;
    unsigned sum, cnt, mine, sp = 0u;
    for (;;) {
        sum = 0u; cnt = 0u; mine = 0u;
#pragma unroll
        for (unsigned j = 0; j < 16; ++j) { const unsigned c = xb_ld(&bar[XB_XCNT(j)]); sum += c; cnt += (c > 0u) ? 1u : 0u; mine = (j == x) ? c : mine; }
        if (sum == G) break;
        __builtin_amdgcn_s_sleep(1);
        if ((++sp & 255u) == 0u) { if (xb_ld(&bar[XB_TMO])) break; if (sp > XB_SPIN_CAP) { atomicAdd(&bar[XB_TMO], 1u); break; } }
    }
    nloc = mine > 0u ? mine : 1u; nx = cnt > 0u ? cnt : 1u;
}
__device__ __forceinline__ void xcd_barrier(unsigned* bar, volatile LAS unsigned* st, int tid) {
    asm volatile("s_waitcnt vmcnt(0)" ::: "memory");
    __syncthreads();
    if (tid == 0) {
        const unsigned x = xb_xcc_id();
        __builtin_amdgcn_s_waitcnt(0);
        unsigned nloc = st[0], nx = st[1];
        if (nloc == 0u) { xcd_barrier_complete(bar, x, nloc, nx); st[0] = nloc; st[1] = nx; }
        const unsigned old = xb_add(&bar[XB_XSUB(x)], 1u);
        const unsigned gen = old / nloc;
        if (old + 1u == (gen + 1u) * nloc) {
            __builtin_amdgcn_fence(__ATOMIC_RELEASE, "agent");
            asm volatile("s_waitcnt vmcnt(0)" ::: "memory");
            const unsigned og = xb_add(&bar[XB_TOP], 1u);
            const unsigned tg = og / nx;
            if (og + 1u == (tg + 1u) * nx) xb_add(&bar[XB_TOPGEN], 1u);
            else XB_SPIN(xb_ld(&bar[XB_TOPGEN]) == tg, bar);
            __builtin_amdgcn_fence(__ATOMIC_ACQUIRE, "agent");
            xb_add(&bar[XB_XGEN(x)], 1u);
            asm volatile("s_waitcnt vmcnt(0)" ::: "memory");
        } else {
            XB_SPIN(xb_ld(&bar[XB_XGEN(x)]) == gen, bar);
            __builtin_amdgcn_fence(__ATOMIC_ACQUIRE, "agent");
            asm volatile("s_waitcnt vmcnt(0)" ::: "memory");
        }
    }
    __syncthreads();
}

using pg8::Unit;
struct EpiIn {
    static constexpr bool PERM = false, AFTER_DRAIN = false;
    unsigned char* ws; const float* BF;
    __device__ __forceinline__ void operator()(const f32x4 (&acc)[2][2][4][2], const Unit& u, int wr, int wc, int fr, int fq) const {
        const int row0 = u.pm * 256 + wr * 64 + fr;
        bf16_t* QF = (bf16_t*)(ws + WS_QF); bf16_t* GATE = (bf16_t*)(ws + WS_GATE); bf16_t* QLAT = (bf16_t*)(ws + WS_QLAT); bf16_t* KVLAT = (bf16_t*)(ws + WS_KVLAT); bf16_t* KR = (bf16_t*)(ws + WS_KR);
        float* LOGF = (float*)(ws + WS_LOGF); float* SSQQ = (float*)(ws + WS_SSQQ); float* SSQK = (float*)(ws + WS_SSQK); const float* COS = (const float*)(ws + WS_COS); const float* SIN = (const float*)(ws + WS_SIN);
        if (u.pn == 8) {
#pragma unroll
            for (int ai = 0; ai < 2; ++ai)
#pragma unroll
                for (int m = 0; m < 4; ++m) {
                    float s = 0.f;
#pragma unroll
                    for (int bj = 0; bj < 2; ++bj)
#pragma unroll
                        for (int n = 0; n < 2; ++n) { const f32x4 x = acc[ai][bj][m][n]; s += (x[0] * x[0] + x[1] * x[1]) + (x[2] * x[2] + x[3] * x[3]); }
                    s += shx(s, 16, fq * 16 + fr); s += shx(s, 32, fq * 16 + fr);
                    if (fq == 0) SSQQ[(size_t)(row0 + ai * 128 + m * 16) * 4 + wc] = s;
                }
        } else if (u.pn == 9) {
#pragma unroll
            for (int ai = 0; ai < 2; ++ai)
#pragma unroll
                for (int m = 0; m < 4; ++m) {
                    float s = 0.f;
#pragma unroll
                    for (int n = 0; n < 2; ++n) { const f32x4 x = acc[ai][0][m][n]; s += (x[0] * x[0] + x[1] * x[1]) + (x[2] * x[2] + x[3] * x[3]); }
                    s += shx(s, 16, fq * 16 + fr); s += shx(s, 32, fq * 16 + fr);
                    if (fq == 0) SSQK[(size_t)(row0 + ai * 128 + m * 16) * 4 + wc] = s;
                }
        }
#pragma unroll
        for (int bj = 0; bj < 2; ++bj) {
            const int gcol = u.pn * 256 + bj * 128 + wc * 32;
            if (gcol < 1536) {
                const int seg = gcol >> 9; bf16_t* base = QF + (size_t)seg * ((WS_KF - WS_QF) / 2); const float sc = seg == 0 ? C2F : 1.f; const int c0 = (gcol & 511) + 4 * fq;
#pragma unroll
                for (int ai = 0; ai < 2; ++ai)
#pragma unroll
                    for (int m = 0; m < 4; ++m) { bf16_t* rp = base + (size_t)(row0 + ai * 128 + m * 16) * 512 + c0;
#pragma unroll
                        for (int n = 0; n < 2; ++n) *(u32x2*)(rp + 16 * n) = pk4(acc[ai][bj][m][n] * sc); }
                if (seg < 2) {
                    const int ln = fq * 16 + fr; float mx = 0.f;
#pragma unroll
                    for (int ai = 0; ai < 2; ++ai)
#pragma unroll
                        for (int m = 0; m < 4; ++m) { const f32x4 a = acc[ai][bj][m][0] * sc, c = acc[ai][bj][m][1] * sc;
                            float s = ((a[0] * a[0] + a[1] * a[1]) + (a[2] * a[2] + a[3] * a[3])) + ((c[0] * c[0] + c[1] * c[1]) + (c[2] * c[2] + c[3] * c[3]));
                            s += shx(s, 16, ln); s += shx(s, 32, ln); mx = fmaxf(mx, s); }
                    mx = fmaxf(mx, shx(mx, 1, ln)); mx = fmaxf(mx, shx(mx, 2, ln)); mx = fmaxf(mx, shx(mx, 4, ln)); mx = fmaxf(mx, shx(mx, 8, ln));
                    if (ln == 0) __hip_atomic_fetch_max((unsigned*)(ws + WS_SB) + ((((u.pm * 256) >> 12) * 8 + ((gcol & 511) >> 6)) * 2 + seg) * 2 + ((gcol >> 5) & 1), __builtin_bit_cast(unsigned, mx), __ATOMIC_RELAXED, __HIP_MEMORY_SCOPE_AGENT);
                }
            } else if (gcol < 2048 || (gcol >= 2464 && gcol < 2976)) {
                const int c0 = (gcol < 2048 ? gcol - 1536 : gcol - 2464 + 512) + 4 * fq;
#pragma unroll
                for (int ai = 0; ai < 2; ++ai)
#pragma unroll
                    for (int m = 0; m < 4; ++m) { bf16_t* rp = GATE + (size_t)(row0 + ai * 128 + m * 16) * 1024 + c0;
#pragma unroll
                        for (int n = 0; n < 2; ++n) *(u32x2*)(rp + 16 * n) = pk4(silu4(acc[ai][bj][m][n])); }
            } else if (gcol < 2304) {
                const int c0 = gcol - 2048 + 4 * fq;
#pragma unroll
                for (int ai = 0; ai < 2; ++ai)
#pragma unroll
                    for (int m = 0; m < 4; ++m) { bf16_t* rp = QLAT + (size_t)(row0 + ai * 128 + m * 16) * 256 + c0;
#pragma unroll
                        for (int n = 0; n < 2; ++n) *(u32x2*)(rp + 16 * n) = pk4(acc[ai][bj][m][n]); }
            } else if (gcol < 2432) {
                const int c0 = gcol - 2304 + 4 * fq;
#pragma unroll
                for (int ai = 0; ai < 2; ++ai)
#pragma unroll
                    for (int m = 0; m < 4; ++m) { bf16_t* rp = KVLAT + (size_t)(row0 + ai * 128 + m * 16) * 128 + c0;
#pragma unroll
                        for (int n = 0; n < 2; ++n) *(u32x2*)(rp + 16 * n) = pk4(acc[ai][bj][m][n]); }
            } else if (gcol < 2464) {
#pragma unroll
                for (int ai = 0; ai < 2; ++ai)
#pragma unroll
                    for (int m = 0; m < 4; ++m) { const size_t row = (size_t)(row0 + ai * 128 + m * 16);
                        const f32x4 cs = *(const f32x4*)(COS + row * 16 + 4 * fq), sn = *(const f32x4*)(SIN + row * 16 + 4 * fq);
                        const f32x4 t1 = acc[ai][bj][m][0], t2 = acc[ai][bj][m][1];
                        const f32x4 o1 = t1 * cs - t2 * sn, o2 = t2 * cs + t1 * sn;
                        bf16_t* rp = KR + row * 32 + 4 * fq; *(u32x2*)(rp) = pk4(o1); *(u32x2*)(rp + 16) = pk4(o2); if (m & 1) asm volatile("" ::: "memory"); }
            } else if (gcol == 2976) {
                if (fq < 2) {
                    const f32x4 bfv = *(const f32x4*)(BF + 4 * fq);
#pragma unroll
                    for (int ai = 0; ai < 2; ++ai)
#pragma unroll
                        for (int m = 0; m < 4; ++m) { const size_t row = (size_t)(row0 + ai * 128 + m * 16); const f32x4 v = acc[ai][bj][m][0] + bfv;
                            *(f32x4*)(LOGF + row * 8 + 4 * fq) = (f32x4){logsig_f(v[0]), logsig_f(v[1]), logsig_f(v[2]), logsig_f(v[3])}; }
                }
            }
        }
    }
};
struct EpiQ {
    static constexpr bool PERM = false, AFTER_DRAIN = false;
    unsigned char* ws;
    __device__ __forceinline__ void operator()(const f32x4 (&acc)[2][2][4][2], const Unit& u, int wr, int wc, int fr, int fq) const {
        const int row0 = u.pm * 256 + wr * 64 + fr;
        const float* SSQ = (const float*)(ws + WS_SSQQ); const float* COS = (const float*)(ws + WS_COS); const float* SIN = (const float*)(ws + WS_SIN); bf16_t* QM = (bf16_t*)(ws + WS_QM);
        float rs[2][4];
#pragma unroll
        for (int ai = 0; ai < 2; ++ai)
#pragma unroll
            for (int m = 0; m < 4; ++m) { const f32x4 s = *(const f32x4*)(SSQ + (size_t)(row0 + ai * 128 + m * 16) * 4); rs[ai][m] = rsqrtf(((s[0] + s[1]) + (s[2] + s[3])) * (1.f / 256.f) + EPS_) * C2M; }
#pragma unroll
        for (int bj = 0; bj < 2; ++bj) {
            const int gcol = u.pn * 256 + bj * 128 + wc * 32; const bool rope = ((gcol >> 5) % 3) == 2;
#pragma unroll
            for (int ai = 0; ai < 2; ++ai)
#pragma unroll
                for (int m = 0; m < 4; ++m) { const size_t row = (size_t)(row0 + ai * 128 + m * 16);
                    f32x4 v0 = acc[ai][bj][m][0] * rs[ai][m], v1 = acc[ai][bj][m][1] * rs[ai][m];
                    if (rope) { const f32x4 cs = *(const f32x4*)(COS + row * 16 + 4 * fq), sn = *(const f32x4*)(SIN + row * 16 + 4 * fq);
                        const f32x4 o1 = v0 * cs - v1 * sn, o2 = v1 * cs + v0 * sn; v0 = o1; v1 = o2; }
                    bf16_t* rp = QM + row * 768 + gcol + 4 * fq; *(u32x2*)(rp) = pk4(v0); *(u32x2*)(rp + 16) = pk4(v1); if (m & 1) asm volatile("" ::: "memory"); }
        }
    }
};
struct EpiKV {
    static constexpr bool PERM = false, AFTER_DRAIN = false;
    unsigned char* ws;
    __device__ __forceinline__ void operator()(const f32x4 (&acc)[2][2][4][2], const Unit& u, int wr, int wc, int fr, int fq) const {
        const int row0 = u.pm * 256 + wr * 64 + fr;
        const float* SSQ = (const float*)(ws + WS_SSQK); bf16_t* KM = (bf16_t*)(ws + WS_KM);
        float rs[2][4];
#pragma unroll
        for (int ai = 0; ai < 2; ++ai)
#pragma unroll
            for (int m = 0; m < 4; ++m) { const f32x4 s = *(const f32x4*)(SSQ + (size_t)(row0 + ai * 128 + m * 16) * 4); rs[ai][m] = rsqrtf(((s[0] + s[1]) + (s[2] + s[3])) * (1.f / 128.f) + EPS_); }
#pragma unroll
        for (int bj = 0; bj < 2; ++bj) {
            const int gcol = u.pn * 256 + bj * 128 + wc * 32; const int head = gcol >> 7, within = gcol & 127;
            bf16_t* base = KM + (within < 64 ? (size_t)0 : (size_t)((WS_VM - WS_KM) / 2)); const int c0 = head * 64 + (within & 63) + 4 * fq;
#pragma unroll
            for (int ai = 0; ai < 2; ++ai)
#pragma unroll
                for (int m = 0; m < 4; ++m) { bf16_t* rp = base + (size_t)(row0 + ai * 128 + m * 16) * 512 + c0;
#pragma unroll
                    for (int n = 0; n < 2; ++n) *(u32x2*)(rp + 16 * n) = pk4(acc[ai][bj][m][n] * rs[ai][m]); }
        }
    }
};
struct EpiOut {
    static constexpr bool PERM = false, AFTER_DRAIN = false;
    const float* XIN; float* XOUT; const float* MODG;
    __device__ __forceinline__ void operator()(const f32x4 (&acc)[2][2][4][2], const Unit& u, int wr, int wc, int fr, int fq) const {
        const int row0 = u.pm * 256 + wr * 64 + fr; const int b = (u.pm * 256) >> 12;
#pragma unroll
        for (int bj = 0; bj < 2; ++bj) {
            const int col = u.pn * 256 + bj * 128 + wc * 32 + 4 * fq;
            const f32x4 g0 = *(const f32x4*)(MODG + (size_t)b * 3072 + col), g1 = *(const f32x4*)(MODG + (size_t)b * 3072 + col + 16);
            f32x4 xi[2][4][2];
#pragma unroll
            for (int ai = 0; ai < 2; ++ai)
#pragma unroll
                for (int m = 0; m < 4; ++m) { const size_t off = (size_t)(row0 + ai * 128 + m * 16) * 1024 + col; xi[ai][m][0] = *(const f32x4*)(XIN + off); xi[ai][m][1] = *(const f32x4*)(XIN + off + 16); }
#pragma unroll
            for (int ai = 0; ai < 2; ++ai)
#pragma unroll
                for (int m = 0; m < 4; ++m) { const size_t off = (size_t)(row0 + ai * 128 + m * 16) * 1024 + col;
                    *(f32x4*)(XOUT + off) = xi[ai][m][0] + g0 * acc[ai][bj][m][0]; *(f32x4*)(XOUT + off + 16) = xi[ai][m][1] + g1 * acc[ai][bj][m][1]; }
            asm volatile("" ::: "memory");
        }
    }
};

__device__ __forceinline__ int crow(int r, int hi) { return (r & 3) + 8 * (r >> 2) + 4 * hi; }
__device__ __forceinline__ bf16x8 vtr2(const LAS unsigned char* p) {
    const v4i16_t lo = __builtin_amdgcn_ds_read_tr16_b64_v4i16((LAS v4i16_t*)p), hi = __builtin_amdgcn_ds_read_tr16_b64_v4i16((LAS v4i16_t*)(p + 512));
    return (bf16x8){lo[0], lo[1], lo[2], lo[3], hi[0], hi[1], hi[2], hi[3]};
}
constexpr int AT_KBUF = 13312, AT_OFF_V = 2 * AT_KBUF, AT_OFF_CK = AT_OFF_V + 2 * 8192, AT_OFF_WS = AT_OFF_CK + 512;

template <bool MLA>
__device__ __forceinline__ void attn_unit(LAS unsigned char* lds, int b, int h, int qb, unsigned char* ws, int wave_s) {
    constexpr int DQK = MLA ? 96 : 64, NDS = DQK / 16, KROW = MLA ? 208 : 144, QP = MLA ? 768 : 512;
    const bf16_t* Q = (const bf16_t*)(ws + (MLA ? WS_QM : WS_QF)); const bf16_t* K = (const bf16_t*)(ws + (MLA ? WS_KM : WS_KF)); const bf16_t* V = (const bf16_t*)(ws + (MLA ? WS_VM : WS_VF));
    const bf16_t* KRp = (const bf16_t*)(ws + WS_KR); const float* CUM = (const float*)(ws + WS_CUM); const bf16_t* GATE = (const bf16_t*)(ws + WS_GATE); bf16_t* Y = (bf16_t*)(ws + WS_H);
    const int tid = otid(wave_s), lane = tid & 63, r32 = lane & 31, hi = lane >> 5; const int wid = __builtin_amdgcn_readfirstlane(tid >> 6);
    const int par = 0;
    const int q0 = qb * 256, qw0 = q0 + wid * 32; const size_t rowbase = (size_t)b * SEQ;
    const int NT = q0 / 64 + 4;
    bf16x8 qr[NDS];
    { const bf16_t* qp = Q + (rowbase + qw0 + r32) * QP + h * DQK + hi * 8;
#pragma unroll
      for (int ds = 0; ds < NDS; ++ds) qr[ds] = *(const bf16x8*)(qp + ds * 16); }
    int t0 = 0;
    if (!MLA) {
        LAS int* tb = (LAS int*)(lds + AT_OFF_WS);
        if (wid == 0) {
            const unsigned* SB = (const unsigned*)(ws + WS_SB) + (size_t)(b * 8 + h) * 4;
            const float sb = sqrtf(__builtin_bit_cast(float, SB[0]) + __builtin_bit_cast(float, SB[1])) * sqrtf(__builtin_bit_cast(float, SB[2]) + __builtin_bit_cast(float, SB[3])) * 1.02f + 1.0f;
            const float* cb_ = CUM + (size_t)(b * 8 + h) * SEQ; const float c0 = cb_[q0];
            float Bd = -1e30f; if (lane < NT) Bd = 2.f * sb + c0 - cb_[64 * lane + 63];
            const unsigned long long mk = __ballot(Bd >= -160.f);
            int tmin = mk ? (int)__builtin_ctzll(mk) : 0;
            tmin &= ~1; if (tmin > NT - 4) tmin = NT - 4;
            if (lane == 0) *tb = tmin;
        }
        __syncthreads();
        t0 = __builtin_amdgcn_readfirstlane(*tb);
    }
    const int krow = tid >> 3, kch = tid & 7;
    const bf16_t* kgu = K + rowbase * 512 + h * 64; const unsigned koff = (unsigned)(krow * 512 + kch * 8); const int kdst = krow * KROW + kch * 16;
    const bf16_t* krgu = KRp + rowbase * 32; const unsigned kroff = (unsigned)((tid >> 2) * 32 + (tid & 3) * 8); const int krdst = (tid >> 2) * KROW + 128 + (tid & 3) * 16;
    const int vdh = tid >> 8, vrow = (tid >> 2) & 63, vc4 = tid & 3;
    const bf16_t* vgu = V + rowbase * 512 + h * 64; const unsigned voff = (unsigned)(vrow * 512 + vdh * 32 + vc4 * 8); const int vdst = AT_OFF_V + vdh * 4096 + vrow * 64 + vc4 * 16;
    const float* ckgu = CUM + (size_t)(b * 8 + h) * SEQ; const unsigned ckoff = (unsigned)(tid & 63);
    u32x4 kreg, krreg = (u32x4){0u, 0u, 0u, 0u}, vreg; float ckreg = 0.f;
#define AT_LOADK(t) do { kreg = *(const u32x4*)(kgu + (size_t)(t) * 64 * 512 + koff); \
        if (MLA) { if (tid < 256) krreg = *(const u32x4*)(krgu + (size_t)(t) * 64 * 32 + kroff); } else { if (tid < 64) ckreg = -ckgu[(size_t)(t) * 64 + ckoff]; } } while (0)
#define AT_STOREK(bf) do { *(LAS u32x4*)(lds + (bf) * AT_KBUF + kdst) = kreg; \
        if (MLA) { if (tid < 256) *(LAS u32x4*)(lds + (bf) * AT_KBUF + krdst) = krreg; } else { if (tid < 64) *(LAS float*)(lds + AT_OFF_CK + (bf) * 256 + tid * 4) = ckreg; } } while (0)
#define AT_LOADV(t) do { vreg = *(const u32x4*)(vgu + (size_t)(t) * 64 * 512 + voff); } while (0)
#define AT_STOREV(bf) do { *(LAS u32x4*)(lds + (bf) * 8192 + vdst) = vreg; } while (0)
    float mhat = -1e30f, lsum = 0.f; f32x16 o0 = {}, o1 = {};
    const int vb = AT_OFF_V + ((lane >> 4) & 1) * 32 + (lane & 3) * 8 + (4 * hi + ((lane & 15) >> 2)) * 64;
#define AT_QK(P0, P1, t_, MASKOK) do { const int bf_ = (t_) & 1; \
        if (!MLA) { _Pragma("unroll") for (int g = 0; g < 4; ++g) { const f32x4 c0 = *(const LAS f32x4*)(lds + AT_OFF_CK + bf_ * 256 + (8 * g + 4 * hi) * 4), c1 = *(const LAS f32x4*)(lds + AT_OFF_CK + bf_ * 256 + (32 + 8 * g + 4 * hi) * 4); \
                _Pragma("unroll") for (int e = 0; e < 4; ++e) { P0[4 * g + e] = c0[e]; P1[4 * g + e] = c1[e]; } } } \
        else { P0 = (f32x16){}; P1 = (f32x16){}; } \
        const LAS unsigned char* kb_ = lds + bf_ * AT_KBUF + r32 * KROW + hi * 16; \
        _Pragma("unroll") for (int ds = 0; ds < NDS; ++ds) { \
            const bf16x8 kf0 = *(const LAS bf16x8*)(kb_ + ds * 32), kf1 = *(const LAS bf16x8*)(kb_ + 32 * KROW + ds * 32); \
            P0 = __builtin_amdgcn_mfma_f32_32x32x16_bf16(kf0, qr[ds], P0, 0, 0, 0); \
            P1 = __builtin_amdgcn_mfma_f32_32x32x16_bf16(kf1, qr[ds], P1, 0, 0, 0); } \
        if (MASKOK && !MLA && (t_) * 64 + 63 > qw0) { const int q_ = qw0 + r32; \
            _Pragma("unroll") for (int r = 0; r < 16; ++r) { const int kv = (t_) * 64 + crow(r, hi); if (kv > q_) P0[r] = -INFINITY; if (kv + 32 > q_) P1[r] = -INFINITY; } } } while (0)
#define AT_QKF(P0, P1, t_, MASKOK) do { const int bf_ = (t_) & 1; \
        if (!MLA) { _Pragma("unroll") for (int g = 0; g < 4; ++g) { const f32x4 c0 = *(const LAS f32x4*)(lds + AT_OFF_CK + bf_ * 256 + (8 * g + 4 * hi) * 4), c1 = *(const LAS f32x4*)(lds + AT_OFF_CK + bf_ * 256 + (32 + 8 * g + 4 * hi) * 4); \
                _Pragma("unroll") for (int e = 0; e < 4; ++e) { P0[4 * g + e] = c0[e]; P1[4 * g + e] = c1[e]; } } } \
        else { P0 = (f32x16){}; P1 = (f32x16){}; } \
        const LAS unsigned char* kb_ = lds + bf_ * AT_KBUF + r32 * KROW + hi * 16; \
        _Pragma("unroll") for (int hb = 0; hb < 2; ++hb) { bf16x8 kf_[NDS]; \
            _Pragma("unroll") for (int d2 = 0; d2 < NDS / 2; ++d2) { const int ds = hb * (NDS / 2) + d2; kf_[2 * d2] = *(const LAS bf16x8*)(kb_ + ds * 32); kf_[2 * d2 + 1] = *(const LAS bf16x8*)(kb_ + 32 * KROW + ds * 32); } \
            __builtin_amdgcn_sched_barrier(0); \
            _Pragma("unroll") for (int d2 = 0; d2 < NDS / 2; ++d2) { const int ds = hb * (NDS / 2) + d2; \
                P0 = __builtin_amdgcn_mfma_f32_32x32x16_bf16(kf_[2 * d2], qr[ds], P0, 0, 0, 0); \
                P1 = __builtin_amdgcn_mfma_f32_32x32x16_bf16(kf_[2 * d2 + 1], qr[ds], P1, 0, 0, 0); } } \
        if (MASKOK && !MLA && (t_) * 64 + 63 > qw0) { const int q_ = qw0 + r32; \
            _Pragma("unroll") for (int r = 0; r < 16; ++r) { const int kv = (t_) * 64 + crow(r, hi); if (kv > q_) P0[r] = -INFINITY; if (kv + 32 > q_) P1[r] = -INFINITY; } } } while (0)
#define AT_SMPV(P0, P1, t_) do { const int bf_ = (t_) & 1; \
        float ra = fmaxf(fmaxf(P0[0], P0[1]), P1[0]), rb = fmaxf(fmaxf(P0[2], P0[3]), P1[1]); ra = fmaxf(fmaxf(ra, P1[2]), P1[3]); \
        _Pragma("unroll") for (int r = 4; r < 16; r += 4) { ra = fmaxf(fmaxf(ra, P0[r]), P0[r + 1]); rb = fmaxf(fmaxf(rb, P0[r + 2]), P0[r + 3]); ra = fmaxf(fmaxf(ra, P1[r]), P1[r + 1]); rb = fmaxf(fmaxf(rb, P1[r + 2]), P1[r + 3]); } \
        float rm = fmaxf(ra, rb); { auto rr = __builtin_amdgcn_permlane32_swap(__float_as_uint(rm), __float_as_uint(rm), false, false); rm = fmaxf(__uint_as_float(rr[0]), __uint_as_float(rr[1])); } \
        if (__any(rm > mhat + 16.f)) { \
            const float mnew = fmaxf(mhat, rm), alpha = __builtin_amdgcn_exp2f(mhat - mnew); \
            lsum *= alpha; mhat = mnew; \
            _Pragma("unroll") for (int r = 0; r < 16; ++r) { o0[r] *= alpha; o1[r] *= alpha; } } \
        float sacc = 0.f; \
        _Pragma("unroll") for (int r = 0; r < 16; ++r) { P0[r] = __builtin_amdgcn_exp2f(P0[r] - mhat); P1[r] = __builtin_amdgcn_exp2f(P1[r] - mhat); sacc += P0[r] + P1[r]; } \
        lsum += sacc; \
        u32x4 pw[4]; \
        _Pragma("unroll") for (int s = 0; s < 2; ++s) { \
            pw[s]     = (u32x4){cvtpk_s(P0[8 * s], P0[8 * s + 1]), cvtpk_s(P0[8 * s + 2], P0[8 * s + 3]), cvtpk_s(P0[8 * s + 4], P0[8 * s + 5]), cvtpk_s(P0[8 * s + 6], P0[8 * s + 7])}; \
            pw[2 + s] = (u32x4){cvtpk_s(P1[8 * s], P1[8 * s + 1]), cvtpk_s(P1[8 * s + 2], P1[8 * s + 3]), cvtpk_s(P1[8 * s + 4], P1[8 * s + 5]), cvtpk_s(P1[8 * s + 6], P1[8 * s + 7])}; } \
        const LAS unsigned char* vp_ = lds + vb + bf_ * 8192; \
        _Pragma("unroll") for (int s = 0; s < 4; ++s) { \
            const bf16x8 pa = __builtin_bit_cast(bf16x8, pw[s]); \
            const bf16x8 v0 = vtr2(vp_ + s * 1024), v1 = vtr2(vp_ + 4096 + s * 1024); \
            o0 = __builtin_amdgcn_mfma_f32_32x32x16_bf16(v0, pa, o0, 0, 0, 0); \
            o1 = __builtin_amdgcn_mfma_f32_32x32x16_bf16(v1, pa, o1, 0, 0, 0); } } while (0)
#define AT_STEP(PAR, C0, C1, N0, N1, t_) do { \
        if ((t_) + 2 < NT) AT_LOADK((t_) + 2); if ((t_) + 1 < NT) AT_LOADV((t_) + 1); \
        const bool actN_ = ((t_) + 1 < NT) && (((t_) + 1) * 64 <= qw0), actC_ = ((t_) * 64 <= qw0); \
        __builtin_amdgcn_sched_barrier(0); \
        if (PAR == 0) { if (actN_) AT_QK(N0, N1, (t_) + 1, true); if (actC_) AT_SMPV(C0, C1, t_); } \
        else          { if (actC_) AT_SMPV(C0, C1, t_); if (actN_) AT_QK(N0, N1, (t_) + 1, true); } \
        __builtin_amdgcn_sched_barrier(0); \
        if ((t_) + 2 < NT) AT_STOREK((t_) & 1); if ((t_) + 1 < NT) AT_STOREV(((t_) + 1) & 1); \
        __syncthreads(); } while (0)
#define AT_STEADY(PAR, C0, C1, N0, N1, t_) do { \
        AT_LOADK((t_) + 2); AT_LOADV((t_) + 1); \
        __builtin_amdgcn_sched_barrier(0); \
        if (PAR == 0) { AT_QKF(N0, N1, (t_) + 1, false); AT_SMPV(C0, C1, t_); } \
        else          { AT_SMPV(C0, C1, t_); AT_QK(N0, N1, (t_) + 1, false); \
            _Pragma("unroll") for (int i_ = 0; i_ < 2 * NDS; ++i_) { __builtin_amdgcn_sched_group_barrier(0x002, 12, 0); __builtin_amdgcn_sched_group_barrier(0x008, 1, 0); } } \
        __builtin_amdgcn_sched_barrier(0); \
        AT_STOREK((t_) & 1); AT_STOREV(((t_) + 1) & 1); \
        __syncthreads(); } while (0)
    f32x16 sa0, sa1, sb0, sb1;
    __syncthreads();
    AT_LOADK(t0); AT_LOADV(t0); AT_STOREK(0); AT_STOREV(0); AT_LOADK(t0 + 1); AT_STOREK(1);
    __syncthreads();
    AT_QK(sa0, sa1, t0, true);
    __syncthreads();
    int t = t0;
    if (par == 0) {
        for (; t + 6 < NT; t += 2) { AT_STEADY(0, sa0, sa1, sb0, sb1, t); AT_STEADY(0, sb0, sb1, sa0, sa1, t + 1); }
        for (; t < NT; t += 2) { AT_STEP(0, sa0, sa1, sb0, sb1, t); AT_STEP(0, sb0, sb1, sa0, sa1, t + 1); }
    } else {
        for (; t + 6 < NT; t += 2) { AT_STEADY(1, sa0, sa1, sb0, sb1, t); AT_STEADY(1, sb0, sb1, sa0, sa1, t + 1); }
        for (; t < NT; t += 2) { AT_STEP(1, sa0, sa1, sb0, sb1, t); AT_STEP(1, sb0, sb1, sa0, sa1, t + 1); }
    }
#undef AT_LOADK
#undef AT_STOREK
#undef AT_LOADV
#undef AT_STOREV
#undef AT_QK
#undef AT_QKF
#undef AT_SMPV
#undef AT_STEP
#undef AT_STEADY
    float lt; { auto rr = __builtin_amdgcn_permlane32_swap(__float_as_uint(lsum), __float_as_uint(lsum), false, false); lt = __uint_as_float(rr[0]) + __uint_as_float(rr[1]); }
    const float rl = __builtin_amdgcn_rcpf(lt);
    const size_t ob = (rowbase + qw0 + r32) * 1024 + (MLA ? 512 : 0) + h * 64 + 4 * hi;
#pragma unroll
    for (int g = 0; g < 4; ++g) {
        const u32x2 ga = *(const u32x2*)(GATE + ob + 8 * g), gb = *(const u32x2*)(GATE + ob + 32 + 8 * g);
        f32x4 a = (f32x4){o0[4 * g], o0[4 * g + 1], o0[4 * g + 2], o0[4 * g + 3]} * rl, c = (f32x4){o1[4 * g], o1[4 * g + 1], o1[4 * g + 2], o1[4 * g + 3]} * rl;
        a = a * (f32x4){__builtin_bit_cast(float, ga.x << 16), __builtin_bit_cast(float, ga.x & 0xffff0000u), __builtin_bit_cast(float, ga.y << 16), __builtin_bit_cast(float, ga.y & 0xffff0000u)};
        c = c * (f32x4){__builtin_bit_cast(float, gb.x << 16), __builtin_bit_cast(float, gb.x & 0xffff0000u), __builtin_bit_cast(float, gb.y << 16), __builtin_bit_cast(float, gb.y & 0xffff0000u)};
        *(u32x2*)(Y + ob + 8 * g) = pk4(a); *(u32x2*)(Y + ob + 32 + 8 * g) = pk4(c);
    }
}

template <int MODE>
__device__ __forceinline__ void transpose_item(const float* __restrict__ W, int K, int Nsrc, int Ndst, bf16_t* __restrict__ WT, const float* __restrict__ kscale, LAS float* scr, int item, int lane) {
    const int nblk = Ndst / 32, kb = item / nblk, nb = item % nblk, k0 = 64 * kb, n0 = 32 * nb;
    const int nd = n0 + (lane & 31); int ns = nd; bool valid = true;
    if (MODE == 1) { if (nd < 1536) ns = nd; else if (nd < 2976) ns = nd + 8; else if (nd < 2984) ns = nd - 1440; else { ns = 0; valid = false; } }
#pragma unroll 32
    for (int i = 0; i < 32; ++i) { const int kk = 2 * i + (lane >> 5); float v = valid ? W[(size_t)(k0 + kk) * Nsrc + ns] : 0.f; if (kscale) v *= kscale[k0 + kk]; scr[kk * 33 + (lane & 31)] = v; }
    LDS_WAIT();
    const int c = lane & 7;
#pragma unroll
    for (int j = 0; j < 4; ++j) { const int n = (lane >> 3) + 8 * j; const LAS float* s = scr + (8 * c) * 33 + n;
        u32x4 o; o.x = pk2(s[0 * 33], s[1 * 33]); o.y = pk2(s[2 * 33], s[3 * 33]); o.z = pk2(s[4 * 33], s[5 * 33]); o.w = pk2(s[6 * 33], s[7 * 33]);
        *(u32x4*)(WT + (size_t)(n0 + n) * K + k0 + 8 * c) = o; }
    LDS_WAIT();
}

struct Args { const void* in[14]; float* out; unsigned char* ws; };

__global__ void __launch_bounds__(512) mk_fwd(Args args) {
    extern __shared__ __attribute__((aligned(16))) unsigned char smem[];
    LAS unsigned char* lds = (LAS unsigned char*)smem;
    cg::grid_group grid = cg::this_grid();
    const int wave_s = __builtin_amdgcn_readfirstlane((int)threadIdx.x >> 6);
    const int G = gridDim.x, bx = blockIdx.x, NGW = G * 8;
    unsigned char* ws = args.ws; float* X = args.out;
    float* MOD = (float*)(ws + WS_MOD);
    unsigned* bar = (unsigned*)ws;
    volatile LAS unsigned* bst = (volatile LAS unsigned*)(lds + 131072);
    { const int t0 = otid(wave_s); if (t0 < 2) bst[t0] = 0u; __syncthreads(); if (t0 == 0) (void)xb_add(&bar[XB_XCNT(xb_xcc_id())], 1u); }
#define GRID_BAR() xcd_barrier(bar, bst, otid(wave_s))

    {
        const int tid = otid(wave_s), lane = tid & 63; const int wave = __builtin_amdgcn_readfirstlane(tid >> 6); const int gw = bx * 8 + wave;
        const float* c_in = (const float*)args.in[1]; const int* pos_in = (const int*)args.in[2];
        const float* w_ada = (const float*)args.in[4]; const float* b_ada = (const float*)args.in[5];
        const float* w_in = (const float*)args.in[6]; const float* q_norm_g = (const float*)args.in[8];
        const float* w_uq = (const float*)args.in[9]; const float* kv_norm_g = (const float*)args.in[10]; const float* w_ukv = (const float*)args.in[11];
        const float* w_out = (const float*)args.in[12];
        bf16_t* WIN = (bf16_t*)(ws + WS_WIN); bf16_t* WOUT = (bf16_t*)(ws + WS_WOUT); bf16_t* WUQ = (bf16_t*)(ws + WS_WUQ); bf16_t* WUKV = (bf16_t*)(ws + WS_WUKV);
        float* COS = (float*)(ws + WS_COS); float* SIN = (float*)(ws + WS_SIN);
        for (int unit = bx; unit < DEPTH * 48; unit += G) {
            LAS float* cact = (LAS float*)lds; LAS float* red = (LAS float*)(lds + 32768);
            const int l = unit / 48, n = (unit % 48) * 64 + lane;
            for (int i = tid; i < NB * DM; i += 512) cact[i] = silu_f(c_in[i]);
            __syncthreads();
            float a[8];
#pragma unroll
            for (int b = 0; b < 8; ++b) a[b] = 0.f;
            const float* wp = w_ada + ((size_t)l * DM + 128 * wave) * 3072 + n;
#pragma unroll 16
            for (int kk = 0; kk < 128; ++kk) { const float wv = wp[(size_t)kk * 3072];
#pragma unroll
                for (int b = 0; b < 8; ++b) a[b] += cact[b * DM + 128 * wave + kk] * wv; }
#pragma unroll
            for (int b = 0; b < 8; ++b) red[(wave * 8 + b) * 64 + lane] = a[b];
            __syncthreads();
            { float s = b_ada[l * 3072 + n];
#pragma unroll
              for (int w2 = 0; w2 < 8; ++w2) s += red[(w2 * 8 + wave) * 64 + lane];
              MOD[(size_t)(l * 8 + wave) * 3072 + n] = s; }
            __syncthreads();
        }
        { LAS float* scr = (LAS float*)(lds + 49152) + wave * (64 * 33);
          constexpr int I_IN = 16 * 96, I_OUT = 16 * 32, I_UQ = 4 * 24, I_UKV = 2 * 32, I_L = I_IN + I_OUT + I_UQ + I_UKV;
          for (int it = gw; it < DEPTH * I_L; it += NGW) {
              const int l = it / I_L; int r = it % I_L;
              if (r < I_IN) { transpose_item<1>(w_in + (size_t)l * DM * NIN, DM, NIN, NINP, WIN + (size_t)l * NINP * DM, nullptr, scr, r, lane); continue; } r -= I_IN;
              if (r < I_OUT) { transpose_item<0>(w_out + (size_t)l * DM * DM, DM, DM, DM, WOUT + (size_t)l * DM * DM, nullptr, scr, r, lane); continue; } r -= I_OUT;
              if (r < I_UQ) { transpose_item<0>(w_uq + (size_t)l * 256 * 768, 256, 768, 768, WUQ + (size_t)l * 768 * 256, q_norm_g + l * 256, scr, r, lane); continue; } r -= I_UQ;
              transpose_item<0>(w_ukv + (size_t)l * 128 * 1024, 128, 1024, 1024, WUKV + (size_t)l * 1024 * 128, kv_norm_g + l * 128, scr, r, lane);
          } }
        for (int idx = bx * 512 + tid; idx < MTOK * 16; idx += G * 512) {
            const int tok = idx >> 4, i = idx & 15;
            const float inv = 1.0f / powf(10000.0f, (float)(2 * i) * (1.0f / 32.0f));
            const float ang = (float)pos_in[tok] * inv; float sn, cs; sincosf(ang, &sn, &cs);
            COS[idx] = cs; SIN[idx] = sn;
        }
    }

    grid.sync();
    for (int l = 0; l <= DEPTH; ++l) {
        if (l > 0) GRID_BAR();
        {
            const int tid = otid(wave_s), lane = tid & 63; const int wave = __builtin_amdgcn_readfirstlane(tid >> 6); const int gw = bx * 8 + wave;
            const bool fin = (l == DEPTH);
            if (bx == 0 && tid < 256) ((unsigned*)(ws + WS_SB))[tid] = 0u;
            const float* xs = (l == 0) ? (const float*)args.in[0] : X; const float* gsrc = fin ? (const float*)args.in[13] : (const float*)args.in[3] + l * DM;
            bf16_t* H = (bf16_t*)(ws + WS_H);
            for (int r0 = gw * 16; r0 < MTOK; r0 += NGW * 16) {
                const int b = r0 >> 12;
                f32x4 gs[4], sh[4];
#pragma unroll
                for (int j = 0; j < 4; ++j) { const int col = 4 * lane + 256 * j; const f32x4 g = *(const f32x4*)(gsrc + col);
                    if (fin) { gs[j] = g; sh[j] = (f32x4){0.f, 0.f, 0.f, 0.f}; }
                    else { const f32x4 sc = *(const f32x4*)(MOD + (size_t)(l * 8 + b) * 3072 + 1024 + col); gs[j] = g * (sc + 1.0f); sh[j] = *(const f32x4*)(MOD + (size_t)(l * 8 + b) * 3072 + col); } }
                for (int rr = 0; rr < 16; ++rr) {
                    const size_t row = (size_t)(r0 + rr);
                    f32x4 v[4]; float ss = 0.f;
#pragma unroll
                    for (int j = 0; j < 4; ++j) { v[j] = *(const f32x4*)(xs + row * DM + 4 * lane + 256 * j); ss += (v[j][0] * v[j][0] + v[j][1] * v[j][1]) + (v[j][2] * v[j][2] + v[j][3] * v[j][3]); }
                    const float rstd = rsqrtf(wave_sum(ss, lane) * (1.f / DM) + EPS_);
                    if (fin) {
#pragma unroll
                        for (int j = 0; j < 4; ++j) *(f32x4*)(X + row * DM + 4 * lane + 256 * j) = v[j] * rstd * gs[j];
                    } else {
#pragma unroll
                        for (int j = 0; j < 4; ++j) *(u32x2*)(H + row * DM + 4 * lane + 256 * j) = pk4(v[j] * rstd * gs[j] + sh[j]);
                    }
                }
            }
        }
        if (l == DEPTH) break;
        GRID_BAR();
        {
            pg8::Gemm g{(const bf16_t*)(ws + WS_H), (const bf16_t*)(ws + WS_WIN) + (size_t)l * NINP * DM, MTOK, NINP, DM}; pg8::StaticOrder S; S.init(MTOK, NINP, G, bx);
            EpiIn E{ws, (const float*)args.in[7] + l * 8};
            pg8::gemm_phase<EpiIn, pg8::StaticOrder, true, true>(lds, g, S, E, wave_s);
        }
        GRID_BAR();
        {
            const int tid = otid(wave_s), lane = tid & 63; const int wave = __builtin_amdgcn_readfirstlane(tid >> 6);
            const float* LOGF = (const float*)(ws + WS_LOGF); float* CUM = (float*)(ws + WS_CUM);
            for (int u = bx; u < 64; u += G) {
                LAS float* wsum = (LAS float*)lds;
                const float* lf = LOGF + (size_t)(u >> 3) * SEQ * 8 + (u & 7);
                float v[8]; float s = 0.f;
#pragma unroll
                for (int i = 0; i < 8; ++i) { s += lf[(size_t)(8 * tid + i) * 8]; v[i] = s; }
                float incl = s;
#pragma unroll
                for (int off = 1; off < 64; off <<= 1) { const float t = shup(incl, off, lane); if (lane >= off) incl += t; }
                if (lane == 63) wsum[wave] = incl;
                __syncthreads();
                float base = 0.f;
                for (int w2 = 0; w2 < wave; ++w2) base += wsum[w2];
                const float excl = base + incl - s;
#pragma unroll
                for (int i = 0; i < 8; ++i) CUM[(size_t)u * SEQ + 8 * tid + i] = (excl + v[i]) * LOG2E;
                __syncthreads();
            }
        }
        { pg8::Gemm g{(const bf16_t*)(ws + WS_QLAT), (const bf16_t*)(ws + WS_WUQ) + (size_t)l * 768 * 256, MTOK, 768, 256}; pg8::StaticOrder S; S.init(MTOK, 768, G, bx);
          EpiQ E{ws};
          pg8::gemm_phase<EpiQ, pg8::StaticOrder, true, true>(lds, g, S, E, wave_s); }
        __syncthreads();
        { pg8::Gemm g{(const bf16_t*)(ws + WS_KVLAT), (const bf16_t*)(ws + WS_WUKV) + (size_t)l * 1024 * 128, MTOK, 1024, 128}; pg8::StaticOrder S; S.init(MTOK, 1024, G, bx);
          EpiKV E{ws};
          pg8::gemm_phase<EpiKV, pg8::StaticOrder, true, true>(lds, g, S, E, wave_s); }
        GRID_BAR();
        {
            unsigned* ctr = bar + CTR_WORD + 64 * l;
            LAS int* ub = (LAS int*)(lds + 131072 + 64);
            for (;;) {
                const int tq = otid(wave_s);
                __syncthreads();
                if (tq == 0) *ub = (int)__hip_atomic_fetch_add(ctr, 1u, __ATOMIC_RELAXED, __HIP_MEMORY_SCOPE_AGENT);
                __syncthreads();
                const int u = __builtin_amdgcn_readfirstlane(*ub);
                if (u >= 2048) break;
                const int r = u & 1023, qb = 15 - (r >> 6), bh = r & 63;
                if (u < 1024) attn_unit<true>(lds, bh >> 3, bh & 7, qb, ws, wave_s);
                else attn_unit<false>(lds, bh >> 3, bh & 7, qb, ws, wave_s);
            }
        }
        GRID_BAR();
        {
            pg8::Gemm g{(const bf16_t*)(ws + WS_H), (const bf16_t*)(ws + WS_WOUT) + (size_t)l * DM * DM, MTOK, DM, DM}; pg8::StaticOrder S; S.init(MTOK, DM, G, bx);
            EpiOut E{l == 0 ? (const float*)args.in[0] : X, X, MOD + (size_t)l * 8 * 3072 + 2048};
            pg8::gemm_phase<EpiOut, pg8::StaticOrder, true, true>(lds, g, S, E, wave_s);
        }
    }
}

extern "C" void kernel_launch(void* const* d_in, const int* in_sizes, int n_in, void* d_out, int out_size, void* d_ws, size_t ws_size, hipStream_t stream) {
    static int grid = 0;
    if (grid == 0) {
        if (n_in != 14 || out_size != MTOK * DM || ws_size < WS_END) { fprintf(stderr, "kernel_launch: unexpected shapes (n_in %d, out %d, ws %zu)\n", n_in, out_size, ws_size); grid = -1; return; }
        int dev = 0, cus = 0, per_cu = 0;
        (void)hipGetDevice(&dev); (void)hipDeviceGetAttribute(&cus, hipDeviceAttributeMultiprocessorCount, dev);
        (void)hipFuncSetAttribute((const void*)mk_fwd, hipFuncAttributeMaxDynamicSharedMemorySize, LDS_BYTES);
        if (hipOccupancyMaxActiveBlocksPerMultiprocessor(&per_cu, (const void*)mk_fwd, 512, LDS_BYTES) != hipSuccess || per_cu < 1) per_cu = 1;
        (void)hipGetLastError();
        grid = cus * per_cu;
    }
    if (grid < 0) return;
    (void)hipMemsetAsync(d_ws, 0, 16384, stream);
    Args a{};
    for (int i = 0; i < 14; ++i) a.in[i] = d_in[i];
    a.out = (float*)d_out; a.ws = (unsigned char*)d_ws;
    void* kargs[] = {&a};
    hipError_t e = hipLaunchCooperativeKernel((const void*)mk_fwd, dim3(grid), dim3(512), kargs, LDS_BYTES, stream);
    if (e != hipSuccess) fprintf(stderr, "cooperative launch failed: %s (grid %d)\n", hipGetErrorString(e), grid);
}
```

```cpp
#include <hip/hip_runtime.h>
#include <hip/hip_cooperative_groups.h>
#include <cstdio>
#include <cstdint>
#include <cmath>
namespace cg = cooperative_groups;
__device__ __forceinline__ int otid(int wave_s) { int l; asm volatile("v_mbcnt_lo_u32_b32 %0, -1, 0\n\tv_mbcnt_hi_u32_b32 %0, -1, %0" : "=v"(l)); int w = wave_s; asm volatile("" : "+s"(w)); return (w << 6) | l; }
namespace pg8 {
#define PG8_LAS __attribute__((address_space(3)))
typedef unsigned short bf16_t;
typedef short bf16x8 __attribute__((ext_vector_type(8)));
typedef float f32x4 __attribute__((ext_vector_type(4)));
typedef unsigned u32x4 __attribute__((ext_vector_type(4)));
constexpr int BM = 256, BK = 64, HALF = 128, HTB = HALF * BK * 2  , STAGE_BYTES = 8 * HTB, NXCD = 8, WGM = 8;

__host__ __device__ __forceinline__ int lds_byte(int r, int c) { const int st = (r >> 4) * 2 + (c >> 5), rr = r & 15, cc = c & 31, ob = rr * 64 + cc * 2; return st * 1024 + (ob ^ (((ob >> 9) & 1) << 5)); }
__host__ __device__ __forceinline__ void stage_rc(int b, int& R, int& C) { const int st = b / 1024, sb = b % 1024, swz = sb ^ (((sb >> 9) & 1) << 5); R = (st >> 1) * 16 + swz / 64; C = (st & 1) * 32 + (swz % 64) / 2; }
__host__ __device__ __forceinline__ int perm32(int rho) { const int n = rho >> 4, i = rho & 15; return 8 * (i >> 2) + 4 * n + (i & 3); }

struct Unit { int pm, pn; };
struct Gemm { const bf16_t* A; const bf16_t* Bt; int M, N, K; };

struct StaticOrder {
    int nM, nN, nwg, G, c;
    __host__ __device__ void init(int M, int N, int G_, int c_) { nM = M / BM; nN = N / BM; nwg = nM * nN; G = G_; c = c_; }
    __host__ __device__ bool next(int i, Unit& u) const {
        const long L = (long)i * G + c; if (L >= nwg) return false;
        int wgid = (int)L; { const int q = nwg / NXCD, r = nwg % NXCD, xcd = wgid % NXCD, off = wgid / NXCD; wgid = (xcd < r ? xcd * (q + 1) : r * (q + 1) + (xcd - r) * q) + off; }
        const int nig = WGM * nN, gid = wgid / nig, fm = gid * WGM, gsz = (nM - fm) < WGM ? (nM - fm) : WGM;
        u.pm = fm + ((wgid % nig) % gsz); u.pn = (wgid % nig) / gsz; return true;
    }
    __device__ __forceinline__ void a_ready(const Unit&) const {}
    __device__ __forceinline__ void done(const Unit&) const {}
};

__device__ __forceinline__ unsigned cvt_pk_bf16(float lo, float hi) { unsigned r; asm volatile("v_cvt_pk_bf16_f32 %0, %1, %2" : "=v"(r) : "v"(lo), "v"(hi)); return r; }
template <class Epi, class Sched, bool ALIGN_EPI = false, bool SP2 = false>
__device__ __forceinline__ void gemm_phase(PG8_LAS unsigned char* lds, const Gemm g, const Sched& S, const Epi& E, int wave_s) {
    const int tid = otid(wave_s), wid = __builtin_amdgcn_readfirstlane(tid >> 6), lane = tid & 63, wr = wid >> 2, wc = wid & 3, fr = lane & 15, fq = lane >> 4;
    const int K = g.K, nt = K / BK;
    unsigned voffA[2], voffB[2];
#pragma unroll
    for (int i = 0; i < 2; ++i) { int R, C; stage_rc(tid * 16 + i * 8192, R, C); const int Rb = Epi::PERM ? ((R & ~31) + perm32(R & 31)) : R;
        voffA[i] = (unsigned)(R * K + C) * 2u; voffB[i] = (unsigned)(Rb * K + C) * 2u; }
    const size_t kstep = (size_t)(BK * 2);
    const size_t hstep = (size_t)HALF * K * 2;
    const size_t tstep = 2 * hstep;
    const unsigned ldsw = (unsigned)wid * 1024u;
    const int aoff = lds_byte(wr * 64 + fr, fq * 8), boff = lds_byte(wc * 32 + fr, fq * 8);
#define PG8_SA(b, h) (((b) * 2 + (h)) * HTB)
#define PG8_SB(b, h) ((4 + (b) * 2 + (h)) * HTB)
#define PG8_STAGE(bufoff, gbase, voff) do { _Pragma("unroll") for (int _i = 0; _i < 2; ++_i) \
        __builtin_amdgcn_global_load_lds((const unsigned*)((const char*)(gbase) + (voff)[_i]), (PG8_LAS unsigned*)(lds + (bufoff) + ldsw + _i * 8192), 16, 0, 0); } while (0)
#define PG8_LDA(dst, b, h) do { _Pragma("unroll") for (int m = 0; m < 4; ++m) _Pragma("unroll") for (int k = 0; k < 2; ++k) dst[m][k] = *(const PG8_LAS bf16x8*)(lds + PG8_SA(b, h) + aoff + m * 2048 + k * 1024); } while (0)
#define PG8_LDB(dst, b, h) do { _Pragma("unroll") for (int n = 0; n < 2; ++n) _Pragma("unroll") for (int k = 0; k < 2; ++k) dst[n][k] = *(const PG8_LAS bf16x8*)(lds + PG8_SB(b, h) + boff + n * 2048 + k * 1024); } while (0)
#define PG8_MMA(ai, bj, At, Bt) do { __builtin_amdgcn_s_setprio(1); _Pragma("unroll") for (int m = 0; m < 4; ++m) _Pragma("unroll") for (int n = 0; n < 2; ++n) _Pragma("unroll") for (int k = 0; k < 2; ++k) \
        acc[ai][bj][m][n] = __builtin_amdgcn_mfma_f32_16x16x32_bf16(Bt[n][k], At[m][k], acc[ai][bj][m][n], 0, 0, 0); __builtin_amdgcn_s_setprio(0); } while (0)
#define PG8_WAIT_V(n) asm volatile("s_waitcnt vmcnt(" #n ")" ::: "memory")
#define PG8_WAIT_L(n) asm volatile("s_waitcnt lgkmcnt(" #n ")" ::: "memory")
#define PG8_BAR __builtin_amdgcn_s_barrier()
#define PG8_SCHED __builtin_amdgcn_sched_barrier(0)
    Unit cur, nxt; int ui = 0;
    if (!S.next(0, cur)) return;
    f32x4 acc[2][2][4][2];
#pragma unroll
    for (int a = 0; a < 2; ++a)
#pragma unroll
        for (int b = 0; b < 2; ++b)
#pragma unroll
            for (int m = 0; m < 4; ++m)
#pragma unroll
                for (int n = 0; n < 2; ++n) acc[a][b][m][n] = (f32x4){0.f, 0.f, 0.f, 0.f};
    bf16x8 At[4][2], B0[2][2], B1[2][2];
    const char* cA = (const char*)g.A + (size_t)cur.pm * tstep; const char* cB = (const char*)g.Bt + (size_t)cur.pn * tstep;
    S.a_ready(cur);
    if constexpr (SP2) {
        PG8_STAGE(PG8_SB(0, 0), cB, voffB); PG8_STAGE(PG8_SB(0, 1), cB + hstep, voffB); PG8_STAGE(PG8_SA(0, 0), cA, voffA); PG8_STAGE(PG8_SA(0, 1), cA + hstep, voffA);
        if (wr == 1) PG8_BAR;
        PG8_WAIT_V(2); PG8_BAR;
        PG8_STAGE(PG8_SB(1, 0), cB + kstep, voffB); PG8_STAGE(PG8_SA(1, 0), cA + kstep, voffA); PG8_STAGE(PG8_SB(1, 1), cB + hstep + kstep, voffB);
        PG8_WAIT_V(6); PG8_BAR;
    } else {
        PG8_STAGE(PG8_SB(0, 0), cB, voffB); PG8_STAGE(PG8_SA(0, 0), cA, voffA); PG8_STAGE(PG8_SB(0, 1), cB + hstep, voffB); PG8_STAGE(PG8_SA(0, 1), cA + hstep, voffA);
        if (wr == 1) PG8_BAR;
        PG8_WAIT_V(4); PG8_BAR;
        PG8_STAGE(PG8_SB(1, 0), cB + kstep, voffB); PG8_STAGE(PG8_SA(1, 0), cA + kstep, voffA); PG8_STAGE(PG8_SB(1, 1), cB + hstep + kstep, voffB);
        PG8_WAIT_V(6); PG8_BAR;
    }
    for (;;) {
        const bool has_next = S.next(ui + 1, nxt);
        const char* nA = has_next ? (const char*)g.A + (size_t)nxt.pm * tstep : cA; const char* nB = has_next ? (const char*)g.Bt + (size_t)nxt.pn * tstep : cB;
        for (int t = 0; t < nt; t += 2) {
            const bool last = (t == nt - 2);
            const char* a1 = cA + (size_t)(t + 1) * kstep;
            const char* a2 = last ? nA : cA + (size_t)(t + 2) * kstep; const char* b2 = last ? nB : cB + (size_t)(t + 2) * kstep;
            const char* a3 = a2 + kstep; const char* b3 = b2 + kstep;
            if (last && has_next) S.a_ready(nxt);
            if constexpr (SP2) {
            PG8_LDB(B0, 0, 0); PG8_LDB(B1, 0, 1); PG8_SCHED; PG8_LDA(At, 0, 0); PG8_STAGE(PG8_SA(1, 1), a1 + hstep, voffA);
            PG8_WAIT_V(8); PG8_WAIT_L(0); PG8_BAR; PG8_MMA(0, 0, At, B0); PG8_MMA(0, 1, At, B1); PG8_BAR; PG8_SCHED;
            PG8_LDA(At, 0, 1); PG8_STAGE(PG8_SB(0, 0), b2, voffB); PG8_STAGE(PG8_SB(0, 1), b2 + hstep, voffB); PG8_STAGE(PG8_SA(0, 0), a2, voffA);
            PG8_WAIT_V(8); PG8_WAIT_L(0); PG8_BAR; PG8_MMA(1, 0, At, B0); PG8_MMA(1, 1, At, B1); PG8_BAR; PG8_SCHED;
            PG8_LDB(B0, 1, 0); PG8_LDB(B1, 1, 1); PG8_SCHED; PG8_LDA(At, 1, 0); PG8_STAGE(PG8_SA(0, 1), a2 + hstep, voffA);
            PG8_WAIT_V(8); PG8_WAIT_L(0); PG8_BAR; PG8_MMA(0, 0, At, B0); PG8_MMA(0, 1, At, B1); PG8_BAR; PG8_SCHED;
            PG8_LDA(At, 1, 1); PG8_STAGE(PG8_SB(1, 0), b3, voffB); PG8_STAGE(PG8_SB(1, 1), b3 + hstep, voffB); PG8_STAGE(PG8_SA(1, 0), a3, voffA);
            PG8_WAIT_V(8); PG8_WAIT_L(0); PG8_BAR; PG8_MMA(1, 0, At, B0); PG8_MMA(1, 1, At, B1); PG8_BAR; PG8_SCHED;
            } else {
            PG8_LDB(B0, 0, 0); PG8_SCHED; PG8_LDA(At, 0, 0); PG8_STAGE(PG8_SA(1, 1), a1 + hstep, voffA);
            PG8_WAIT_L(8); PG8_BAR; PG8_WAIT_L(0); PG8_MMA(0, 0, At, B0); PG8_BAR; PG8_SCHED;
            PG8_LDB(B1, 0, 1); PG8_STAGE(PG8_SB(0, 0), b2, voffB);
            PG8_BAR; PG8_WAIT_L(0); PG8_MMA(0, 1, At, B1); PG8_BAR;
            PG8_LDA(At, 0, 1); PG8_STAGE(PG8_SA(0, 0), a2, voffA);
            PG8_BAR; PG8_WAIT_L(0); PG8_MMA(1, 0, At, B0); PG8_BAR; PG8_SCHED;
            PG8_STAGE(PG8_SB(0, 1), b2 + hstep, voffB);
            PG8_WAIT_V(6); PG8_BAR; PG8_MMA(1, 1, At, B1); PG8_BAR;
            PG8_LDB(B0, 1, 0); PG8_SCHED; PG8_LDA(At, 1, 0); PG8_STAGE(PG8_SA(0, 1), a2 + hstep, voffA);
            PG8_WAIT_L(8); PG8_BAR; PG8_WAIT_L(0); PG8_MMA(0, 0, At, B0); PG8_BAR; PG8_SCHED;
            PG8_LDB(B1, 1, 1); PG8_STAGE(PG8_SB(1, 0), b3, voffB);
            PG8_BAR; PG8_WAIT_L(0); PG8_MMA(0, 1, At, B1); PG8_BAR;
            PG8_LDA(At, 1, 1); PG8_STAGE(PG8_SA(1, 0), a3, voffA);
            PG8_BAR; PG8_WAIT_L(0); PG8_MMA(1, 0, At, B0); PG8_BAR; PG8_SCHED;
            PG8_STAGE(PG8_SB(1, 1), b3 + hstep, voffB);
            PG8_WAIT_V(6); PG8_BAR; PG8_MMA(1, 1, At, B1); PG8_BAR;
            }
        }
        if constexpr (ALIGN_EPI) { if (wr == 0) PG8_BAR; }
        if constexpr (!Epi::AFTER_DRAIN) { int fr2 = fr, fq2 = fq; asm volatile("" : "+v"(fr2), "+v"(fq2)); E(acc, cur, wr, wc, fr2, fq2); S.done(cur); }
        if (!has_next) break;
#pragma unroll
        for (int a = 0; a < 2; ++a)
#pragma unroll
            for (int b = 0; b < 2; ++b)
#pragma unroll
                for (int m = 0; m < 4; ++m)
#pragma unroll
                    for (int n = 0; n < 2; ++n) acc[a][b][m][n] = (f32x4){0.f, 0.f, 0.f, 0.f};
        cur = nxt; cA = nA; cB = nB; ++ui;
        if constexpr (ALIGN_EPI) { if (wr == 1) PG8_BAR; }
    }
    PG8_WAIT_V(0);
    if constexpr (!ALIGN_EPI) { if (wr == 0) PG8_BAR; }
    PG8_BAR;
    if constexpr (Epi::AFTER_DRAIN) { E.fused(acc, cur, wr, wc, fr, fq, lds, wid, lane); S.done(cur); }
#undef PG8_SA
#undef PG8_SB
#undef PG8_STAGE
#undef PG8_LDA
#undef PG8_LDB
#undef PG8_MMA
#undef PG8_WAIT_V
#undef PG8_WAIT_L
#undef PG8_BAR
#undef PG8_SCHED
}
}

#define LAS __attribute__((address_space(3)))
typedef unsigned short bf16_t;
typedef short bf16x8 __attribute__((ext_vector_type(8)));
typedef float f32x4 __attribute__((ext_vector_type(4)));
typedef float f32x16 __attribute__((ext_vector_type(16)));
typedef unsigned u32x4 __attribute__((ext_vector_type(4)));
typedef unsigned u32x2 __attribute__((ext_vector_type(2)));
typedef short v4i16_t __attribute__((ext_vector_type(4)));

constexpr int NB = 8, SEQ = 4096, DM = 1024, DEPTH = 4, MTOK = NB * SEQ, NIN = 2984, NINP = 3072;
constexpr float EPS_ = 1e-6f, LOG2E = 1.4426950408889634f;
constexpr float C2F = 0.125f * LOG2E;
constexpr float C2M = 0.10206207261596575f * LOG2E;
constexpr int LDS_BYTES = 132096;

constexpr size_t MiB = 1u << 20;
constexpr size_t WS_WIN = 2 * MiB, WS_WOUT = 26 * MiB, WS_WUQ = 34 * MiB, WS_WUKV = 36 * MiB, WS_MOD = 37 * MiB, WS_COS = 38 * MiB, WS_SIN = 40 * MiB,
                 WS_LOGF = 42 * MiB, WS_CUM = 43 * MiB, WS_SSQQ = 44 * MiB, WS_SSQK = 45 * MiB, WS_H = 48 * MiB, WS_QF = 112 * MiB, WS_KF = 144 * MiB,
                 WS_VF = 176 * MiB, WS_GATE = 208 * MiB, WS_QLAT = 272 * MiB, WS_KVLAT = 288 * MiB, WS_KR = 296 * MiB, WS_QM = 298 * MiB, WS_KM = 346 * MiB,
                 WS_VM = 378 * MiB, WS_END = 410 * MiB;
constexpr size_t WS_SB = 47 * MiB;
constexpr int CTR_WORD = 3500;

__device__ __forceinline__ unsigned f2bf(float f) { unsigned u = __builtin_bit_cast(unsigned, f); return (u + 0x7fffu + ((u >> 16) & 1u)) >> 16; }
typedef float f32x2_t __attribute__((ext_vector_type(2))); typedef __bf16 bf16x2_t __attribute__((ext_vector_type(2)));
__device__ __forceinline__ unsigned cvtpk_s(float lo, float hi) { f32x2_t v = {lo, hi}; bf16x2_t b = __builtin_convertvector(v, bf16x2_t); return __builtin_bit_cast(unsigned, b); }
__device__ __forceinline__ unsigned pk2(float lo, float hi) { return cvtpk_s(lo, hi); }
__device__ __forceinline__ float bf2f(bf16_t v) { return __builtin_bit_cast(float, (unsigned)v << 16); }
__device__ __forceinline__ u32x2 pk4(f32x4 v) { u32x2 w; w.x = pk2(v[0], v[1]); w.y = pk2(v[2], v[3]); return w; }
__device__ __forceinline__ float silu_f(float v) { return v * __builtin_amdgcn_rcpf(1.f + __builtin_amdgcn_exp2f(-1.4426950408889634f * v)); }
__device__ __forceinline__ f32x4 silu4(f32x4 v) { return (f32x4){silu_f(v[0]), silu_f(v[1]), silu_f(v[2]), silu_f(v[3])}; }
__device__ __forceinline__ float logsig_f(float x) { return fminf(x, 0.f) - log1pf(expf(-fabsf(x))); }
__device__ __forceinline__ float shx(float v, int mask, int lane) { return __builtin_bit_cast(float, __builtin_amdgcn_ds_bpermute((lane ^ mask) << 2, __builtin_bit_cast(int, v))); }
__device__ __forceinline__ float shup(float v, int off, int lane) { return __builtin_bit_cast(float, __builtin_amdgcn_ds_bpermute(((lane - off) & 63) << 2, __builtin_bit_cast(int, v))); }
__device__ __forceinline__ float wave_sum(float v, int lane) {
#pragma unroll
    for (int o = 1; o < 64; o <<= 1) v += shx(v, o, lane);
    return v;
}
#define LDS_WAIT() asm volatile("s_waitcnt lgkmcnt(0)" ::: "memory")


#define XB_TMO      128
#define XB_XCNT(j)  (256  + 64 * (j))
#define XB_XSUB(j)  (1280 + 64 * (j))
#define XB_XGEN(j)  (2304 + 64 * (j))
#define XB_TOP      3328
#define XB_TOPGEN   3392
#define XCD_BAR_WORDS 3456
#define XB_SPIN_CAP (1u << 18)
__device__ __forceinline__ unsigned xb_ld(unsigned* p)              { return __hip_atomic_load(p, __ATOMIC_RELAXED, __HIP_MEMORY_SCOPE_AGENT); }
__device__ __forceinline__ unsigned xb_add(unsigned* p, unsigned v) { return __hip_atomic_fetch_add(p, v, __ATOMIC_RELAXED, __HIP_MEMORY_SCOPE_AGENT); }
__device__ __forceinline__ unsigned xb_xcc_id() { return (unsigned)__builtin_amdgcn_s_getreg((3 << 11) | 20) & 0xFu; }
#define XB_SPIN(cond, bar) do { unsigned _sp = 0; while (cond) { __builtin_amdgcn_s_sleep(1); \
    if ((++_sp & 255u) == 0u) { if (xb_ld(&(bar)[XB_TMO])) break; if (_sp > XB_SPIN_CAP) { atomicAdd(&(bar)[XB_TMO], 1u); break; } } } } while (0)
__device__ __forceinline__ void xcd_barrier_complete(unsigned* bar, unsigned x, unsigned& nloc, unsigned& nx) {
    const unsigned G = gridDim.x * gridDim.y * gridDim.z;
    unsigned sum, cnt, mine, sp = 0u;
    for (;;) {
        sum = 0u; cnt = 0u; mine = 0u;
#pragma unroll
        for (unsigned j = 0; j < 16; ++j) { const unsigned c = xb_ld(&bar[XB_XCNT(j)]); sum += c; cnt += (c > 0u) ? 1u : 0u; mine = (j == x) ? c : mine; }
        if (sum == G) break;
        __builtin_amdgcn_s_sleep(1);
        if ((++sp & 255u) == 0u) { if (xb_ld(&bar[XB_TMO])) break; if (sp > XB_SPIN_CAP) { atomicAdd(&bar[XB_TMO], 1u); break; } }
    }
    nloc = mine > 0u ? mine : 1u; nx = cnt > 0u ? cnt : 1u;
}
__device__ __forceinline__ void xcd_barrier(unsigned* bar, volatile LAS unsigned* st, int tid) {
    asm volatile("s_waitcnt vmcnt(0)" ::: "memory");
    __syncthreads();
    if (tid == 0) {
        const unsigned x = xb_xcc_id();
        __builtin_amdgcn_s_waitcnt(0);
        unsigned nloc = st[0], nx = st[1];
        if (nloc == 0u) { xcd_barrier_complete(bar, x, nloc, nx); st[0] = nloc; st[1] = nx; }
        const unsigned old = xb_add(&bar[XB_XSUB(x)], 1u);
        const unsigned gen = old / nloc;
        if (old + 1u == (gen + 1u) * nloc) {
            __builtin_amdgcn_fence(__ATOMIC_RELEASE, "agent");
            asm volatile("s_waitcnt vmcnt(0)" ::: "memory");
            const unsigned og = xb_add(&bar[XB_TOP], 1u);
            const unsigned tg = og / nx;
            if (og + 1u == (tg + 1u) * nx) xb_add(&bar[XB_TOPGEN], 1u);
            else XB_SPIN(xb_ld(&bar[XB_TOPGEN]) == tg, bar);
            __builtin_amdgcn_fence(__ATOMIC_ACQUIRE, "agent");
            xb_add(&bar[XB_XGEN(x)], 1u);
            asm volatile("s_waitcnt vmcnt(0)" ::: "memory");
        } else {
            XB_SPIN(xb_ld(&bar[XB_XGEN(x)]) == gen, bar);
            __builtin_amdgcn_fence(__ATOMIC_ACQUIRE, "agent");
            asm volatile("s_waitcnt vmcnt(0)" ::: "memory");
        }
    }
    __syncthreads();
}

using pg8::Unit;
struct EpiIn {
    static constexpr bool PERM = false, AFTER_DRAIN = false;
    unsigned char* ws; const float* BF;
    __device__ __forceinline__ void operator()(const f32x4 (&acc)[2][2][4][2], const Unit& u, int wr, int wc, int fr, int fq) const {
        const int row0 = u.pm * 256 + wr * 64 + fr;
        bf16_t* QF = (bf16_t*)(ws + WS_QF); bf16_t* GATE = (bf16_t*)(ws + WS_GATE); bf16_t* QLAT = (bf16_t*)(ws + WS_QLAT); bf16_t* KVLAT = (bf16_t*)(ws + WS_KVLAT); bf16_t* KR = (bf16_t*)(ws + WS_KR);
        float* LOGF = (float*)(ws + WS_LOGF); float* SSQQ = (float*)(ws + WS_SSQQ); float* SSQK = (float*)(ws + WS_SSQK); const float* COS = (const float*)(ws + WS_COS); const float* SIN = (const float*)(ws + WS_SIN);
        if (u.pn == 8) {
#pragma unroll
            for (int ai = 0; ai < 2; ++ai)
#pragma unroll
                for (int m = 0; m < 4; ++m) {
                    float s = 0.f;
#pragma unroll
                    for (int bj = 0; bj < 2; ++bj)
#pragma unroll
                        for (int n = 0; n < 2; ++n) { const f32x4 x = acc[ai][bj][m][n]; s += (x[0] * x[0] + x[1] * x[1]) + (x[2] * x[2] + x[3] * x[3]); }
                    s += shx(s, 16, fq * 16 + fr); s += shx(s, 32, fq * 16 + fr);
                    if (fq == 0) SSQQ[(size_t)(row0 + ai * 128 + m * 16) * 4 + wc] = s;
                }
        } else if (u.pn == 9) {
#pragma unroll
            for (int ai = 0; ai < 2; ++ai)
#pragma unroll
                for (int m = 0; m < 4; ++m) {
                    float s = 0.f;
#pragma unroll
                    for (int n = 0; n < 2; ++n) { const f32x4 x = acc[ai][0][m][n]; s += (x[0] * x[0] + x[1] * x[1]) + (x[2] * x[2] + x[3] * x[3]); }
                    s += shx(s, 16, fq * 16 + fr); s += shx(s, 32, fq * 16 + fr);
                    if (fq == 0) SSQK[(size_t)(row0 + ai * 128 + m * 16) * 4 + wc] = s;
                }
        }
#pragma unroll
        for (int bj = 0; bj < 2; ++bj) {
            const int gcol = u.pn * 256 + bj * 128 + wc * 32;
            if (gcol < 1536) {
                const int seg = gcol >> 9; bf16_t* base = QF + (size_t)seg * ((WS_KF - WS_QF) / 2); const float sc = seg == 0 ? C2F : 1.f; const int c0 = (gcol & 511) + 4 * fq;
#pragma unroll
                for (int ai = 0; ai < 2; ++ai)
#pragma unroll
                    for (int m = 0; m < 4; ++m) { bf16_t* rp = base + (size_t)(row0 + ai * 128 + m * 16) * 512 + c0;
#pragma unroll
                        for (int n = 0; n < 2; ++n) *(u32x2*)(rp + 16 * n) = pk4(acc[ai][bj][m][n] * sc); }
                if (seg < 2) {
                    const int ln = fq * 16 + fr; float mx = 0.f;
#pragma unroll
                    for (int ai = 0; ai < 2; ++ai)
#pragma unroll
                        for (int m = 0; m < 4; ++m) { const f32x4 a = acc[ai][bj][m][0] * sc, c = acc[ai][bj][m][1] * sc;
                            float s = ((a[0] * a[0] + a[1] * a[1]) + (a[2] * a[2] + a[3] * a[3])) + ((c[0] * c[0] + c[1] * c[1]) + (c[2] * c[2] + c[3] * c[3]));
                            s += shx(s, 16, ln); s += shx(s, 32, ln); mx = fmaxf(mx, s); }
                    mx = fmaxf(mx, shx(mx, 1, ln)); mx = fmaxf(mx, shx(mx, 2, ln)); mx = fmaxf(mx, shx(mx, 4, ln)); mx = fmaxf(mx, shx(mx, 8, ln));
                    if (ln == 0) __hip_atomic_fetch_max((unsigned*)(ws + WS_SB) + ((((u.pm * 256) >> 12) * 8 + ((gcol & 511) >> 6)) * 2 + seg) * 2 + ((gcol >> 5) & 1), __builtin_bit_cast(unsigned, mx), __ATOMIC_RELAXED, __HIP_MEMORY_SCOPE_AGENT);
                }
            } else if (gcol < 2048 || (gcol >= 2464 && gcol < 2976)) {
                const int c0 = (gcol < 2048 ? gcol - 1536 : gcol - 2464 + 512) + 4 * fq;
#pragma unroll
                for (int ai = 0; ai < 2; ++ai)
#pragma unroll
                    for (int m = 0; m < 4; ++m) { bf16_t* rp = GATE + (size_t)(row0 + ai * 128 + m * 16) * 1024 + c0;
#pragma unroll
                        for (int n = 0; n < 2; ++n) *(u32x2*)(rp + 16 * n) = pk4(silu4(acc[ai][bj][m][n])); }
            } else if (gcol < 2304) {
                const int c0 = gcol - 2048 + 4 * fq;
#pragma unroll
                for (int ai = 0; ai < 2; ++ai)
#pragma unroll
                    for (int m = 0; m < 4; ++m) { bf16_t* rp = QLAT + (size_t)(row0 + ai * 128 + m * 16) * 256 + c0;
#pragma unroll
                        for (int n = 0; n < 2; ++n) *(u32x2*)(rp + 16 * n) = pk4(acc[ai][bj][m][n]); }
            } else if (gcol < 2432) {
                const int c0 = gcol - 2304 + 4 * fq;
#pragma unroll
                for (int ai = 0; ai < 2; ++ai)
#pragma unroll
                    for (int m = 0; m < 4; ++m) { bf16_t* rp = KVLAT + (size_t)(row0 + ai * 128 + m * 16) * 128 + c0;
#pragma unroll
                        for (int n = 0; n < 2; ++n) *(u32x2*)(rp + 16 * n) = pk4(acc[ai][bj][m][n]); }
            } else if (gcol < 2464) {
#pragma unroll
                for (int ai = 0; ai < 2; ++ai)
#pragma unroll
                    for (int m = 0; m < 4; ++m) { const size_t row = (size_t)(row0 + ai * 128 + m * 16);
                        const f32x4 cs = *(const f32x4*)(COS + row * 16 + 4 * fq), sn = *(const f32x4*)(SIN + row * 16 + 4 * fq);
                        const f32x4 t1 = acc[ai][bj][m][0], t2 = acc[ai][bj][m][1];
                        const f32x4 o1 = t1 * cs - t2 * sn, o2 = t2 * cs + t1 * sn;
                        bf16_t* rp = KR + row * 32 + 4 * fq; *(u32x2*)(rp) = pk4(o1); *(u32x2*)(rp + 16) = pk4(o2); if (m & 1) asm volatile("" ::: "memory"); }
            } else if (gcol == 2976) {
                if (fq < 2) {
                    const f32x4 bfv = *(const f32x4*)(BF + 4 * fq);
#pragma unroll
                    for (int ai = 0; ai < 2; ++ai)
#pragma unroll
                        for (int m = 0; m < 4; ++m) { const size_t row = (size_t)(row0 + ai * 128 + m * 16); const f32x4 v = acc[ai][bj][m][0] + bfv;
                            *(f32x4*)(LOGF + row * 8 + 4 * fq) = (f32x4){logsig_f(v[0]), logsig_f(v[1]), logsig_f(v[2]), logsig_f(v[3])}; }
                }
            }
        }
    }
};
struct EpiQ {
    static constexpr bool PERM = false, AFTER_DRAIN = false;
    unsigned char* ws;
    __device__ __forceinline__ void operator()(const f32x4 (&acc)[2][2][4][2], const Unit& u, int wr, int wc, int fr, int fq) const {
        const int row0 = u.pm * 256 + wr * 64 + fr;
        const float* SSQ = (const float*)(ws + WS_SSQQ); const float* COS = (const float*)(ws + WS_COS); const float* SIN = (const float*)(ws + WS_SIN); bf16_t* QM = (bf16_t*)(ws + WS_QM);
        float rs[2][4];
#pragma unroll
        for (int ai = 0; ai < 2; ++ai)
#pragma unroll
            for (int m = 0; m < 4; ++m) { const f32x4 s = *(const f32x4*)(SSQ + (size_t)(row0 + ai * 128 + m * 16) * 4); rs[ai][m] = rsqrtf(((s[0] + s[1]) + (s[2] + s[3])) * (1.f / 256.f) + EPS_) * C2M; }
#pragma unroll
        for (int bj = 0; bj < 2; ++bj) {
            const int gcol = u.pn * 256 + bj * 128 + wc * 32; const bool rope = ((gcol >> 5) % 3) == 2;
#pragma unroll
            for (int ai = 0; ai < 2; ++ai)
#pragma unroll
                for (int m = 0; m < 4; ++m) { const size_t row = (size_t)(row0 + ai * 128 + m * 16);
                    f32x4 v0 = acc[ai][bj][m][0] * rs[ai][m], v1 = acc[ai][bj][m][1] * rs[ai][m];
                    if (rope) { const f32x4 cs = *(const f32x4*)(COS + row * 16 + 4 * fq), sn = *(const f32x4*)(SIN + row * 16 + 4 * fq);
                        const f32x4 o1 = v0 * cs - v1 * sn, o2 = v1 * cs + v0 * sn; v0 = o1; v1 = o2; }
                    bf16_t* rp = QM + row * 768 + gcol + 4 * fq; *(u32x2*)(rp) = pk4(v0); *(u32x2*)(rp + 16) = pk4(v1); if (m & 1) asm volatile("" ::: "memory"); }
        }
    }
};
struct EpiKV {
    static constexpr bool PERM = false, AFTER_DRAIN = false;
    unsigned char* ws;
    __device__ __forceinline__ void operator()(const f32x4 (&acc)[2][2][4][2], const Unit& u, int wr, int wc, int fr, int fq) const {
        const int row0 = u.pm * 256 + wr * 64 + fr;
        const float* SSQ = (const float*)(ws + WS_SSQK); bf16_t* KM = (bf16_t*)(ws + WS_KM);
        float rs[2][4];
#pragma unroll
        for (int ai = 0; ai < 2; ++ai)
#pragma unroll
            for (int m = 0; m < 4; ++m) { const f32x4 s = *(const f32x4*)(SSQ + (size_t)(row0 + ai * 128 + m * 16) * 4); rs[ai][m] = rsqrtf(((s[0] + s[1]) + (s[2] + s[3])) * (1.f / 128.f) + EPS_); }
#pragma unroll
        for (int bj = 0; bj < 2; ++bj) {
            const int gcol = u.pn * 256 + bj * 128 + wc * 32; const int head = gcol >> 7, within = gcol & 127;
            bf16_t* base = KM + (within < 64 ? (size_t)0 : (size_t)((WS_VM - WS_KM) / 2)); const int c0 = head * 64 + (within & 63) + 4 * fq;
#pragma unroll
            for (int ai = 0; ai < 2; ++ai)
#pragma unroll
                for (int m = 0; m < 4; ++m) { bf16_t* rp = base + (size_t)(row0 + ai * 128 + m * 16) * 512 + c0;
#pragma unroll
                    for (int n = 0; n < 2; ++n) *(u32x2*)(rp + 16 * n) = pk4(acc[ai][bj][m][n] * rs[ai][m]); }
        }
    }
};
struct EpiOut {
    static constexpr bool PERM = false, AFTER_DRAIN = false;
    const float* XIN; float* XOUT; const float* MODG;
    __device__ __forceinline__ void operator()(const f32x4 (&acc)[2][2][4][2], const Unit& u, int wr, int wc, int fr, int fq) const {
        const int row0 = u.pm * 256 + wr * 64 + fr; const int b = (u.pm * 256) >> 12;
#pragma unroll
        for (int bj = 0; bj < 2; ++bj) {
            const int col = u.pn * 256 + bj * 128 + wc * 32 + 4 * fq;
            const f32x4 g0 = *(const f32x4*)(MODG + (size_t)b * 3072 + col), g1 = *(const f32x4*)(MODG + (size_t)b * 3072 + col + 16);
            f32x4 xi[2][4][2];
#pragma unroll
            for (int ai = 0; ai < 2; ++ai)
#pragma unroll
                for (int m = 0; m < 4; ++m) { const size_t off = (size_t)(row0 + ai * 128 + m * 16) * 1024 + col; xi[ai][m][0] = *(const f32x4*)(XIN + off); xi[ai][m][1] = *(const f32x4*)(XIN + off + 16); }
#pragma unroll
            for (int ai = 0; ai < 2; ++ai)
#pragma unroll
                for (int m = 0; m < 4; ++m) { const size_t off = (size_t)(row0 + ai * 128 + m * 16) * 1024 + col;
                    *(f32x4*)(XOUT + off) = xi[ai][m][0] + g0 * acc[ai][bj][m][0]; *(f32x4*)(XOUT + off + 16) = xi[ai][m][1] + g1 * acc[ai][bj][m][1]; }
            asm volatile("" ::: "memory");
        }
    }
};

__device__ __forceinline__ int crow(int r, int hi) { return (r & 3) + 8 * (r >> 2) + 4 * hi; }
__device__ __forceinline__ bf16x8 vtr2(const LAS unsigned char* p) {
    const v4i16_t lo = __builtin_amdgcn_ds_read_tr16_b64_v4i16((LAS v4i16_t*)p), hi = __builtin_amdgcn_ds_read_tr16_b64_v4i16((LAS v4i16_t*)(p + 512));
    return (bf16x8){lo[0], lo[1], lo[2], lo[3], hi[0], hi[1], hi[2], hi[3]};
}
constexpr int AT_KBUF = 13312, AT_OFF_V = 2 * AT_KBUF, AT_OFF_CK = AT_OFF_V + 2 * 8192, AT_OFF_WS = AT_OFF_CK + 512;

template <bool MLA>
__device__ __forceinline__ void attn_unit(LAS unsigned char* lds, int b, int h, int qb, unsigned char* ws, int wave_s) {
    constexpr int DQK = MLA ? 96 : 64, NDS = DQK / 16, KROW = MLA ? 208 : 144, QP = MLA ? 768 : 512;
    const bf16_t* Q = (const bf16_t*)(ws + (MLA ? WS_QM : WS_QF)); const bf16_t* K = (const bf16_t*)(ws + (MLA ? WS_KM : WS_KF)); const bf16_t* V = (const bf16_t*)(ws + (MLA ? WS_VM : WS_VF));
    const bf16_t* KRp = (const bf16_t*)(ws + WS_KR); const float* CUM = (const float*)(ws + WS_CUM); const bf16_t* GATE = (const bf16_t*)(ws + WS_GATE); bf16_t* Y = (bf16_t*)(ws + WS_H);
    const int tid = otid(wave_s), lane = tid & 63, r32 = lane & 31, hi = lane >> 5; const int wid = __builtin_amdgcn_readfirstlane(tid >> 6);
    const int par = 0;
    const int q0 = qb * 256, qw0 = q0 + wid * 32; const size_t rowbase = (size_t)b * SEQ;
    const int NT = q0 / 64 + 4;
    bf16x8 qr[NDS];
    { const bf16_t* qp = Q + (rowbase + qw0 + r32) * QP + h * DQK + hi * 8;
#pragma unroll
      for (int ds = 0; ds < NDS; ++ds) qr[ds] = *(const bf16x8*)(qp + ds * 16); }
    int t0 = 0;
    if (!MLA) {
        LAS int* tb = (LAS int*)(lds + AT_OFF_WS);
        if (wid == 0) {
            const unsigned* SB = (const unsigned*)(ws + WS_SB) + (size_t)(b * 8 + h) * 4;
            const float sb = sqrtf(__builtin_bit_cast(float, SB[0]) + __builtin_bit_cast(float, SB[1])) * sqrtf(__builtin_bit_cast(float, SB[2]) + __builtin_bit_cast(float, SB[3])) * 1.02f + 1.0f;
            const float* cb_ = CUM + (size_t)(b * 8 + h) * SEQ; const float c0 = cb_[q0];
            float Bd = -1e30f; if (lane < NT) Bd = 2.f * sb + c0 - cb_[64 * lane + 63];
            const unsigned long long mk = __ballot(Bd >= -64.f);
            int tmin = mk ? (int)__builtin_ctzll(mk) : 0;
            tmin &= ~1; if (tmin > NT - 4) tmin = NT - 4;
            if (lane == 0) *tb = tmin;
        }
        __syncthreads();
        t0 = __builtin_amdgcn_readfirstlane(*tb);
    }
    const int krow = tid >> 3, kch = tid & 7;
    const bf16_t* kgu = K + rowbase * 512 + h * 64; const unsigned koff = (unsigned)(krow * 512 + kch * 8); const int kdst = krow * KROW + kch * 16;
    const bf16_t* krgu = KRp + rowbase * 32; const unsigned kroff = (unsigned)((tid >> 2) * 32 + (tid & 3) * 8); const int krdst = (tid >> 2) * KROW + 128 + (tid & 3) * 16;
    const int vdh = tid >> 8, vrow = (tid >> 2) & 63, vc4 = tid & 3;
    const bf16_t* vgu = V + rowbase * 512 + h * 64; const unsigned voff = (unsigned)(vrow * 512 + vdh * 32 + vc4 * 8); const int vdst = AT_OFF_V + vdh * 4096 + vrow * 64 + vc4 * 16;
    const float* ckgu = CUM + (size_t)(b * 8 + h) * SEQ; const unsigned ckoff = (unsigned)(tid & 63);
    u32x4 kreg, krreg = (u32x4){0u, 0u, 0u, 0u}, vreg; float ckreg = 0.f;
#define AT_LOADK(t) do { kreg = *(const u32x4*)(kgu + (size_t)(t) * 64 * 512 + koff); \
        if (MLA) { if (tid < 256) krreg = *(const u32x4*)(krgu + (size_t)(t) * 64 * 32 + kroff); } else { if (tid < 64) ckreg = -ckgu[(size_t)(t) * 64 + ckoff]; } } while (0)
#define AT_STOREK(bf) do { *(LAS u32x4*)(lds + (bf) * AT_KBUF + kdst) = kreg; \
        if (MLA) { if (tid < 256) *(LAS u32x4*)(lds + (bf) * AT_KBUF + krdst) = krreg; } else { if (tid < 64) *(LAS float*)(lds + AT_OFF_CK + (bf) * 256 + tid * 4) = ckreg; } } while (0)
#define AT_LOADV(t) do { vreg = *(const u32x4*)(vgu + (size_t)(t) * 64 * 512 + voff); } while (0)
#define AT_STOREV(bf) do { *(LAS u32x4*)(lds + (bf) * 8192 + vdst) = vreg; } while (0)
    float mhat = -1e30f, lsum = 0.f; f32x16 o0 = {}, o1 = {};
    const int vb = AT_OFF_V + ((lane >> 4) & 1) * 32 + (lane & 3) * 8 + (4 * hi + ((lane & 15) >> 2)) * 64;
#define AT_QK(P0, P1, t_, MASKOK) do { const int bf_ = (t_) & 1; \
        if (!MLA) { _Pragma("unroll") for (int g = 0; g < 4; ++g) { const f32x4 c0 = *(const LAS f32x4*)(lds + AT_OFF_CK + bf_ * 256 + (8 * g + 4 * hi) * 4), c1 = *(const LAS f32x4*)(lds + AT_OFF_CK + bf_ * 256 + (32 + 8 * g + 4 * hi) * 4); \
                _Pragma("unroll") for (int e = 0; e < 4; ++e) { P0[4 * g + e] = c0[e]; P1[4 * g + e] = c1[e]; } } } \
        else { P0 = (f32x16){}; P1 = (f32x16){}; } \
        const LAS unsigned char* kb_ = lds + bf_ * AT_KBUF + r32 * KROW + hi * 16; \
        _Pragma("unroll") for (int ds = 0; ds < NDS; ++ds) { \
            const bf16x8 kf0 = *(const LAS bf16x8*)(kb_ + ds * 32), kf1 = *(const LAS bf16x8*)(kb_ + 32 * KROW + ds * 32); \
            P0 = __builtin_amdgcn_mfma_f32_32x32x16_bf16(kf0, qr[ds], P0, 0, 0, 0); \
            P1 = __builtin_amdgcn_mfma_f32_32x32x16_bf16(kf1, qr[ds], P1, 0, 0, 0); } \
        if (MASKOK && !MLA && (t_) * 64 + 63 > qw0) { const int q_ = qw0 + r32; \
            _Pragma("unroll") for (int r = 0; r < 16; ++r) { const int kv = (t_) * 64 + crow(r, hi); if (kv > q_) P0[r] = -INFINITY; if (kv + 32 > q_) P1[r] = -INFINITY; } } } while (0)
#define AT_QKF(P0, P1, t_, MASKOK) do { const int bf_ = (t_) & 1; \
        if (!MLA) { _Pragma("unroll") for (int g = 0; g < 4; ++g) { const f32x4 c0 = *(const LAS f32x4*)(lds + AT_OFF_CK + bf_ * 256 + (8 * g + 4 * hi) * 4), c1 = *(const LAS f32x4*)(lds + AT_OFF_CK + bf_ * 256 + (32 + 8 * g + 4 * hi) * 4); \
                _Pragma("unroll") for (int e = 0; e < 4; ++e) { P0[4 * g + e] = c0[e]; P1[4 * g + e] = c1[e]; } } } \
        else { P0 = (f32x16){}; P1 = (f32x16){}; } \
        const LAS unsigned char* kb_ = lds + bf_ * AT_KBUF + r32 * KROW + hi * 16; \
        _Pragma("unroll") for (int hb = 0; hb < 2; ++hb) { bf16x8 kf_[NDS]; \
            _Pragma("unroll") for (int d2 = 0; d2 < NDS / 2; ++d2) { const int ds = hb * (NDS / 2) + d2; kf_[2 * d2] = *(const LAS bf16x8*)(kb_ + ds * 32); kf_[2 * d2 + 1] = *(const LAS bf16x8*)(kb_ + 32 * KROW + ds * 32); } \
            __builtin_amdgcn_sched_barrier(0); \
            _Pragma("unroll") for (int d2 = 0; d2 < NDS / 2; ++d2) { const int ds = hb * (NDS / 2) + d2; \
                P0 = __builtin_amdgcn_mfma_f32_32x32x16_bf16(kf_[2 * d2], qr[ds], P0, 0, 0, 0); \
                P1 = __builtin_amdgcn_mfma_f32_32x32x16_bf16(kf_[2 * d2 + 1], qr[ds], P1, 0, 0, 0); } } \
        if (MASKOK && !MLA && (t_) * 64 + 63 > qw0) { const int q_ = qw0 + r32; \
            _Pragma("unroll") for (int r = 0; r < 16; ++r) { const int kv = (t_) * 64 + crow(r, hi); if (kv > q_) P0[r] = -INFINITY; if (kv + 32 > q_) P1[r] = -INFINITY; } } } while (0)
#define AT_SMPV(P0, P1, t_) do { const int bf_ = (t_) & 1; \
        float ra = fmaxf(fmaxf(P0[0], P0[1]), P1[0]), rb = fmaxf(fmaxf(P0[2], P0[3]), P1[1]); ra = fmaxf(fmaxf(ra, P1[2]), P1[3]); \
        _Pragma("unroll") for (int r = 4; r < 16; r += 4) { ra = fmaxf(fmaxf(ra, P0[r]), P0[r + 1]); rb = fmaxf(fmaxf(rb, P0[r + 2]), P0[r + 3]); ra = fmaxf(fmaxf(ra, P1[r]), P1[r + 1]); rb = fmaxf(fmaxf(rb, P1[r + 2]), P1[r + 3]); } \
        float rm = fmaxf(ra, rb); { auto rr = __builtin_amdgcn_permlane32_swap(__float_as_uint(rm), __float_as_uint(rm), false, false); rm = fmaxf(__uint_as_float(rr[0]), __uint_as_float(rr[1])); } \
        if (__any(rm > mhat + 16.f)) { \
            const float mnew = fmaxf(mhat, rm), alpha = __builtin_amdgcn_exp2f(mhat - mnew); \
            lsum *= alpha; mhat = mnew; \
            _Pragma("unroll") for (int r = 0; r < 16; ++r) { o0[r] *= alpha; o1[r] *= alpha; } } \
        float sacc = 0.f; \
        _Pragma("unroll") for (int r = 0; r < 16; ++r) { P0[r] = __builtin_amdgcn_exp2f(P0[r] - mhat); P1[r] = __builtin_amdgcn_exp2f(P1[r] - mhat); sacc += P0[r] + P1[r]; } \
        lsum += sacc; \
        u32x4 pw[4]; \
        _Pragma("unroll") for (int s = 0; s < 2; ++s) { \
            pw[s]     = (u32x4){cvtpk_s(P0[8 * s], P0[8 * s + 1]), cvtpk_s(P0[8 * s + 2], P0[8 * s + 3]), cvtpk_s(P0[8 * s + 4], P0[8 * s + 5]), cvtpk_s(P0[8 * s + 6], P0[8 * s + 7])}; \
            pw[2 + s] = (u32x4){cvtpk_s(P1[8 * s], P1[8 * s + 1]), cvtpk_s(P1[8 * s + 2], P1[8 * s + 3]), cvtpk_s(P1[8 * s + 4], P1[8 * s + 5]), cvtpk_s(P1[8 * s + 6], P1[8 * s + 7])}; } \
        const LAS unsigned char* vp_ = lds + vb + bf_ * 8192; \
        _Pragma("unroll") for (int s = 0; s < 4; ++s) { \
            const bf16x8 pa = __builtin_bit_cast(bf16x8, pw[s]); \
            const bf16x8 v0 = vtr2(vp_ + s * 1024), v1 = vtr2(vp_ + 4096 + s * 1024); \
            o0 = __builtin_amdgcn_mfma_f32_32x32x16_bf16(v0, pa, o0, 0, 0, 0); \
            o1 = __builtin_amdgcn_mfma_f32_32x32x16_bf16(v1, pa, o1, 0, 0, 0); } } while (0)
#define AT_STEP(PAR, C0, C1, N0, N1, t_) do { \
        if ((t_) + 2 < NT) AT_LOADK((t_) + 2); if ((t_) + 1 < NT) AT_LOADV((t_) + 1); \
        const bool actN_ = ((t_) + 1 < NT) && (((t_) + 1) * 64 <= qw0), actC_ = ((t_) * 64 <= qw0); \
        __builtin_amdgcn_sched_barrier(0); \
        if (PAR == 0) { if (actN_) AT_QK(N0, N1, (t_) + 1, true); if (actC_) AT_SMPV(C0, C1, t_); } \
        else          { if (actC_) AT_SMPV(C0, C1, t_); if (actN_) AT_QK(N0, N1, (t_) + 1, true); } \
        __builtin_amdgcn_sched_barrier(0); \
        if ((t_) + 2 < NT) AT_STOREK((t_) & 1); if ((t_) + 1 < NT) AT_STOREV(((t_) + 1) & 1); \
        __syncthreads(); } while (0)
#define AT_STEADY(PAR, C0, C1, N0, N1, t_) do { \
        AT_LOADK((t_) + 2); AT_LOADV((t_) + 1); \
        __builtin_amdgcn_sched_barrier(0); \
        if (PAR == 0) { AT_QKF(N0, N1, (t_) + 1, false); AT_SMPV(C0, C1, t_); } \
        else          { AT_SMPV(C0, C1, t_); AT_QK(N0, N1, (t_) + 1, false); \
            _Pragma("unroll") for (int i_ = 0; i_ < 2 * NDS; ++i_) { __builtin_amdgcn_sched_group_barrier(0x002, 12, 0); __builtin_amdgcn_sched_group_barrier(0x008, 1, 0); } } \
        __builtin_amdgcn_sched_barrier(0); \
        AT_STOREK((t_) & 1); AT_STOREV(((t_) + 1) & 1); \
        __syncthreads(); } while (0)
    f32x16 sa0, sa1, sb0, sb1;
    __syncthreads();
    AT_LOADK(t0); AT_LOADV(t0); AT_STOREK(0); AT_STOREV(0); AT_LOADK(t0 + 1); AT_STOREK(1);
    __syncthreads();
    AT_QK(sa0, sa1, t0, true);
    __syncthreads();
    int t = t0;
    if (par == 0) {
        for (; t + 6 < NT; t += 2) { AT_STEADY(0, sa0, sa1, sb0, sb1, t); AT_STEADY(0, sb0, sb1, sa0, sa1, t + 1); }
        for (; t < NT; t += 2) { AT_STEP(0, sa0, sa1, sb0, sb1, t); AT_STEP(0, sb0, sb1, sa0, sa1, t + 1); }
    } else {
        for (; t + 6 < NT; t += 2) { AT_STEADY(1, sa0, sa1, sb0, sb1, t); AT_STEADY(1, sb0, sb1, sa0, sa1, t + 1); }
        for (; t < NT; t += 2) { AT_STEP(1, sa0, sa1, sb0, sb1, t); AT_STEP(1, sb0, sb1, sa0, sa1, t + 1); }
    }
#undef AT_LOADK
#undef AT_STOREK
#undef AT_LOADV
#undef AT_STOREV
#undef AT_QK
#undef AT_QKF
#undef AT_SMPV
#undef AT_STEP
#undef AT_STEADY
    float lt; { auto rr = __builtin_amdgcn_permlane32_swap(__float_as_uint(lsum), __float_as_uint(lsum), false, false); lt = __uint_as_float(rr[0]) + __uint_as_float(rr[1]); }
    const float rl = __builtin_amdgcn_rcpf(lt);
    const size_t ob = (rowbase + qw0 + r32) * 1024 + (MLA ? 512 : 0) + h * 64 + 4 * hi;
#pragma unroll
    for (int g = 0; g < 4; ++g) {
        const u32x2 ga = *(const u32x2*)(GATE + ob + 8 * g), gb = *(const u32x2*)(GATE + ob + 32 + 8 * g);
        f32x4 a = (f32x4){o0[4 * g], o0[4 * g + 1], o0[4 * g + 2], o0[4 * g + 3]} * rl, c = (f32x4){o1[4 * g], o1[4 * g + 1], o1[4 * g + 2], o1[4 * g + 3]} * rl;
        a = a * (f32x4){__builtin_bit_cast(float, ga.x << 16), __builtin_bit_cast(float, ga.x & 0xffff0000u), __builtin_bit_cast(float, ga.y << 16), __builtin_bit_cast(float, ga.y & 0xffff0000u)};
        c = c * (f32x4){__builtin_bit_cast(float, gb.x << 16), __builtin_bit_cast(float, gb.x & 0xffff0000u), __builtin_bit_cast(float, gb.y << 16), __builtin_bit_cast(float, gb.y & 0xffff0000u)};
        *(u32x2*)(Y + ob + 8 * g) = pk4(a); *(u32x2*)(Y + ob + 32 + 8 * g) = pk4(c);
    }
}

template <int MODE>
__device__ __forceinline__ void transpose_item(const float* __restrict__ W, int K, int Nsrc, int Ndst, bf16_t* __restrict__ WT, const float* __restrict__ kscale, LAS float* scr, int item, int lane) {
    const int nblk = Ndst / 32, kb = item / nblk, nb = item % nblk, k0 = 64 * kb, n0 = 32 * nb;
    const int nd = n0 + (lane & 31); int ns = nd; bool valid = true;
    if (MODE == 1) { if (nd < 1536) ns = nd; else if (nd < 2976) ns = nd + 8; else if (nd < 2984) ns = nd - 1440; else { ns = 0; valid = false; } }
#pragma unroll 32
    for (int i = 0; i < 32; ++i) { const int kk = 2 * i + (lane >> 5); float v = valid ? W[(size_t)(k0 + kk) * Nsrc + ns] : 0.f; if (kscale) v *= kscale[k0 + kk]; scr[kk * 33 + (lane & 31)] = v; }
    LDS_WAIT();
    const int c = lane & 7;
#pragma unroll
    for (int j = 0; j < 4; ++j) { const int n = (lane >> 3) + 8 * j; const LAS float* s = scr + (8 * c) * 33 + n;
        u32x4 o; o.x = pk2(s[0 * 33], s[1 * 33]); o.y = pk2(s[2 * 33], s[3 * 33]); o.z = pk2(s[4 * 33], s[5 * 33]); o.w = pk2(s[6 * 33], s[7 * 33]);
        *(u32x4*)(WT + (size_t)(n0 + n) * K + k0 + 8 * c) = o; }
    LDS_WAIT();
}

struct Args { const void* in[14]; float* out; unsigned char* ws; };

__global__ void __launch_bounds__(512) mk_fwd(Args args) {
    extern __shared__ __attribute__((aligned(16))) unsigned char smem[];
    LAS unsigned char* lds = (LAS unsigned char*)smem;
    cg::grid_group grid = cg::this_grid();
    const int wave_s = __builtin_amdgcn_readfirstlane((int)threadIdx.x >> 6);
    const int G = gridDim.x, bx = blockIdx.x, NGW = G * 8;
    unsigned char* ws = args.ws; float* X = args.out;
    float* MOD = (float*)(ws + WS_MOD);
    unsigned* bar = (unsigned*)ws;
    volatile LAS unsigned* bst = (volatile LAS unsigned*)(lds + 131072);
    { const int t0 = otid(wave_s); if (t0 < 2) bst[t0] = 0u; __syncthreads(); if (t0 == 0) (void)xb_add(&bar[XB_XCNT(xb_xcc_id())], 1u); }
#define GRID_BAR() xcd_barrier(bar, bst, otid(wave_s))

    {
        const int tid = otid(wave_s), lane = tid & 63; const int wave = __builtin_amdgcn_readfirstlane(tid >> 6); const int gw = bx * 8 + wave;
        const float* c_in = (const float*)args.in[1]; const int* pos_in = (const int*)args.in[2];
        const float* w_ada = (const float*)args.in[4]; const float* b_ada = (const float*)args.in[5];
        const float* w_in = (const float*)args.in[6]; const float* q_norm_g = (const float*)args.in[8];
        const float* w_uq = (const float*)args.in[9]; const float* kv_norm_g = (const float*)args.in[10]; const float* w_ukv = (const float*)args.in[11];
        const float* w_out = (const float*)args.in[12];
        bf16_t* WIN = (bf16_t*)(ws + WS_WIN); bf16_t* WOUT = (bf16_t*)(ws + WS_WOUT); bf16_t* WUQ = (bf16_t*)(ws + WS_WUQ); bf16_t* WUKV = (bf16_t*)(ws + WS_WUKV);
        float* COS = (float*)(ws + WS_COS); float* SIN = (float*)(ws + WS_SIN);
        for (int unit = bx; unit < DEPTH * 48; unit += G) {
            LAS float* cact = (LAS float*)lds; LAS float* red = (LAS float*)(lds + 32768);
            const int l = unit / 48, n = (unit % 48) * 64 + lane;
            for (int i = tid; i < NB * DM; i += 512) cact[i] = silu_f(c_in[i]);
            __syncthreads();
            float a[8];
#pragma unroll
            for (int b = 0; b < 8; ++b) a[b] = 0.f;
            const float* wp = w_ada + ((size_t)l * DM + 128 * wave) * 3072 + n;
#pragma unroll 16
            for (int kk = 0; kk < 128; ++kk) { const float wv = wp[(size_t)kk * 3072];
#pragma unroll
                for (int b = 0; b < 8; ++b) a[b] += cact[b * DM + 128 * wave + kk] * wv; }
#pragma unroll
            for (int b = 0; b < 8; ++b) red[(wave * 8 + b) * 64 + lane] = a[b];
            __syncthreads();
            { float s = b_ada[l * 3072 + n];
#pragma unroll
              for (int w2 = 0; w2 < 8; ++w2) s += red[(w2 * 8 + wave) * 64 + lane];
              MOD[(size_t)(l * 8 + wave) * 3072 + n] = s; }
            __syncthreads();
        }
        { LAS float* scr = (LAS float*)(lds + 49152) + wave * (64 * 33);
          constexpr int I_IN = 16 * 96, I_OUT = 16 * 32, I_UQ = 4 * 24, I_UKV = 2 * 32, I_L = I_IN + I_OUT + I_UQ + I_UKV;
          for (int it = gw; it < DEPTH * I_L; it += NGW) {
              const int l = it / I_L; int r = it % I_L;
              if (r < I_IN) { transpose_item<1>(w_in + (size_t)l * DM * NIN, DM, NIN, NINP, WIN + (size_t)l * NINP * DM, nullptr, scr, r, lane); continue; } r -= I_IN;
              if (r < I_OUT) { transpose_item<0>(w_out + (size_t)l * DM * DM, DM, DM, DM, WOUT + (size_t)l * DM * DM, nullptr, scr, r, lane); continue; } r -= I_OUT;
              if (r < I_UQ) { transpose_item<0>(w_uq + (size_t)l * 256 * 768, 256, 768, 768, WUQ + (size_t)l * 768 * 256, q_norm_g + l * 256, scr, r, lane); continue; } r -= I_UQ;
              transpose_item<0>(w_ukv + (size_t)l * 128 * 1024, 128, 1024, 1024, WUKV + (size_t)l * 1024 * 128, kv_norm_g + l * 128, scr, r, lane);
          } }
        for (int idx = bx * 512 + tid; idx < MTOK * 16; idx += G * 512) {
            const int tok = idx >> 4, i = idx & 15;
            const float inv = 1.0f / powf(10000.0f, (float)(2 * i) * (1.0f / 32.0f));
            const float ang = (float)pos_in[tok] * inv; float sn, cs; sincosf(ang, &sn, &cs);
            COS[idx] = cs; SIN[idx] = sn;
        }
    }

    grid.sync();
    for (int l = 0; l <= DEPTH; ++l) {
        if (l > 0) GRID_BAR();
        {
            const int tid = otid(wave_s), lane = tid & 63; const int wave = __builtin_amdgcn_readfirstlane(tid >> 6); const int gw = bx * 8 + wave;
            const bool fin = (l == DEPTH);
            if (bx == 0 && tid < 256) ((unsigned*)(ws + WS_SB))[tid] = 0u;
            const float* xs = (l == 0) ? (const float*)args.in[0] : X; const float* gsrc = fin ? (const float*)args.in[13] : (const float*)args.in[3] + l * DM;
            bf16_t* H = (bf16_t*)(ws + WS_H);
            for (int r0 = gw * 16; r0 < MTOK; r0 += NGW * 16) {
                const int b = r0 >> 12;
                f32x4 gs[4], sh[4];
#pragma unroll
                for (int j = 0; j < 4; ++j) { const int col = 4 * lane + 256 * j; const f32x4 g = *(const f32x4*)(gsrc + col);
                    if (fin) { gs[j] = g; sh[j] = (f32x4){0.f, 0.f, 0.f, 0.f}; }
                    else { const f32x4 sc = *(const f32x4*)(MOD + (size_t)(l * 8 + b) * 3072 + 1024 + col); gs[j] = g * (sc + 1.0f); sh[j] = *(const f32x4*)(MOD + (size_t)(l * 8 + b) * 3072 + col); } }
                for (int rr = 0; rr < 16; ++rr) {
                    const size_t row = (size_t)(r0 + rr);
                    f32x4 v[4]; float ss = 0.f;
#pragma unroll
                    for (int j = 0; j < 4; ++j) { v[j] = *(const f32x4*)(xs + row * DM + 4 * lane + 256 * j); ss += (v[j][0] * v[j][0] + v[j][1] * v[j][1]) + (v[j][2] * v[j][2] + v[j][3] * v[j][3]); }
                    const float rstd = rsqrtf(wave_sum(ss, lane) * (1.f / DM) + EPS_);
                    if (fin) {
#pragma unroll
                        for (int j = 0; j < 4; ++j) *(f32x4*)(X + row * DM + 4 * lane + 256 * j) = v[j] * rstd * gs[j];
                    } else {
#pragma unroll
                        for (int j = 0; j < 4; ++j) *(u32x2*)(H + row * DM + 4 * lane + 256 * j) = pk4(v[j] * rstd * gs[j] + sh[j]);
                    }
                }
            }
        }
        if (l == DEPTH) break;
        GRID_BAR();
        {
            pg8::Gemm g{(const bf16_t*)(ws + WS_H), (const bf16_t*)(ws + WS_WIN) + (size_t)l * NINP * DM, MTOK, NINP, DM}; pg8::StaticOrder S; S.init(MTOK, NINP, G, bx);
            EpiIn E{ws, (const float*)args.in[7] + l * 8};
            pg8::gemm_phase<EpiIn, pg8::StaticOrder, true, true>(lds, g, S, E, wave_s);
        }
        GRID_BAR();
        {
            const int tid = otid(wave_s), lane = tid & 63; const int wave = __builtin_amdgcn_readfirstlane(tid >> 6);
            const float* LOGF = (const float*)(ws + WS_LOGF); float* CUM = (float*)(ws + WS_CUM);
            for (int u = bx; u < 64; u += G) {
                LAS float* wsum = (LAS float*)lds;
                const float* lf = LOGF + (size_t)(u >> 3) * SEQ * 8 + (u & 7);
                float v[8]; float s = 0.f;
#pragma unroll
                for (int i = 0; i < 8; ++i) { s += lf[(size_t)(8 * tid + i) * 8]; v[i] = s; }
                float incl = s;
#pragma unroll
                for (int off = 1; off < 64; off <<= 1) { const float t = shup(incl, off, lane); if (lane >= off) incl += t; }
                if (lane == 63) wsum[wave] = incl;
                __syncthreads();
                float base = 0.f;
                for (int w2 = 0; w2 < wave; ++w2) base += wsum[w2];
                const float excl = base + incl - s;
#pragma unroll
                for (int i = 0; i < 8; ++i) CUM[(size_t)u * SEQ + 8 * tid + i] = (excl + v[i]) * LOG2E;
                __syncthreads();
            }
        }
        { pg8::Gemm g{(const bf16_t*)(ws + WS_QLAT), (const bf16_t*)(ws + WS_WUQ) + (size_t)l * 768 * 256, MTOK, 768, 256}; pg8::StaticOrder S; S.init(MTOK, 768, G, bx);
          EpiQ E{ws};
          pg8::gemm_phase<EpiQ, pg8::StaticOrder, true, true>(lds, g, S, E, wave_s); }
        __syncthreads();
        { pg8::Gemm g{(const bf16_t*)(ws + WS_KVLAT), (const bf16_t*)(ws + WS_WUKV) + (size_t)l * 1024 * 128, MTOK, 1024, 128}; pg8::StaticOrder S; S.init(MTOK, 1024, G, bx);
          EpiKV E{ws};
          pg8::gemm_phase<EpiKV, pg8::StaticOrder, true, true>(lds, g, S, E, wave_s); }
        GRID_BAR();
        {
            unsigned* ctr = bar + CTR_WORD + 64 * l;
            LAS int* ub = (LAS int*)(lds + 131072 + 64);
            for (;;) {
                const int tq = otid(wave_s);
                __syncthreads();
                if (tq == 0) *ub = (int)__hip_atomic_fetch_add(ctr, 1u, __ATOMIC_RELAXED, __HIP_MEMORY_SCOPE_AGENT);
                __syncthreads();
                const int u = __builtin_amdgcn_readfirstlane(*ub);
                if (u >= 2048) break;
                const int r = u & 1023, qb = 15 - (r >> 6), bh = r & 63;
                if (u < 1024) attn_unit<true>(lds, bh >> 3, bh & 7, qb, ws, wave_s);
                else attn_unit<false>(lds, bh >> 3, bh & 7, qb, ws, wave_s);
            }
        }
        GRID_BAR();
        {
            pg8::Gemm g{(const bf16_t*)(ws + WS_H), (const bf16_t*)(ws + WS_WOUT) + (size_t)l * DM * DM, MTOK, DM, DM}; pg8::StaticOrder S; S.init(MTOK, DM, G, bx);
            EpiOut E{l == 0 ? (const float*)args.in[0] : X, X, MOD + (size_t)l * 8 * 3072 + 2048};
            pg8::gemm_phase<EpiOut, pg8::StaticOrder, true, true>(lds, g, S, E, wave_s);
        }
    }
}

extern "C" void kernel_launch(void* const* d_in, const int* in_sizes, int n_in, void* d_out, int out_size, void* d_ws, size_t ws_size, hipStream_t stream) {
    static int grid = 0;
    if (grid == 0) {
        if (n_in != 14 || out_size != MTOK * DM || ws_size < WS_END) { fprintf(stderr, "kernel_launch: unexpected shapes (n_in %d, out %d, ws %zu)\n", n_in, out_size, ws_size); grid = -1; return; }
        int dev = 0, cus = 0, per_cu = 0;
        (void)hipGetDevice(&dev); (void)hipDeviceGetAttribute(&cus, hipDeviceAttributeMultiprocessorCount, dev);
        (void)hipFuncSetAttribute((const void*)mk_fwd, hipFuncAttributeMaxDynamicSharedMemorySize, LDS_BYTES);
        if (hipOccupancyMaxActiveBlocksPerMultiprocessor(&per_cu, (const void*)mk_fwd, 512, LDS_BYTES) != hipSuccess || per_cu < 1) per_cu = 1;
        (void)hipGetLastError();
        grid = cus * per_cu;
    }
    if (grid < 0) return;
    (void)hipMemsetAsync(d_ws, 0, 16384, stream);
    Args a{};
    for (int i = 0; i < 14; ++i) a.in[i] = d_in[i];
    a.out = (float*)d_out; a.ws = (unsigned char*)d_ws;
    void* kargs[] = {&a};
    hipError_t e = hipLaunchCooperativeKernel((const void*)mk_fwd, dim3(grid), dim3(512), kargs, LDS_BYTES, stream);
    if (e != hipSuccess) fprintf(stderr, "cooperative launch failed: %s (grid %d)\n", hipGetErrorString(e), grid);
}
```
